# Optimizing an MI355X kernel written in HIP

```python
import math
import jax
import jax.numpy as jnp
from jax import lax
import numpy as np

D_MODEL = 2048
BATCH = 2
SEQ = 4096
DEPTH = 4

MEM_LEN = 256
Q_BLOCK = 128
D_FF = 5632
NORM_EPS = 1e-6
NEG_INF = -1e30
SEL_BIG = 1e9

DIFF_HEADS = 8
DIFF_QK_DIM = 64
DIFF_V_DIM = 2 * DIFF_QK_DIM

NSA_HEADS = 8
NSA_GROUPS = 2
NSA_HPG = NSA_HEADS // NSA_GROUPS
NSA_DIM = 128
CMP_LEN = 32
CMP_STRIDE = 16
SLC_LEN = 64
SLC_TOPK = 8
WIN_LEN = 512

MEM_HEADS = 4
MEM_DIM = 128

N_BRANCH = 3

DIFF_QK_COLS = DIFF_HEADS * 2 * DIFF_QK_DIM
DIFF_V_COLS = DIFF_HEADS * DIFF_V_DIM
NSA_Q_COLS = NSA_HEADS * NSA_DIM
NSA_KV_COLS = 3 * 2 * NSA_GROUPS * NSA_DIM
NSA_GATE_COLS = NSA_HEADS * 3
MEM_Q_COLS = MEM_HEADS * MEM_DIM
MERGE_GATE_COLS = N_BRANCH * D_MODEL
IN_SPLITS = (DIFF_QK_COLS, DIFF_QK_COLS, DIFF_V_COLS, NSA_Q_COLS, NSA_KV_COLS, NSA_GATE_COLS, MEM_Q_COLS, MERGE_GATE_COLS)
IN_COLS = sum(IN_SPLITS)

kernel_name = "hybrid_diff_nsa_macaron_trunk"


def rmsnorm(x, g):
    xf = x.astype(jnp.float32)
    y = xf * lax.rsqrt(jnp.mean(xf * xf, axis=-1, keepdims=True) + NORM_EPS)
    return (y * g.astype(jnp.float32)).astype(x.dtype)


def swiglu(x, w_gate, w_up, w_down):
    return (jax.nn.silu(x @ w_gate) * (x @ w_up)) @ w_down


def alibi_slopes(n_heads):
    return jnp.asarray(np.array([2.0 ** (-8.0 * (h + 1) / n_heads) for h in range(n_heads)], dtype=np.float32))


def masked_softmax(s, mask):
    s = jnp.where(mask, s, NEG_INF)
    m = jnp.max(s, axis=-1, keepdims=True)
    e = jnp.where(mask, jnp.exp(s - m), 0.0)
    return e / jnp.maximum(jnp.sum(e, axis=-1, keepdims=True), 1e-30)


def split_columns(proj):
    outs, start = [], 0
    for width in IN_SPLITS:
        outs.append(proj[..., start:start + width])
        start += width
    return outs


def diff_attention(q, k, v, lam, lam_init, subln_g):
    B, S = q.shape[:2]
    nb = S // Q_BLOCK
    scale = DIFF_QK_DIM ** -0.5
    slopes = alibi_slopes(DIFF_HEADS)[None, :, None, None, None]
    kpos = jnp.arange(S)
    qb = q.reshape(B, nb, Q_BLOCK, DIFF_HEADS, 2, DIFF_QK_DIM).transpose(1, 0, 2, 3, 4, 5)

    def block(args):
        q_blk, i = args
        qpos = i * Q_BLOCK + jnp.arange(Q_BLOCK)
        dist = (qpos[:, None] - kpos[None, :]).astype(jnp.float32)
        s = jnp.einsum('bqhmd,bkhmd->bhmqk', q_blk, k).astype(jnp.float32) * scale - slopes * dist
        p = masked_softmax(s, dist >= 0)
        w = p[:, :, 0] - lam * p[:, :, 1]
        return jnp.einsum('bhqk,bkhd->bqhd', w.astype(v.dtype), v)

    o = lax.map(block, (qb, jnp.arange(nb)))
    o = o.transpose(1, 0, 2, 3, 4).reshape(B, S, DIFF_HEADS, DIFF_V_DIM)
    o = rmsnorm(o, subln_g) * (1.0 - lam_init)
    return o.reshape(B, S, DIFF_HEADS * DIFF_V_DIM)


def compress(kv, pos, w1, w2):
    B, S, G, d = kv.shape
    nc = (S - CMP_LEN) // CMP_STRIDE + 1
    idx = jnp.arange(nc)[:, None] * CMP_STRIDE + jnp.arange(CMP_LEN)[None, :]
    blocks = kv[:, idx] + pos[None, None, :, None, :]
    blocks = blocks.transpose(0, 1, 3, 2, 4).reshape(B, nc, G, CMP_LEN * d)
    return jax.nn.gelu(blocks @ w1) @ w2


def nsa_attention(q, k_cmp, v_cmp, k_slc, v_slc, k_win, v_win, gates):
    B, S = q.shape[:2]
    nb = S // Q_BLOCK
    nc = k_cmp.shape[1]
    ns = S // SLC_LEN
    n_sel = min(SLC_TOPK, ns)
    scale = NSA_DIM ** -0.5
    slopes = alibi_slopes(NSA_HEADS).reshape(NSA_GROUPS, NSA_HPG)[None, :, :, None, None]
    cmp_start = jnp.arange(nc) * CMP_STRIDE
    cmp_end = cmp_start + CMP_LEN - 1
    slc_start = jnp.arange(ns) * SLC_LEN
    overlap = ((cmp_start[:, None] < slc_start[None, :] + SLC_LEN) & (cmp_start[:, None] + CMP_LEN > slc_start[None, :])).astype(jnp.float32)
    k_slc_t = k_slc.transpose(0, 2, 1, 3)
    v_slc_t = v_slc.transpose(0, 2, 1, 3)
    kw_pad = jnp.pad(k_win, ((0, 0), (WIN_LEN, 0), (0, 0), (0, 0)))
    vw_pad = jnp.pad(v_win, ((0, 0), (WIN_LEN, 0), (0, 0), (0, 0)))
    bi = jnp.arange(B)[:, None, None, None]
    gi = jnp.arange(NSA_GROUPS)[None, :, None, None]
    jblk = jnp.arange(ns)
    qb = q.reshape(B, nb, Q_BLOCK, NSA_GROUPS, NSA_HPG, NSA_DIM).transpose(1, 0, 2, 3, 4, 5)
    gb = gates.reshape(B, nb, Q_BLOCK, NSA_GROUPS, NSA_HPG, 3).transpose(1, 0, 2, 3, 4, 5)

    def block(args):
        q_blk, g_blk, i = args
        q0 = i * Q_BLOCK
        qpos = q0 + jnp.arange(Q_BLOCK)
        s_c = jnp.einsum('bqghd,bcgd->bghqc', q_blk, k_cmp).astype(jnp.float32) * scale
        p_c = masked_softmax(s_c, cmp_end[None, :] <= qpos[:, None])
        o_c = jnp.einsum('bghqc,bcgd->bqghd', p_c.astype(v_cmp.dtype), v_cmp)
        imp = jnp.einsum('bghqc,cj->bgqj', p_c, overlap)
        cur = qpos // SLC_LEN
        forced = (jblk[None, :] == 0) | (jblk[None, :] == cur[:, None]) | (jblk[None, :] == cur[:, None] - 1)
        future = jblk[None, :] > cur[:, None]
        imp = jnp.where(forced, SEL_BIG, jnp.where(future, -SEL_BIG, imp))
        _, sel = lax.top_k(imp, n_sel)
        tok = (sel[..., None] * SLC_LEN + jnp.arange(SLC_LEN)).reshape(B, NSA_GROUPS, Q_BLOCK, n_sel * SLC_LEN)
        kg = k_slc_t[bi, gi, tok]
        vg = v_slc_t[bi, gi, tok]
        dist_s = (qpos[None, None, :, None] - tok).astype(jnp.float32)[:, :, None]
        s_s = jnp.einsum('bqghd,bgqtd->bghqt', q_blk, kg).astype(jnp.float32) * scale - slopes * dist_s
        p_s = masked_softmax(s_s, dist_s >= 0)
        o_s = jnp.einsum('bghqt,bgqtd->bqghd', p_s.astype(vg.dtype), vg)
        kw = lax.dynamic_slice_in_dim(kw_pad, q0, Q_BLOCK + WIN_LEN, axis=1)
        vw = lax.dynamic_slice_in_dim(vw_pad, q0, Q_BLOCK + WIN_LEN, axis=1)
        kpos = q0 - WIN_LEN + jnp.arange(Q_BLOCK + WIN_LEN)
        dist_w = (qpos[:, None] - kpos[None, :]).astype(jnp.float32)
        mask_w = (dist_w >= 0) & (dist_w < WIN_LEN) & (kpos[None, :] >= 0)
        s_w = jnp.einsum('bqghd,bkgd->bghqk', q_blk, kw).astype(jnp.float32) * scale - slopes * dist_w
        p_w = masked_softmax(s_w, mask_w)
        o_w = jnp.einsum('bghqk,bkgd->bqghd', p_w.astype(vw.dtype), vw)
        return g_blk[..., 0:1] * o_c + g_blk[..., 1:2] * o_s + g_blk[..., 2:3] * o_w

    o = lax.map(block, (qb, gb, jnp.arange(nb)))
    return o.transpose(1, 0, 2, 3, 4, 5).reshape(B, S, NSA_HEADS * NSA_DIM)


def memory_attention(q, k, v):
    B, S = q.shape[:2]
    s = jnp.einsum('bshd,bmhd->bhsm', q, k).astype(jnp.float32) * (MEM_DIM ** -0.5)
    p = jax.nn.softmax(s, axis=-1)
    return jnp.einsum('bhsm,bmhd->bshd', p.astype(v.dtype), v).reshape(B, S, MEM_HEADS * MEM_DIM)


def setup_inputs(seed: int = 0) -> dict:
    key = jax.random.key(seed)
    keys = iter(jax.random.split(key, 32))
    L, D, F = DEPTH, D_MODEL, D_FF

    def dense(shape, fan_in):
        return jax.random.normal(next(keys), shape, jnp.float32) * (fan_in ** -0.5)

    def gain(shape):
        return 1.0 + 0.02 * jax.random.normal(next(keys), shape, jnp.float32)

    return {
        "x": jax.random.normal(next(keys), (BATCH, SEQ, D), jnp.float32),
        "mem": jax.random.normal(next(keys), (BATCH, MEM_LEN, D), jnp.float32),
        "ffn1_norm": gain((L, D)),
        "ffn1_w_gate": dense((L, D, F), D),
        "ffn1_w_up": dense((L, D, F), D),
        "ffn1_w_down": dense((L, F, D), F),
        "mix_norm": gain((L, D)),
        "w_in": dense((L, D, IN_COLS), D),
        "diff_lambda": 0.1 * jax.random.normal(next(keys), (L, 4, DIFF_QK_DIM), jnp.float32),
        "diff_subln": gain((L, DIFF_V_DIM)),
        "nsa_cmp_pos": 0.1 * jax.random.normal(next(keys), (L, 2, CMP_LEN, NSA_DIM), jnp.float32),
        "nsa_cmp_w1": dense((L, 2, CMP_LEN * NSA_DIM, NSA_DIM), CMP_LEN * NSA_DIM),
        "nsa_cmp_w2": dense((L, 2, NSA_DIM, NSA_DIM), NSA_DIM),
        "mem_norm": gain((L, D)),
        "w_mem_kv": dense((L, D, 2 * MEM_HEADS * MEM_DIM), D),
        "w_up_diff": dense((L, DIFF_HEADS * DIFF_V_DIM, D), DIFF_HEADS * DIFF_V_DIM),
        "w_up_nsa": dense((L, NSA_HEADS * NSA_DIM, D), NSA_HEADS * NSA_DIM),
        "w_up_mem": dense((L, MEM_HEADS * MEM_DIM, D), MEM_HEADS * MEM_DIM),
        "w_out": dense((L, D, D), D),
        "ffn2_norm": gain((L, D)),
        "ffn2_w_gate": dense((L, D, F), D),
        "ffn2_w_up": dense((L, D, F), D),
        "ffn2_w_down": dense((L, F, D), F),
        "final_norm": gain((D,)),
    }


def reference(x, mem, ffn1_norm, ffn1_w_gate, ffn1_w_up, ffn1_w_down, mix_norm, w_in,
              diff_lambda, diff_subln, nsa_cmp_pos, nsa_cmp_w1, nsa_cmp_w2, mem_norm, w_mem_kv,
              w_up_diff, w_up_nsa, w_up_mem, w_out, ffn2_norm, ffn2_w_gate, ffn2_w_up,
              ffn2_w_down, final_norm):
    B, S, _ = x.shape
    M = mem.shape[1]
    for l in range(DEPTH):
        x = x + 0.5 * swiglu(rmsnorm(x, ffn1_norm[l]), ffn1_w_gate[l], ffn1_w_up[l], ffn1_w_down[l])
        h = rmsnorm(x, mix_norm[l])
        dq, dk, dv, nq, nkv, ng, mq, mg = split_columns(h @ w_in[l])
        lam_init = 0.8 - 0.6 * math.exp(-0.3 * l)
        lp = diff_lambda[l].astype(jnp.float32)
        lam = jnp.exp(jnp.sum(lp[0] * lp[1])) - jnp.exp(jnp.sum(lp[2] * lp[3])) + lam_init
        o_diff = diff_attention(dq.reshape(B, S, DIFF_HEADS, 2, DIFF_QK_DIM),
                                dk.reshape(B, S, DIFF_HEADS, 2, DIFF_QK_DIM),
                                dv.reshape(B, S, DIFF_HEADS, DIFF_V_DIM),
                                lam, lam_init, diff_subln[l])
        nkv = nkv.reshape(B, S, 3, 2, NSA_GROUPS, NSA_DIM)
        k_cmp = compress(nkv[:, :, 0, 0], nsa_cmp_pos[l, 0], nsa_cmp_w1[l, 0], nsa_cmp_w2[l, 0])
        v_cmp = compress(nkv[:, :, 0, 1], nsa_cmp_pos[l, 1], nsa_cmp_w1[l, 1], nsa_cmp_w2[l, 1])
        o_nsa = nsa_attention(nq.reshape(B, S, NSA_GROUPS, NSA_HPG, NSA_DIM), k_cmp, v_cmp,
                              nkv[:, :, 1, 0], nkv[:, :, 1, 1], nkv[:, :, 2, 0], nkv[:, :, 2, 1],
                              jax.nn.sigmoid(ng).reshape(B, S, NSA_GROUPS, NSA_HPG, 3))
        mem_kv = (rmsnorm(mem, mem_norm[l]) @ w_mem_kv[l]).reshape(B, M, 2, MEM_HEADS, MEM_DIM)
        o_mem = memory_attention(mq.reshape(B, S, MEM_HEADS, MEM_DIM), mem_kv[:, :, 0], mem_kv[:, :, 1])
        g = jax.nn.sigmoid(mg).reshape(B, S, N_BRANCH, D_MODEL)
        merged = (g[:, :, 0] * (o_diff @ w_up_diff[l]) + g[:, :, 1] * (o_nsa @ w_up_nsa[l])
                  + g[:, :, 2] * (o_mem @ w_up_mem[l]))
        x = x + merged @ w_out[l]
        x = x + 0.5 * swiglu(rmsnorm(x, ffn2_norm[l]), ffn2_w_gate[l], ffn2_w_up[l], ffn2_w_down[l])
    return rmsnorm(x, final_norm)
```

```cpp
#include <hip/hip_runtime.h>
#include <cstdio>
#include <cstdint>

namespace pg8 {
#define PG8_LAS __attribute__((address_space(3)))
typedef unsigned short bf16_t;
typedef short bf16x8 __attribute__((ext_vector_type(8)));
typedef float f32x4 __attribute__((ext_vector_type(4)));
typedef unsigned u32x4 __attribute__((ext_vector_type(4)));
typedef unsigned u32x2 __attribute__((ext_vector_type(2)));
constexpr int BM = 256, BK = 64, HALF = 128, HTB = HALF * BK * 2  , STAGE_BYTES = 8 * HTB, NXCD = 8, WGM = 8;

__host__ __device__ __forceinline__ int lds_byte(int r, int c) { const int st = (r >> 4) * 2 + (c >> 5), rr = r & 15, cc = c & 31, ob = rr * 64 + cc * 2; return st * 1024 + (ob ^ (((ob >> 9) & 1) << 5)); }
__host__ __device__ __forceinline__ void stage_rc(int b, int& R, int& C) { const int st = b / 1024, sb = b % 1024, swz = sb ^ (((sb >> 9) & 1) << 5); R = (st >> 1) * 16 + swz / 64; C = (st & 1) * 32 + (swz % 64) / 2; }
__host__ __device__ __forceinline__ int perm32(int rho) { const int n = rho >> 4, i = rho & 15; return 8 * (i >> 2) + 4 * n + (i & 3); }

struct Unit { int pm, pn; };
struct Gemm { const bf16_t* A; const bf16_t* Bt; int M, N, K; };

struct StaticOrder {
    int nM, nN, nwg, G, c;
    __host__ __device__ void init(int M, int N, int G_, int c_) { nM = M / BM; nN = N / BM; nwg = nM * nN; G = G_; c = c_; }
    __host__ __device__ bool next(int i, Unit& u) const {
        const long L = (long)i * G + c; if (L >= nwg) return false;
        int wgid = (int)L; { const int q = nwg / NXCD, r = nwg % NXCD, xcd = wgid % NXCD, off = wgid / NXCD; wgid = (xcd < r ? xcd * (q + 1) : r * (q + 1) + (xcd - r) * q) + off; }
        const int nig = WGM * nN, gid = wgid / nig, fm = gid * WGM, gsz = (nM - fm) < WGM ? (nM - fm) : WGM;
        u.pm = fm + ((wgid % nig) % gsz); u.pn = (wgid % nig) / gsz; return true;
    }
    __device__ __forceinline__ void a_ready(const Unit&) const {}
    __device__ __forceinline__ void done(const Unit&) const {}
};

__device__ __forceinline__ unsigned cvt_pk_bf16(float lo, float hi) { unsigned r; asm volatile("v_cvt_pk_bf16_f32 %0, %1, %2" : "=v"(r) : "v"(lo), "v"(hi)); return r; }
__device__ __forceinline__ float bflo(unsigned w) { return __uint_as_float(w << 16); }
__device__ __forceinline__ float bfhi(unsigned w) { return __uint_as_float(w & 0xffff0000u); }
struct NoHook { static constexpr bool ON = false; static constexpr int T1 = -1, T2 = -1;
    __device__ __forceinline__ void apply(f32x4 (&)[2][2][4][2], const Unit&, int, int, int, int, int) const {} };

__device__ __forceinline__ float row_rstd(const float* ssq, int row) {
    const f32x4 a = *(const f32x4*)(ssq + (size_t)row * 8), b = *(const f32x4*)(ssq + (size_t)row * 8 + 4);
    const float s = ((a[0] + a[1]) + (a[2] + a[3])) + ((b[0] + b[1]) + (b[2] + b[3]));
    return 1.0f / sqrtf(s * (1.0f / 2048.0f) + 1e-6f);
}
__device__ __forceinline__ float fast_sigmoid(float v) { return __builtin_amdgcn_rcpf(1.0f + __builtin_amdgcn_exp2f(-1.4426950408889634f * v)); }

struct EpiSwiGLU { static constexpr bool PERM = true, AFTER_DRAIN = false;
    bf16_t* H; const float* ssq; int ldh;
    __device__ __forceinline__ void operator()(const f32x4 (&acc)[2][2][4][2], const Unit& u, int wr, int wc, int fr, int fq, int, int) const {
        const int row0 = u.pm * BM + wr * 64 + fr, col0 = u.pn * 128 + wc * 32 + 8 * fq;
#pragma unroll
        for (int ai = 0; ai < 2; ++ai)
#pragma unroll
            for (int m = 0; m < 4; ++m) { const int row = row0 + ai * HALF + m * 16; const float rs = row_rstd(ssq, row);
                float hv[8];
#pragma unroll
                for (int n = 0; n < 2; ++n)
#pragma unroll
                    for (int e = 0; e < 4; ++e) { const float gv = acc[ai][0][m][n][e] * rs, uv = acc[ai][1][m][n][e] * rs; hv[n * 4 + e] = gv * fast_sigmoid(gv) * uv; }
                u32x4 w; w.x = cvt_pk_bf16(hv[0], hv[1]); w.y = cvt_pk_bf16(hv[2], hv[3]); w.z = cvt_pk_bf16(hv[4], hv[5]); w.w = cvt_pk_bf16(hv[6], hv[7]);
                *(u32x4*)(H + (size_t)row * ldh + col0) = w; }
    }
};
struct EpiResid { static constexpr bool PERM = false, AFTER_DRAIN = false;
    float* X; bf16_t* XB; float* ssq; float scale; PG8_LAS float* scr;
    __device__ __forceinline__ void operator()(const f32x4 (&acc)[2][2][4][2], const Unit& u, int wr, int wc, int fr, int fq, int wid, int lane) const {
        const int row0 = u.pm * BM + wr * 64 + fr, col0 = u.pn * BM + wc * 32 + 4 * fq;
#pragma unroll
        for (int ai = 0; ai < 2; ++ai)
#pragma unroll
            for (int m = 0; m < 4; ++m) { const int rl = ai * HALF + wr * 64 + m * 16 + fr; const size_t off0 = (size_t)(u.pm * BM + rl) * 2048 + col0; float q = 0.f;
#pragma unroll
                for (int bj = 0; bj < 2; ++bj)
#pragma unroll
                    for (int n = 0; n < 2; ++n) { const size_t off = off0 + bj * HALF + n * 16; const f32x4 xo = *(const f32x4*)(X + off); const f32x4 xn = xo + acc[ai][bj][m][n] * scale;
                        *(f32x4*)(X + off) = xn; u32x2 w; w.x = cvt_pk_bf16(xn[0], xn[1]); w.y = cvt_pk_bf16(xn[2], xn[3]); *(u32x2*)(XB + off) = w;
                        q += (xn[0] * xn[0] + xn[1] * xn[1]) + (xn[2] * xn[2] + xn[3] * xn[3]); }
                q += __shfl_xor(q, 16); q += __shfl_xor(q, 32);
                if (fq == 0) scr[rl * 4 + wc] = q; }
        (void)row0;
        asm volatile("s_waitcnt lgkmcnt(0)\n\ts_barrier" ::: "memory");
        const int tid = wid * 64 + lane;
        if (tid < 256) { const float s = (scr[tid * 4 + 0] + scr[tid * 4 + 1]) + (scr[tid * 4 + 2] + scr[tid * 4 + 3]); ssq[(size_t)(u.pm * BM + tid) * 8 + u.pn] = s; }
        asm volatile("s_waitcnt lgkmcnt(0)" ::: "memory");
    }
};
struct EpiScaleBf16 { static constexpr bool PERM = true, AFTER_DRAIN = false;
    bf16_t* O; int ldc; const float* ssq;
    __device__ __forceinline__ void operator()(const f32x4 (&acc)[2][2][4][2], const Unit& u, int wr, int wc, int fr, int fq, int, int) const {
        const int row0 = u.pm * BM + wr * 64 + fr, col0 = u.pn * BM + wc * 32 + 8 * fq;
#pragma unroll
        for (int ai = 0; ai < 2; ++ai)
#pragma unroll
            for (int m = 0; m < 4; ++m) { const int row = row0 + ai * HALF + m * 16; const float rs = row_rstd(ssq, row);
#pragma unroll
                for (int bj = 0; bj < 2; ++bj) { const f32x4 v0 = acc[ai][bj][m][0] * rs, v1 = acc[ai][bj][m][1] * rs;
                    u32x4 w; w.x = cvt_pk_bf16(v0[0], v0[1]); w.y = cvt_pk_bf16(v0[2], v0[3]); w.z = cvt_pk_bf16(v1[0], v1[1]); w.w = cvt_pk_bf16(v1[2], v1[3]);
                    *(u32x4*)(O + (size_t)row * ldc + col0 + bj * HALF) = w; } }
    }
};
struct EpiProj { static constexpr bool PERM = true, AFTER_DRAIN = false;
    const float* ssq; bf16_t *DQ, *DK, *DV, *NQ, *NKV, *MQ, *MG; int Mrows;
    __device__ __forceinline__ void operator()(const f32x4 (&acc)[2][2][4][2], const Unit& u, int wr, int wc, int fr, int fq, int, int) const {
        const int pn = u.pn; bf16_t* base; int ldc, c0; size_t bjs = HALF;
        if (pn < 4) { base = DQ; ldc = 1024; c0 = 256 * pn; }
        else if (pn < 8) { base = DK; ldc = 1024; c0 = 256 * (pn - 4); }
        else if (pn < 12) { base = DV; ldc = 1024; c0 = 256 * (pn - 8); }
        else if (pn < 16) { base = NQ; ldc = 1024; c0 = 256 * (pn - 12); }
        else if (pn < 22) { base = NKV + (size_t)(2 * (pn - 16)) * Mrows * 128; ldc = 128; c0 = 0; bjs = (size_t)Mrows * 128; }
        else if (pn < 24) { base = MQ; ldc = 512; c0 = 256 * (pn - 22); }
        else { base = MG; ldc = 6144; c0 = 256 * (pn - 24); }
        const int row0 = u.pm * BM + wr * 64 + fr, col0 = c0 + wc * 32 + 8 * fq;
#pragma unroll
        for (int ai = 0; ai < 2; ++ai)
#pragma unroll
            for (int m = 0; m < 4; ++m) { const int row = row0 + ai * HALF + m * 16; const float rs = row_rstd(ssq, row);
#pragma unroll
                for (int bj = 0; bj < 2; ++bj) { const f32x4 v0 = acc[ai][bj][m][0] * rs, v1 = acc[ai][bj][m][1] * rs;
                    u32x4 w; w.x = cvt_pk_bf16(v0[0], v0[1]); w.y = cvt_pk_bf16(v0[2], v0[3]); w.z = cvt_pk_bf16(v1[0], v1[1]); w.w = cvt_pk_bf16(v1[2], v1[3]);
                    *(u32x4*)(base + bj * bjs + (size_t)row * ldc + col0) = w; } }
    }
};
struct MergeGate { static constexpr bool ON = true; static constexpr int T1 = 16, T2 = 32;
    const bf16_t* MG;
    __device__ __forceinline__ void apply(f32x4 (&acc)[2][2][4][2], const Unit& u, int wr, int wc, int fr, int fq, int which) const {
        int row0 = u.pm * BM + wr * 64 + fr, col0 = u.pn * BM + wc * 32 + 8 * fq; asm volatile("" : "+v"(row0), "+v"(col0));
#pragma unroll
        for (int ai = 0; ai < 2; ++ai)
#pragma unroll
            for (int m = 0; m < 4; ++m) { const bf16_t* gp = MG + (size_t)(row0 + ai * HALF + m * 16) * 6144 + col0;
#pragma unroll
                for (int bj = 0; bj < 2; ++bj) {
                    const u32x4 wa = *(const u32x4*)(gp + which * 2048 + bj * HALF);
                    float ea[8];
#pragma unroll
                    for (int e = 0; e < 4; ++e) { ea[2 * e] = bflo(wa[e]); ea[2 * e + 1] = bfhi(wa[e]); }
#pragma unroll
                    for (int e = 0; e < 8; ++e) ea[e] = 1.0f + __builtin_amdgcn_exp2f(-1.4426950408889634f * fminf(fmaxf(ea[e], -30.f), 30.f));
                    float f[8];
                    if (which < 2) { const u32x4 wb = *(const u32x4*)(gp + (which + 1) * 2048 + bj * HALF); float eb[8];
#pragma unroll
                        for (int e = 0; e < 4; ++e) { eb[2 * e] = bflo(wb[e]); eb[2 * e + 1] = bfhi(wb[e]); }
#pragma unroll
                        for (int e = 0; e < 8; ++e) { eb[e] = 1.0f + __builtin_amdgcn_exp2f(-1.4426950408889634f * fminf(fmaxf(eb[e], -30.f), 30.f)); f[e] = eb[e] / ea[e]; } }
                    else {
#pragma unroll
                        for (int e = 0; e < 8; ++e) f[e] = 1.0f / ea[e]; }
#pragma unroll
                    for (int e = 0; e < 4; ++e) { acc[ai][bj][m][0][e] *= f[e]; acc[ai][bj][m][1][e] *= f[4 + e]; }
                    asm volatile("" ::: "memory"); } }
    }
};
struct EpiMerge { static constexpr bool PERM = true, AFTER_DRAIN = false;
    bf16_t* O; MergeGate G;
    __device__ __forceinline__ void operator()(const f32x4 (&acc_in)[2][2][4][2], const Unit& u, int wr, int wc, int fr, int fq, int, int) const {
        int row0 = u.pm * BM + wr * 64 + fr, col0 = u.pn * BM + wc * 32 + 8 * fq; asm volatile("" : "+v"(row0), "+v"(col0));
#pragma unroll
        for (int ai = 0; ai < 2; ++ai)
#pragma unroll
            for (int m = 0; m < 4; ++m) { const int row = row0 + ai * HALF + m * 16; const bf16_t* gp = G.MG + (size_t)row * 6144 + 2 * 2048 + col0;
#pragma unroll
                for (int bj = 0; bj < 2; ++bj) { const u32x4 wa = *(const u32x4*)(gp + bj * HALF); float g[8];
#pragma unroll
                    for (int e = 0; e < 4; ++e) { g[2 * e] = bflo(wa[e]); g[2 * e + 1] = bfhi(wa[e]); }
#pragma unroll
                    for (int e = 0; e < 8; ++e) g[e] = 1.0f / (1.0f + __builtin_amdgcn_exp2f(-1.4426950408889634f * fminf(fmaxf(g[e], -30.f), 30.f)));
                    const f32x4 a0 = acc_in[ai][bj][m][0], a1 = acc_in[ai][bj][m][1];
                    u32x4 w; w.x = cvt_pk_bf16(a0[0] * g[0], a0[1] * g[1]); w.y = cvt_pk_bf16(a0[2] * g[2], a0[3] * g[3]); w.z = cvt_pk_bf16(a1[0] * g[4], a1[1] * g[5]); w.w = cvt_pk_bf16(a1[2] * g[6], a1[3] * g[7]);
                    *(u32x4*)(O + (size_t)row * 2048 + col0 + bj * HALF) = w; } }
    }
};

template <class Epi, class Sched, class Hook, bool ALIGN_EPI = false, bool SP2 = false>
__device__ __forceinline__ void gemm_phase(PG8_LAS unsigned char* lds, const Gemm g, const Sched& S, const Epi& E, const Hook& Hk) {
    int tid_ = threadIdx.x; asm volatile("" : "+v"(tid_));
    const int tid = tid_, wid = __builtin_amdgcn_readfirstlane(tid >> 6), lane = tid & 63, wr = wid >> 2, wc = wid & 3, fr = lane & 15, fq = lane >> 4;
    const int K = g.K, nt = K / BK;
    unsigned voffA[2], voffB[2];
#pragma unroll
    for (int i = 0; i < 2; ++i) { int R, C; stage_rc(tid * 16 + i * 8192, R, C); const int Rb = Epi::PERM ? ((R & ~31) + perm32(R & 31)) : R;
        voffA[i] = (unsigned)(R * K + C) * 2u; voffB[i] = (unsigned)(Rb * K + C) * 2u; }
    const size_t kstep = (size_t)(BK * 2);
    const size_t hstep = (size_t)HALF * K * 2;
    const size_t tstep = 2 * hstep;
    const unsigned ldsw = (unsigned)wid * 1024u;
    const int aoff = lds_byte(wr * 64 + fr, fq * 8), boff = lds_byte(wc * 32 + fr, fq * 8);
#define PG8_SA(b, h) (((b) * 2 + (h)) * HTB)
#define PG8_SB(b, h) ((4 + (b) * 2 + (h)) * HTB)
#define PG8_STAGE(bufoff, gbase, voff) do { _Pragma("unroll") for (int _i = 0; _i < 2; ++_i) \
        __builtin_amdgcn_global_load_lds((const unsigned*)((const char*)(gbase) + (voff)[_i]), (PG8_LAS unsigned*)(lds + (bufoff) + ldsw + _i * 8192), 16, 0, 0); } while (0)
#define PG8_LDA(dst, b, h) do { _Pragma("unroll") for (int m = 0; m < 4; ++m) _Pragma("unroll") for (int k = 0; k < 2; ++k) dst[m][k] = *(const PG8_LAS bf16x8*)(lds + PG8_SA(b, h) + aoff + m * 2048 + k * 1024); } while (0)
#define PG8_LDB(dst, b, h) do { _Pragma("unroll") for (int n = 0; n < 2; ++n) _Pragma("unroll") for (int k = 0; k < 2; ++k) dst[n][k] = *(const PG8_LAS bf16x8*)(lds + PG8_SB(b, h) + boff + n * 2048 + k * 1024); } while (0)
#define PG8_MMA(ai, bj, At, Bt) do { __builtin_amdgcn_s_setprio(1); _Pragma("unroll") for (int m = 0; m < 4; ++m) _Pragma("unroll") for (int n = 0; n < 2; ++n) _Pragma("unroll") for (int k = 0; k < 2; ++k) \
        acc[ai][bj][m][n] = __builtin_amdgcn_mfma_f32_16x16x32_bf16(Bt[n][k], At[m][k], acc[ai][bj][m][n], 0, 0, 0); __builtin_amdgcn_s_setprio(0); } while (0)
#define PG8_WAIT_V(n) asm volatile("s_waitcnt vmcnt(" #n ")" ::: "memory")
#define PG8_WAIT_L(n) asm volatile("s_waitcnt lgkmcnt(" #n ")" ::: "memory")
#define PG8_BAR __builtin_amdgcn_s_barrier()
#define PG8_SCHED __builtin_amdgcn_sched_barrier(0)
    Unit cur, nxt; int ui = 0;
    if (!S.next(0, cur)) return;
    f32x4 acc[2][2][4][2];
#pragma unroll
    for (int a = 0; a < 2; ++a)
#pragma unroll
        for (int b = 0; b < 2; ++b)
#pragma unroll
            for (int m = 0; m < 4; ++m)
#pragma unroll
                for (int n = 0; n < 2; ++n) acc[a][b][m][n] = (f32x4){0.f, 0.f, 0.f, 0.f};
    bf16x8 At[4][2], B0[2][2], B1[2][2];
    const char* cA = (const char*)g.A + (size_t)cur.pm * tstep; const char* cB = (const char*)g.Bt + (size_t)cur.pn * tstep;
    S.a_ready(cur);
    if constexpr (SP2) {
        PG8_STAGE(PG8_SB(0, 0), cB, voffB); PG8_STAGE(PG8_SB(0, 1), cB + hstep, voffB); PG8_STAGE(PG8_SA(0, 0), cA, voffA); PG8_STAGE(PG8_SA(0, 1), cA + hstep, voffA);
        if (wr == 1) PG8_BAR;
        PG8_WAIT_V(2); PG8_BAR;
        PG8_STAGE(PG8_SB(1, 0), cB + kstep, voffB); PG8_STAGE(PG8_SA(1, 0), cA + kstep, voffA); PG8_STAGE(PG8_SB(1, 1), cB + hstep + kstep, voffB);
        PG8_WAIT_V(6); PG8_BAR;
    } else {
        PG8_STAGE(PG8_SB(0, 0), cB, voffB); PG8_STAGE(PG8_SA(0, 0), cA, voffA); PG8_STAGE(PG8_SB(0, 1), cB + hstep, voffB); PG8_STAGE(PG8_SA(0, 1), cA + hstep, voffA);
        if (wr == 1) PG8_BAR;
        PG8_WAIT_V(4); PG8_BAR;
        PG8_STAGE(PG8_SB(1, 0), cB + kstep, voffB); PG8_STAGE(PG8_SA(1, 0), cA + kstep, voffA); PG8_STAGE(PG8_SB(1, 1), cB + hstep + kstep, voffB);
        PG8_WAIT_V(6); PG8_BAR;
    }
    for (;;) {
        const bool has_next = S.next(ui + 1, nxt);
        const char* nA = has_next ? (const char*)g.A + (size_t)nxt.pm * tstep : cA; const char* nB = has_next ? (const char*)g.Bt + (size_t)nxt.pn * tstep : cB;
#pragma unroll
        for (int seg = 0; seg < (Hook::ON ? 3 : 1); ++seg) {
        const int tb = Hook::ON ? (seg == 0 ? 0 : (seg == 1 ? Hook::T1 : Hook::T2)) : 0, te = Hook::ON ? (seg == 0 ? Hook::T1 : (seg == 1 ? Hook::T2 : nt)) : nt;
        if constexpr (Hook::ON) { if (seg > 0) Hk.apply(acc, cur, wr, wc, fr, fq, seg - 1); }
        for (int t = tb; t < te; t += 2) {
            const bool last = (t == nt - 2);
            const char* a1 = cA + (size_t)(t + 1) * kstep;
            const char* a2 = last ? nA : cA + (size_t)(t + 2) * kstep; const char* b2 = last ? nB : cB + (size_t)(t + 2) * kstep;
            const char* a3 = a2 + kstep; const char* b3 = b2 + kstep;
            if (last && has_next) S.a_ready(nxt);
            if constexpr (SP2) {
            PG8_LDB(B0, 0, 0); PG8_LDB(B1, 0, 1); PG8_SCHED; PG8_LDA(At, 0, 0); PG8_STAGE(PG8_SA(1, 1), a1 + hstep, voffA);
            PG8_WAIT_V(8); PG8_WAIT_L(0); PG8_BAR; PG8_MMA(0, 0, At, B0); PG8_MMA(0, 1, At, B1); PG8_BAR; PG8_SCHED;
            PG8_LDA(At, 0, 1); PG8_STAGE(PG8_SB(0, 0), b2, voffB); PG8_STAGE(PG8_SB(0, 1), b2 + hstep, voffB); PG8_STAGE(PG8_SA(0, 0), a2, voffA);
            PG8_WAIT_V(8); PG8_WAIT_L(0); PG8_BAR; PG8_MMA(1, 0, At, B0); PG8_MMA(1, 1, At, B1); PG8_BAR; PG8_SCHED;
            PG8_LDB(B0, 1, 0); PG8_LDB(B1, 1, 1); PG8_SCHED; PG8_LDA(At, 1, 0); PG8_STAGE(PG8_SA(0, 1), a2 + hstep, voffA);
            PG8_WAIT_V(8); PG8_WAIT_L(0); PG8_BAR; PG8_MMA(0, 0, At, B0); PG8_MMA(0, 1, At, B1); PG8_BAR; PG8_SCHED;
            PG8_LDA(At, 1, 1); PG8_STAGE(PG8_SB(1, 0), b3, voffB); PG8_STAGE(PG8_SB(1, 1), b3 + hstep, voffB); PG8_STAGE(PG8_SA(1, 0), a3, voffA);
            PG8_WAIT_V(8); PG8_WAIT_L(0); PG8_BAR; PG8_MMA(1, 0, At, B0); PG8_MMA(1, 1, At, B1); PG8_BAR; PG8_SCHED;
            } else {
            PG8_LDB(B0, 0, 0); PG8_SCHED; PG8_LDA(At, 0, 0); PG8_STAGE(PG8_SA(1, 1), a1 + hstep, voffA);
            PG8_WAIT_L(8); PG8_BAR; PG8_WAIT_L(0); PG8_MMA(0, 0, At, B0); PG8_BAR; PG8_SCHED;
            PG8_LDB(B1, 0, 1); PG8_STAGE(PG8_SB(0, 0), b2, voffB);
            PG8_BAR; PG8_WAIT_L(0); PG8_MMA(0, 1, At, B1); PG8_BAR;
            PG8_LDA(At, 0, 1); PG8_STAGE(PG8_SA(0, 0), a2, voffA);
            PG8_BAR; PG8_WAIT_L(0); PG8_MMA(1, 0, At, B0); PG8_BAR; PG8_SCHED;
            PG8_STAGE(PG8_SB(0, 1), b2 + hstep, voffB);
            PG8_WAIT_V(6); PG8_BAR; PG8_MMA(1, 1, At, B1); PG8_BAR;
            PG8_LDB(B0, 1, 0); PG8_SCHED; PG8_LDA(At, 1, 0); PG8_STAGE(PG8_SA(0, 1), a2 + hstep, voffA);
            PG8_WAIT_L(8); PG8_BAR; PG8_WAIT_L(0); PG8_MMA(0, 0, At, B0); PG8_BAR; PG8_SCHED;
            PG8_LDB(B1, 1, 1); PG8_STAGE(PG8_SB(1, 0), b3, voffB);
            PG8_BAR; PG8_WAIT_L(0); PG8_MMA(0, 1, At, B1); PG8_BAR;
            PG8_LDA(At, 1, 1); PG8_STAGE(PG8_SA(1, 0), a3, voffA);
            PG8_BAR; PG8_WAIT_L(0); PG8_MMA(1, 0, At, B0); PG8_BAR; PG8_SCHED;
            PG8_STAGE(PG8_SB(1, 1), b3 + hstep, voffB);
            PG8_WAIT_V(6); PG8_BAR; PG8_MMA(1, 1, At, B1); PG8_BAR;
            }
        }
        }
        if constexpr (ALIGN_EPI) { if (wr == 0) PG8_BAR; }
        if constexpr (!Epi::AFTER_DRAIN) { E(acc, cur, wr, wc, fr, fq, wid, lane); S.done(cur); }
        if (!has_next) break;
#pragma unroll
        for (int a = 0; a < 2; ++a)
#pragma unroll
            for (int b = 0; b < 2; ++b)
#pragma unroll
                for (int m = 0; m < 4; ++m)
#pragma unroll
                    for (int n = 0; n < 2; ++n) acc[a][b][m][n] = (f32x4){0.f, 0.f, 0.f, 0.f};
        cur = nxt; cA = nA; cB = nB; ++ui;
        if constexpr (ALIGN_EPI) { if (wr == 1) PG8_BAR; }
    }
    PG8_WAIT_V(0);
    if constexpr (!ALIGN_EPI) { if (wr == 0) PG8_BAR; }
    PG8_BAR;
    if constexpr (Epi::AFTER_DRAIN) { E.fused(acc, cur, wr, wc, fr, fq, lds, wid, lane); S.done(cur); }
#undef PG8_SA
#undef PG8_SB
#undef PG8_STAGE
#undef PG8_LDA
#undef PG8_LDB
#undef PG8_MMA
#undef PG8_WAIT_V
#undef PG8_WAIT_L
#undef PG8_BAR
#undef PG8_SCHED
}
}

constexpr int NWAVES = 8, NTHREADS = 512;
constexpr int BATCH = 2, SEQ = 4096, DM = 2048, DFF = 5632, DEPTH = 4, MROWS = BATCH * SEQ;
constexpr int MEM_LEN = 256, MEMROWS = BATCH * MEM_LEN;
constexpr int IN_COLS = 12312, PROJ_N = 12288, NG_COL0 = 5632;
constexpr int NCMP = 255;
constexpr float NORM_EPS = 1e-6f;
enum { I_X = 0, I_MEM, I_F1N, I_F1G, I_F1U, I_F1D, I_MIXN, I_WIN, I_LAM, I_SUBLN, I_CPOS, I_CW1, I_CW2, I_MEMN, I_WMKV, I_WUD, I_WUN, I_WUM, I_WO, I_F2N, I_F2G, I_F2U, I_F2D, I_FINN, N_IN };

constexpr size_t MiB = 1u << 20;
constexpr size_t WS_CTL = 0, CTL_ZERO_BYTES = 1 * MiB;
constexpr size_t WS_WL = 2 * MiB, WL_STRIDE = 202 * MiB;
constexpr size_t WL_GU1 = 0, WL_D1 = 44 * MiB, WL_IN = 66 * MiB, WL_NG = 114 * MiB, WL_C1 = 115 * MiB, WL_C2 = 117 * MiB, WL_UP = 118 * MiB, WL_O = 128 * MiB, WL_GU2 = 136 * MiB, WL_D2 = 180 * MiB;
constexpr size_t WS_WMKV = WS_WL + DEPTH * WL_STRIDE;
constexpr size_t WS_X = WS_WMKV + 16 * MiB;
constexpr size_t WS_XB = WS_X + 64 * MiB;
constexpr size_t WS_SSQ = WS_XB + 32 * MiB;
constexpr size_t WS_H = WS_SSQ + 1 * MiB;
constexpr size_t WS_DQ = WS_H + 88 * MiB, WS_DK = WS_DQ + 16 * MiB, WS_DV = WS_DK + 16 * MiB, WS_NQ = WS_DV + 16 * MiB;
constexpr size_t WS_NKV = WS_NQ + 16 * MiB;
constexpr size_t WS_MQ = WS_NKV + 24 * MiB;
constexpr size_t WS_MG = WS_MQ + 8 * MiB;
constexpr size_t WS_NG = WS_MG + 96 * MiB;
constexpr size_t WS_KCMP = WS_NG + 1 * MiB;
constexpr size_t WS_HC = WS_KCMP + 1 * MiB;
constexpr size_t WS_MEMB = WS_HC + 1 * MiB;
constexpr size_t WS_MEMSSQ = WS_MEMB + 2 * MiB;
constexpr size_t WS_MEMKV = WS_MEMSSQ + 1 * MiB;
constexpr size_t WS_ACAT = WS_MEMKV + 4 * MiB;
constexpr size_t WS_MERGED = WS_ACAT + 40 * MiB;
constexpr size_t WS_MISC = WS_MERGED + 32 * MiB;
constexpr size_t WS_END = WS_MISC + 1 * MiB;
constexpr int CW_BAR = 4096;

constexpr int RING_OFF = 0, RING_BYTES = 131072;
constexpr int EPI_OFF = RING_BYTES, EPI_BYTES = 4096;
constexpr int LDSCTL_OFF = EPI_OFF + EPI_BYTES, MISC_OFF = LDSCTL_OFF + 320;
constexpr int LDS_BYTES = 147456;

#define GAS __attribute__((address_space(1)))
#define LAS __attribute__((address_space(3)))
typedef unsigned short bf16;
typedef unsigned v4u __attribute__((ext_vector_type(4)));
typedef float f32x4 __attribute__((ext_vector_type(4)));
typedef short bf16x8 __attribute__((ext_vector_type(8)));
typedef GAS unsigned gu32;
typedef GAS unsigned long long gu64;
#define RLX_AGENT __ATOMIC_RELAXED, __HIP_MEMORY_SCOPE_AGENT
#define LDS_WAIT() asm volatile("s_waitcnt lgkmcnt(0)" ::: "memory")
#define VM_WAIT() asm volatile("s_waitcnt vmcnt(0)" ::: "memory")
__device__ __forceinline__ unsigned long long rt() { return __builtin_amdgcn_s_memrealtime(); }
__device__ __forceinline__ unsigned f2bf(float f) { unsigned u = __builtin_bit_cast(unsigned, f); return (u + 0x7fffu + ((u >> 16) & 1u)) >> 16; }
__device__ __forceinline__ unsigned pk2(float lo, float hi) { return f2bf(lo) | (f2bf(hi) << 16); }

#define XB_TMO      128
#define XB_XCNT(j)  (256  + 64 * (j))
#define XB_XSUB(j)  (1280 + 64 * (j))
#define XB_XGEN(j)  (2304 + 64 * (j))
#define XB_TOP      3328
#define XB_TOPGEN   3392
#define XCD_BAR_WORDS 3456
#define XB_SPIN_CAP (1u << 18)

__device__ __forceinline__ unsigned xb_ld(unsigned* p)              { return __hip_atomic_load(p, __ATOMIC_RELAXED, __HIP_MEMORY_SCOPE_AGENT); }
__device__ __forceinline__ unsigned xb_add(unsigned* p, unsigned v) { return __hip_atomic_fetch_add(p, v, __ATOMIC_RELAXED, __HIP_MEMORY_SCOPE_AGENT); }
__device__ __forceinline__ unsigned xb_xcc_id() { return (unsigned)__builtin_amdgcn_s_getreg((3 << 11) | 20) & 0xFu; }
#define XB_SPIN(cond, bar) do { unsigned _sp = 0; while (cond) { __builtin_amdgcn_s_sleep(1); \
    if ((++_sp & 255u) == 0u) { if (xb_ld(&(bar)[XB_TMO])) break; if (_sp > XB_SPIN_CAP) { atomicAdd(&(bar)[XB_TMO], 1u); break; } } } } while (0)

struct XcdBarrier {
    unsigned* bar; unsigned x;
    volatile LAS unsigned* st;
};

__device__ __forceinline__ XcdBarrier xcd_barrier_post(unsigned* bar, volatile LAS unsigned* st) {
    XcdBarrier b; b.bar = bar; b.x = xb_xcc_id(); b.st = st;
    if (threadIdx.x == 0) (void)xb_add(&bar[XB_XCNT(b.x)], 1u);
    return b;
}
__device__ __forceinline__ void xcd_barrier_complete(unsigned* bar, unsigned x, unsigned& nloc, unsigned& nx) {
    const unsigned G = gridDim.x * gridDim.y * gridDim.z;
    unsigned sum, cnt, mine, sp = 0u;
    for (;;) {
        sum = 0u; cnt = 0u; mine = 0u;
#pragma unroll
        for (unsigned j = 0; j < 16; ++j) { const unsigned c = xb_ld(&bar[XB_XCNT(j)]); sum += c; cnt += (c > 0u) ? 1u : 0u; mine = (j == x) ? c : mine; }
        if (sum == G) break;
        __builtin_amdgcn_s_sleep(1);
        if ((++sp & 255u) == 0u) { if (xb_ld(&bar[XB_TMO])) break; if (sp > XB_SPIN_CAP) { atomicAdd(&bar[XB_TMO], 1u); break; } }
    }
    nloc = mine > 0u ? mine : 1u; nx = cnt > 0u ? cnt : 1u;
}

__device__ __forceinline__ void xcd_barrier(const XcdBarrier& b) {
    asm volatile("s_waitcnt vmcnt(0)" ::: "memory");
    __syncthreads();
    if (threadIdx.x == 0) {
        unsigned* bar = b.bar;
        __builtin_amdgcn_s_waitcnt(0);
        unsigned nloc = b.st[0], nx = b.st[1];
        if (nloc == 0u) { xcd_barrier_complete(bar, b.x, nloc, nx); b.st[0] = nloc; b.st[1] = nx; }
        const unsigned old = xb_add(&bar[XB_XSUB(b.x)], 1u);
        const unsigned gen = old / nloc;
        if (old + 1u == (gen + 1u) * nloc) {
            __builtin_amdgcn_fence(__ATOMIC_RELEASE, "agent");
            asm volatile("s_waitcnt vmcnt(0)" ::: "memory");
            const unsigned og = xb_add(&bar[XB_TOP], 1u);
            const unsigned tg = og / nx;
            if (og + 1u == (tg + 1u) * nx) xb_add(&bar[XB_TOPGEN], 1u);
            else XB_SPIN(xb_ld(&bar[XB_TOPGEN]) == tg, bar);
            __builtin_amdgcn_fence(__ATOMIC_ACQUIRE, "agent");
            xb_add(&bar[XB_XGEN(b.x)], 1u);
            asm volatile("s_waitcnt vmcnt(0)" ::: "memory");
        } else {
            XB_SPIN(xb_ld(&bar[XB_XGEN(b.x)]) == gen, bar);
            __builtin_amdgcn_fence(__ATOMIC_ACQUIRE, "agent");
            asm volatile("s_waitcnt vmcnt(0)" ::: "memory");
        }
    }
    __syncthreads();
}

__device__ __forceinline__ float wave_sum(float v) {
#pragma unroll
    for (int o = 1; o < 64; o <<= 1) v += __shfl_xor(v, o);
    return v;
}
__device__ __forceinline__ float bf2f(unsigned short u) { return __uint_as_float(((unsigned)u) << 16); }
__device__ __forceinline__ float blo(unsigned w) { return __uint_as_float(w << 16); }
__device__ __forceinline__ float bhi(unsigned w) { return __uint_as_float(w & 0xffff0000u); }
__device__ __forceinline__ float gelu_tanh(float v) { const float u = 0.7978845608028654f * (v + 0.044715f * v * v * v); return 0.5f * v * (1.0f + tanhf(u)); }

__device__ __forceinline__ void cvt_item(const float* W, size_t ldw, int k0, int c0, int ncv, const float* scale,
                                         bf16* WT, size_t ldt, int r0, int kd0, LAS float* scr, int lane) {
#pragma unroll 8
    for (int i = 0; i < 32; ++i) { const int kk = 2 * i + (lane >> 5), n = lane & 31;
        float v = (n < ncv) ? W[(size_t)(k0 + kk) * ldw + c0 + n] : 0.f; if (scale) v *= scale[k0 + kk]; scr[kk * 33 + n] = v; }
    LDS_WAIT(); asm volatile("" ::: "memory");
    const int c = lane & 7;
#pragma unroll
    for (int j = 0; j < 4; ++j) { const int n = (lane >> 3) + 8 * j; const LAS float* s = scr + (8 * c) * 33 + n;
        v4u o; o.x = pk2(s[0 * 33], s[1 * 33]); o.y = pk2(s[2 * 33], s[3 * 33]); o.z = pk2(s[4 * 33], s[5 * 33]); o.w = pk2(s[6 * 33], s[7 * 33]);
        *(GAS v4u*)(WT + (size_t)(r0 + n) * ldt + kd0 + k0 + 8 * c) = o; }
    LDS_WAIT(); asm volatile("" ::: "memory");
}
__device__ __forceinline__ void cvt_job(const float* W, int K, int ldw, int nblk, const float* scale, bf16* WT, size_t ldt, int kd0, int mode, LAS float* scr, int gw, int NGW, int lane) {
    const int nit = (K / 64) * nblk;
    for (int it = gw; it < nit; it += NGW) {
        const int kb = it / nblk, nb = it % nblk, n0 = 32 * nb; int c0 = n0, r0 = n0, ncv = 32;
        if (mode == 1) r0 = 256 * (n0 >> 7) + (n0 & 127);
        else if (mode == 2) r0 = 256 * (n0 >> 7) + 128 + (n0 & 127);
        else if (mode == 3) c0 = (n0 < NG_COL0) ? n0 : n0 + 24;
        else if (mode == 4) { c0 = NG_COL0; ncv = 24; }
        cvt_item(W, (size_t)ldw, 64 * kb, c0, ncv, scale, WT, ldt, r0, kd0, scr, lane);
    }
}

template <int N> __device__ __forceinline__ void q_load(float (&qv)[N], const bf16* qp) {
#pragma unroll
    for (int i = 0; i < N / 8; ++i) { const v4u w = *(const v4u*)(qp + 8 * i);
#pragma unroll
        for (int e = 0; e < 4; ++e) { qv[8 * i + 2 * e] = blo(w[e]); qv[8 * i + 2 * e + 1] = bhi(w[e]); } }
}
template <int N> __device__ __forceinline__ float q_dot(const float (&qv)[N], const bf16* kp) {
    float s = 0.f;
#pragma unroll
    for (int i = 0; i < N / 8; ++i) { const v4u w = *(const v4u*)(kp + 8 * i);
#pragma unroll
        for (int e = 0; e < 4; ++e) { s += qv[8 * i + 2 * e] * blo(w[e]); s += qv[8 * i + 2 * e + 1] * bhi(w[e]); } }
    s += __shfl_xor(s, 1); s += __shfl_xor(s, 2); return s;
}
__device__ __forceinline__ void o_axpy(float (&o)[32], float a, float p, const bf16* vp) {
#pragma unroll
    for (int i = 0; i < 4; ++i) { const v4u w = *(const v4u*)(vp + 8 * i);
#pragma unroll
        for (int e = 0; e < 4; ++e) { o[8 * i + 2 * e] = o[8 * i + 2 * e] * a + p * blo(w[e]); o[8 * i + 2 * e + 1] = o[8 * i + 2 * e + 1] * a + p * bhi(w[e]); } }
}
__device__ __forceinline__ void osm_step(float s, const bf16* vp, float (&o)[32], float& m, float& l) {
    const float mn = fmaxf(m, s), a = __expf(m - mn), p = __expf(s - mn); l = l * a + p; o_axpy(o, a, p, vp); m = mn;
}

__device__ __forceinline__ void naive_diff(const bf16* DQ, const bf16* DK, const bf16* DV, bf16* ACAT, const float* subln, float lam, float lam_init, int gtid, int NT) {
    const int part = gtid & 3, nquads = NT >> 2;
    for (int qi0 = 0; qi0 < BATCH * 8 * SEQ; qi0 += nquads) {
        const int qi = qi0 + (gtid >> 2); if (qi >= BATCH * 8 * SEQ) break;
        int q = qi & (SEQ - 1); const int h = (qi >> 12) & 7, b = qi >> 15; if (b) q = SEQ - 1 - q;
        const size_t row = (size_t)b * SEQ + q; const float slope = exp2f(-(float)(h + 1));
        float res[32];
#pragma unroll
        for (int mp = 0; mp < 2; ++mp) {
            float qv[16]; q_load<16>(qv, DQ + row * 1024 + h * 128 + mp * 64 + part * 16);
            float o[32]; float m = -1e30f, l = 0.f;
#pragma unroll
            for (int i = 0; i < 32; ++i) o[i] = 0.f;
            for (int k = 0; k <= q; ++k) { const size_t kr = (size_t)b * SEQ + k;
                const float s = q_dot<16>(qv, DK + kr * 1024 + h * 128 + mp * 64 + part * 16) * 0.125f - slope * (float)(q - k);
                osm_step(s, DV + kr * 1024 + h * 128 + part * 32, o, m, l); }
            const float il = 1.0f / fmaxf(l, 1e-30f);
#pragma unroll
            for (int i = 0; i < 32; ++i) res[i] = (mp == 0) ? o[i] * il : res[i] - lam * o[i] * il;
        }
        float ss = 0.f;
#pragma unroll
        for (int i = 0; i < 32; ++i) ss += res[i] * res[i];
        ss += __shfl_xor(ss, 1); ss += __shfl_xor(ss, 2);
        const float rs = (1.0f / sqrtf(ss * (1.0f / 128.0f) + NORM_EPS)) * (1.0f - lam_init);
        bf16* op = ACAT + row * 2560 + h * 128 + part * 32;
#pragma unroll
        for (int i = 0; i < 4; ++i) { v4u w;
#pragma unroll
            for (int e = 0; e < 4; ++e) { const int d = 8 * i + 2 * e; w[e] = pk2(res[d] * rs * subln[part * 32 + d], res[d + 1] * rs * subln[part * 32 + d + 1]); }
            *(v4u*)(op + 8 * i) = w; }
    }
}
__device__ __forceinline__ void naive_mem(const bf16* MQ, const bf16* MKV, bf16* ACAT, int gtid, int NT) {
    const int part = gtid & 3, nquads = NT >> 2;
    for (int qi0 = 0; qi0 < BATCH * 4 * SEQ; qi0 += nquads) {
        const int qi = qi0 + (gtid >> 2); if (qi >= BATCH * 4 * SEQ) break;
        const int q = qi & (SEQ - 1), hm = (qi >> 12) & 3, b = qi >> 14; const size_t row = (size_t)b * SEQ + q;
        float qv[32]; q_load<32>(qv, MQ + row * 512 + hm * 128 + part * 32);
        float o[32]; float m = -1e30f, l = 0.f;
#pragma unroll
        for (int i = 0; i < 32; ++i) o[i] = 0.f;
        for (int k = 0; k < MEM_LEN; ++k) { const bf16* kr = MKV + (size_t)(b * MEM_LEN + k) * 4096 + hm * 128 + part * 32;
            const float s = q_dot<32>(qv, kr) * 0.08838834764831845f; osm_step(s, kr + 512, o, m, l); }
        const float il = 1.0f / fmaxf(l, 1e-30f);
        bf16* op = ACAT + row * 2560 + 2048 + hm * 128 + part * 32;
#pragma unroll
        for (int i = 0; i < 4; ++i) { v4u w;
#pragma unroll
            for (int e = 0; e < 4; ++e) { const int d = 8 * i + 2 * e; w[e] = pk2(o[d] * il, o[d + 1] * il); }
            *(v4u*)(op + 8 * i) = w; }
    }
}
__device__ __forceinline__ void naive_nsa(const bf16* NQ, const bf16* NKV, const bf16* KCMP, const float* NG, bf16* ACAT, LAS float* impbase, int tid, int gtid, int NT) {
    const int part = gtid & 3, nquads = NT >> 2; LAS float* imp = impbase + (tid >> 2) * 64;
    const float scale = 0.08838834764831845f;
    for (int qi0 = 0; qi0 < BATCH * 2 * SEQ; qi0 += nquads) {
        const int qi = qi0 + (gtid >> 2); if (qi >= BATCH * 2 * SEQ) break;
        const int q = qi & (SEQ - 1), g = (qi >> 12) & 1, b = qi >> 13; const size_t row = (size_t)b * SEQ + q;
        const int cmax = (q >= 31) ? ((q - 31) >> 4) : -1, cur = q >> 6;
        const bf16* kc = KCMP + ((size_t)((0 * BATCH + b) * 2 + g) * 256) * 128 + part * 32;
        const bf16* vc = KCMP + ((size_t)((1 * BATCH + b) * 2 + g) * 256) * 128 + part * 32;
        if (part == 0) for (int j = 0; j < 64; ++j) imp[j] = 0.f;
        for (int hh = 0; hh < 4; ++hh) {
            float qv[32]; q_load<32>(qv, NQ + row * 1024 + (g * 4 + hh) * 128 + part * 32);
            float m = -1e30f, l = 0.f;
            for (int c = 0; c <= cmax; ++c) { const float s = q_dot<32>(qv, kc + (size_t)c * 128) * scale; const float mn = fmaxf(m, s); l = l * __expf(m - mn) + __expf(s - mn); m = mn; }
            const float il = 1.0f / fmaxf(l, 1e-30f);
            for (int c = 0; c <= cmax; ++c) { const float s = q_dot<32>(qv, kc + (size_t)c * 128) * scale; const float p = __expf(s - m) * il;
                if (part == 0) { imp[c >> 2] += p; if ((c & 3) == 3 && ((c + 1) >> 2) < 64) imp[(c + 1) >> 2] += p; } }
        }
        unsigned sel_lo = 0u, sel_hi = 0u;
        if (part == 0) {
            unsigned long long sel = 0ull;
            for (int t = 0; t < 8; ++t) { float best = -3e38f; int bj = 0;
                for (int j = 0; j < 64; ++j) { if ((sel >> j) & 1ull) continue;
                    const float v = (j == 0 || j == cur || j == cur - 1) ? 1e9f : (j > cur ? -1e9f : imp[j]);
                    if (v > best) { best = v; bj = j; } }
                sel |= 1ull << bj; }
            sel_lo = (unsigned)sel; sel_hi = (unsigned)(sel >> 32);
        }
        sel_lo = __shfl(sel_lo, (int)((threadIdx.x & 63) & ~3)); sel_hi = __shfl(sel_hi, (int)((threadIdx.x & 63) & ~3));
        const unsigned long long sel = ((unsigned long long)sel_hi << 32) | sel_lo;
        for (int hh = 0; hh < 4; ++hh) {
            const int head = g * 4 + hh; const float slope = exp2f(-(float)(head + 1));
            float qv[32]; q_load<32>(qv, NQ + row * 1024 + head * 128 + part * 32);
            const float gc = NG[row * 24 + head * 3 + 0], gs = NG[row * 24 + head * 3 + 1], gw = NG[row * 24 + head * 3 + 2];
            float res[32], o[32]; float m = -1e30f, l = 0.f;
#pragma unroll
            for (int i = 0; i < 32; ++i) o[i] = 0.f;
            for (int c = 0; c <= cmax; ++c) { const float s = q_dot<32>(qv, kc + (size_t)c * 128) * scale; osm_step(s, vc + (size_t)c * 128, o, m, l); }
            { const float il = gc / fmaxf(l, 1e-30f);
#pragma unroll
              for (int i = 0; i < 32; ++i) res[i] = o[i] * il; }
            { const bf16* ks = NKV + ((size_t)(1 * 4 + 0 * 2 + g) * MROWS + (size_t)b * SEQ) * 128 + part * 32;
              const bf16* vs = NKV + ((size_t)(1 * 4 + 1 * 2 + g) * MROWS + (size_t)b * SEQ) * 128 + part * 32;
              m = -1e30f; l = 0.f;
#pragma unroll
              for (int i = 0; i < 32; ++i) o[i] = 0.f;
              for (int j = 0; j <= cur; ++j) { if (!((sel >> j) & 1ull)) continue;
                  for (int t = 0; t < 64; ++t) { const int k = 64 * j + t; if (k > q) break;
                      const float s = q_dot<32>(qv, ks + (size_t)k * 128) * scale - slope * (float)(q - k); osm_step(s, vs + (size_t)k * 128, o, m, l); } }
              const float il = gs / fmaxf(l, 1e-30f);
#pragma unroll
              for (int i = 0; i < 32; ++i) res[i] += o[i] * il; }
            { const bf16* kw = NKV + ((size_t)(2 * 4 + 0 * 2 + g) * MROWS + (size_t)b * SEQ) * 128 + part * 32;
              const bf16* vw = NKV + ((size_t)(2 * 4 + 1 * 2 + g) * MROWS + (size_t)b * SEQ) * 128 + part * 32;
              m = -1e30f; l = 0.f;
#pragma unroll
              for (int i = 0; i < 32; ++i) o[i] = 0.f;
              const int k0 = (q - 511) > 0 ? (q - 511) : 0;
              for (int k = k0; k <= q; ++k) { const float s = q_dot<32>(qv, kw + (size_t)k * 128) * scale - slope * (float)(q - k); osm_step(s, vw + (size_t)k * 128, o, m, l); }
              const float il = gw / fmaxf(l, 1e-30f);
#pragma unroll
              for (int i = 0; i < 32; ++i) res[i] += o[i] * il; }
            bf16* op = ACAT + row * 2560 + 1024 + head * 128 + part * 32;
#pragma unroll
            for (int i = 0; i < 4; ++i) { v4u w;
#pragma unroll
                for (int e = 0; e < 4; ++e) { const int d = 8 * i + 2 * e; w[e] = pk2(res[d], res[d + 1]); }
                *(v4u*)(op + 8 * i) = w; }
        }
    }
}
__device__ __forceinline__ void naive_cmp1(const bf16* NKV, const float* w1  , const float* bias1  , float* HC, int gtid, int NT) {
    for (int i = gtid; i < 2 * BATCH * 2 * 256 * 128; i += NT) {
        const int n = i & 127, c = (i >> 7) & 255, g = (i >> 15) & 1, b = (i >> 16) & 1, kv = i >> 17;
        float acc = 0.f;
        if (c < NCMP) { acc = bias1[kv * 128 + n];
            const bf16* a = NKV + ((size_t)(0 * 4 + kv * 2 + g) * MROWS + (size_t)b * SEQ + 16 * c) * 128; const float* w = w1 + (size_t)kv * 4096 * 128 + n;
            for (int k = 0; k < 4096; k += 8) { const v4u v = *(const v4u*)(a + k);
#pragma unroll
                for (int e = 0; e < 4; ++e) { acc += blo(v[e]) * w[(size_t)(k + 2 * e) * 128]; acc += bhi(v[e]) * w[(size_t)(k + 2 * e + 1) * 128]; } }
            acc = gelu_tanh(acc); }
        HC[i] = acc;
    }
}
__device__ __forceinline__ void naive_cmp2(const float* HC, const float* w2  , bf16* KCMP, int gtid, int NT) {
    for (int i = gtid; i < 2 * BATCH * 2 * 256 * 128; i += NT) {
        const int n = i & 127, c = (i >> 7) & 255, kv = i >> 17; float acc = 0.f;
        if (c < NCMP) { const float* hrow = HC + (size_t)(i >> 7) * 128; const float* w = w2 + (size_t)kv * 128 * 128 + n;
            for (int k = 0; k < 128; ++k) acc += hrow[k] * w[(size_t)k * 128]; }
        KCMP[i] = (bf16)f2bf(acc);
    }
}
__device__ __forceinline__ void naive_ng(const bf16* XB, const bf16* WNG, const float* ssq, float* NG, int gtid, int NT) {
    for (int i = gtid; i < MROWS * 24; i += NT) { const int row = i / 24, j = i % 24; const bf16* a = XB + (size_t)row * DM; const bf16* w = WNG + (size_t)j * DM; float acc = 0.f;
        for (int k = 0; k < DM; k += 8) { const v4u va = *(const v4u*)(a + k), vw = *(const v4u*)(w + k);
#pragma unroll
            for (int e = 0; e < 4; ++e) { acc += blo(va[e]) * blo(vw[e]); acc += bhi(va[e]) * bhi(vw[e]); } }
        const float v = acc * pg8::row_rstd(ssq, row); NG[i] = 1.0f / (1.0f + __expf(-v)); }
}

#ifndef SITE_MASK
#define SITE_MASK 0xffffffffu
#endif
#define SITE(k) ((SITE_MASK >> (k)) & 1u)
struct Args { const float* in[N_IN]; float* out; unsigned char* ws; int step_lo, step_hi; };
constexpr int N_STEPS = 1 + DEPTH * 10 + 1;

__global__ void __launch_bounds__(NTHREADS, 2) trunk_fwd(Args args_unused) {
#define SITE_ARGS const __attribute__((address_space(4))) Args* argp_ = (const __attribute__((address_space(4))) Args*)__builtin_amdgcn_kernarg_segment_ptr(); asm volatile("" : "+s"(argp_)); const __attribute__((address_space(4))) Args& args = *argp_;
    unsigned char* ws; int lo, hi; { SITE_ARGS ws = args.ws; lo = args.step_lo; hi = args.step_hi; }
    extern __shared__ __attribute__((aligned(16))) unsigned char lds_raw[];
    LAS unsigned char* lds = (LAS unsigned char*)lds_raw;
    volatile LAS unsigned* MISC = (volatile LAS unsigned*)(lds + MISC_OFF);
    const int G = gridDim.x, NT = G * NTHREADS, NGW = G * NWAVES;
#define SITE_IDS int tid = threadIdx.x; asm volatile("" : "+v"(tid)); const int lane = tid & 63, wave = __builtin_amdgcn_readfirstlane(tid >> 6), gtid = blockIdx.x * NTHREADS + tid, gw = blockIdx.x * NWAVES + wave; (void)lane; (void)gtid; (void)gw;
    gu32* ctl = (gu32*)(ws + WS_CTL);
    for (int u = threadIdx.x; u < (LDS_BYTES - LDSCTL_OFF) / 4; u += NTHREADS) ((LAS unsigned*)(lds + LDSCTL_OFF))[u] = 0u;
    __syncthreads();
    if (hi - lo > 1) (void)xcd_barrier_post((unsigned*)(ctl + CW_BAR), MISC + 8);
#define RUN(s) ((s) >= lo && (s) < hi)
#define SEAM(s) do { if ((s) + 1 < hi) { XcdBarrier bar_; bar_.bar = (unsigned*)((gu32*)(ws + WS_CTL) + CW_BAR); bar_.x = xb_xcc_id(); bar_.st = (volatile LAS unsigned*)(lds + MISC_OFF) + 8; xcd_barrier(bar_); } } while (0)
    float* X = (float*)(ws + WS_X); bf16* XB = (bf16*)(ws + WS_XB); float* SSQ = (float*)(ws + WS_SSQ);
    bf16* Hb = (bf16*)(ws + WS_H);
    float* BIAS1 = (float*)(ws + WS_MISC); float* LAMV = (float*)(ws + WS_MISC + 4096);
    LAS float* epi_scr = (LAS float*)(lds + EPI_OFF);

    if (SITE(0) && RUN(0)) {
        SITE_IDS SITE_ARGS
        LAS float* scr = (LAS float*)(lds + RING_OFF + wave * 16384);
        for (int l = 0; l < DEPTH; ++l) {
            unsigned char* wl = ws + WS_WL + (size_t)l * WL_STRIDE;
            cvt_job(args.in[I_F1G] + (size_t)l * DM * DFF, DM, DFF, DFF / 32, args.in[I_F1N] + l * DM, (bf16*)(wl + WL_GU1), DM, 0, 1, scr, gw, NGW, lane);
            cvt_job(args.in[I_F1U] + (size_t)l * DM * DFF, DM, DFF, DFF / 32, args.in[I_F1N] + l * DM, (bf16*)(wl + WL_GU1), DM, 0, 2, scr, gw, NGW, lane);
            cvt_job(args.in[I_F1D] + (size_t)l * DM * DFF, DFF, DM, DM / 32, nullptr, (bf16*)(wl + WL_D1), DFF, 0, 0, scr, gw, NGW, lane);
            cvt_job(args.in[I_WIN] + (size_t)l * DM * IN_COLS, DM, IN_COLS, PROJ_N / 32, args.in[I_MIXN] + l * DM, (bf16*)(wl + WL_IN), DM, 0, 3, scr, gw, NGW, lane);
            cvt_job(args.in[I_WIN] + (size_t)l * DM * IN_COLS, DM, IN_COLS, 1, args.in[I_MIXN] + l * DM, (bf16*)(wl + WL_NG), DM, 0, 4, scr, gw, NGW, lane);
            for (int kv = 0; kv < 2; ++kv) {
                cvt_job(args.in[I_CW1] + (size_t)(l * 2 + kv) * 4096 * 128, 4096, 128, 4, nullptr, (bf16*)(wl + WL_C1) + (size_t)kv * 128 * 4096, 4096, 0, 0, scr, gw, NGW, lane);
                cvt_job(args.in[I_CW2] + (size_t)(l * 2 + kv) * 128 * 128, 128, 128, 4, nullptr, (bf16*)(wl + WL_C2) + (size_t)kv * 128 * 128, 128, 0, 0, scr, gw, NGW, lane);
            }
            cvt_job(args.in[I_WMKV] + (size_t)l * DM * 1024, DM, 1024, 32, args.in[I_MEMN] + l * DM, (bf16*)(ws + WS_WMKV) + (size_t)l * 1024 * DM, DM, 0, 0, scr, gw, NGW, lane);
            cvt_job(args.in[I_WUD] + (size_t)l * 1024 * DM, 1024, DM, 64, nullptr, (bf16*)(wl + WL_UP), 2560, 0, 0, scr, gw, NGW, lane);
            cvt_job(args.in[I_WUN] + (size_t)l * 1024 * DM, 1024, DM, 64, nullptr, (bf16*)(wl + WL_UP), 2560, 1024, 0, scr, gw, NGW, lane);
            cvt_job(args.in[I_WUM] + (size_t)l * 512 * DM, 512, DM, 64, nullptr, (bf16*)(wl + WL_UP), 2560, 2048, 0, scr, gw, NGW, lane);
            cvt_job(args.in[I_WO] + (size_t)l * DM * DM, DM, DM, 64, nullptr, (bf16*)(wl + WL_O), DM, 0, 0, scr, gw, NGW, lane);
            cvt_job(args.in[I_F2G] + (size_t)l * DM * DFF, DM, DFF, DFF / 32, args.in[I_F2N] + l * DM, (bf16*)(wl + WL_GU2), DM, 0, 1, scr, gw, NGW, lane);
            cvt_job(args.in[I_F2U] + (size_t)l * DM * DFF, DM, DFF, DFF / 32, args.in[I_F2N] + l * DM, (bf16*)(wl + WL_GU2), DM, 0, 2, scr, gw, NGW, lane);
            cvt_job(args.in[I_F2D] + (size_t)l * DM * DFF, DFF, DM, DM / 32, nullptr, (bf16*)(wl + WL_D2), DFF, 0, 0, scr, gw, NGW, lane);
        }
        for (int m = gw; m < MROWS + MEMROWS; m += NGW) {
            const bool isx = m < MROWS; const int r = isx ? m : m - MROWS;
            const float* src = isx ? args.in[I_X] + (size_t)r * DM : args.in[I_MEM] + (size_t)r * DM;
            bf16* db = isx ? XB + (size_t)r * DM : (bf16*)(ws + WS_MEMB) + (size_t)r * DM;
            float* dq = isx ? SSQ + (size_t)r * 8 : (float*)(ws + WS_MEMSSQ) + (size_t)r * 8;
            float s = 0.f;
#pragma unroll
            for (int j = 0; j < 8; ++j) { const f32x4 v = *((const f32x4*)src + lane + 64 * j); s += (v[0] * v[0] + v[1] * v[1]) + (v[2] * v[2] + v[3] * v[3]);
                if (isx) *((f32x4*)(X + (size_t)r * DM) + lane + 64 * j) = v;
                *((unsigned long long*)db + lane + 64 * j) = (unsigned long long)pk2(v[0], v[1]) | ((unsigned long long)pk2(v[2], v[3]) << 32); }
            s = wave_sum(s);
            if (lane < 8) dq[lane] = (lane == 0) ? s : 0.f;
        }
        for (int o = gw; o < DEPTH * 2 * 128; o += NGW) { const int n = o & 127, lk = o >> 7;
            const float* pos = args.in[I_CPOS] + (size_t)lk * 4096; const float* w = args.in[I_CW1] + (size_t)lk * 4096 * 128 + n; float s = 0.f;
            for (int i = 0; i < 64; ++i) { const int k = lane * 64 + i; s += pos[k] * w[(size_t)k * 128]; }
            s = wave_sum(s); if (lane == 0) BIAS1[o] = s; }
        if (gtid < DEPTH) { const float* lp = args.in[I_LAM] + gtid * 256; float a = 0.f, b2 = 0.f;
            for (int i = 0; i < 64; ++i) { a += lp[i] * lp[64 + i]; b2 += lp[128 + i] * lp[192 + i]; }
            LAMV[gtid] = expf(a) - expf(b2) + (0.8f - 0.6f * expf(-0.3f * (float)gtid)); }
        SEAM(0);
    }

    for (int it = 0; it < 3 * DEPTH; ++it) {
        const int l = it / 3, r3 = it - 3 * l; const int sb = 1 + 10 * l + (r3 == 0 ? 0 : (r3 == 1 ? 2 : 8));
        unsigned char* wl = ws + WS_WL + (size_t)l * WL_STRIDE;
        if (r3 != 1) {
            if (SITE(1) && RUN(sb)) {
                pg8::Gemm g{XB, (const bf16*)(wl + (r3 == 0 ? WL_GU1 : WL_GU2)), MROWS, 2 * DFF, DM}; pg8::StaticOrder S; S.init(MROWS, 2 * DFF, G, (int)blockIdx.x);
                pg8::EpiSwiGLU E{Hb, SSQ, DFF}; pg8::NoHook nh;
                pg8::gemm_phase<pg8::EpiSwiGLU, pg8::StaticOrder, pg8::NoHook, true, true>(lds + RING_OFF, g, S, E, nh);
                if (SITE(2) && it == 0) {
                    pg8::Gemm g2{(const bf16*)(ws + WS_MEMB), (const bf16*)(ws + WS_WMKV), MEMROWS, DEPTH * 1024, DM}; pg8::StaticOrder S2; S2.init(MEMROWS, DEPTH * 1024, G, (int)((blockIdx.x + G / 2) % G));
                    pg8::EpiScaleBf16 E2{(bf16*)(ws + WS_MEMKV), DEPTH * 1024, (const float*)(ws + WS_MEMSSQ)};
                    pg8::gemm_phase<pg8::EpiScaleBf16, pg8::StaticOrder, pg8::NoHook, true, true>(lds + RING_OFF, g2, S2, E2, nh);
                }
                SEAM(sb);
            }
            if (SITE(3) && RUN(sb + 1)) {
                pg8::Gemm g{Hb, (const bf16*)(wl + (r3 == 0 ? WL_D1 : WL_D2)), MROWS, DM, DFF}; pg8::StaticOrder S; S.init(MROWS, DM, G, (int)blockIdx.x);
                pg8::EpiResid E{X, XB, SSQ, 0.5f, epi_scr}; pg8::NoHook nh;
                pg8::gemm_phase<pg8::EpiResid, pg8::StaticOrder, pg8::NoHook, true, true>(lds + RING_OFF, g, S, E, nh);
                SEAM(sb + 1);
            }
        } else {
            bf16* DQ = (bf16*)(ws + WS_DQ); bf16* DK = (bf16*)(ws + WS_DK); bf16* DV = (bf16*)(ws + WS_DV); bf16* NQ = (bf16*)(ws + WS_NQ);
            bf16* NKV = (bf16*)(ws + WS_NKV); bf16* MQ = (bf16*)(ws + WS_MQ); bf16* MG = (bf16*)(ws + WS_MG); float* NG = (float*)(ws + WS_NG);
            bf16* KCMP = (bf16*)(ws + WS_KCMP); float* HC = (float*)(ws + WS_HC); bf16* ACAT = (bf16*)(ws + WS_ACAT); bf16* MERGED = (bf16*)(ws + WS_MERGED);
            if (SITE(4) && RUN(sb)) {
                pg8::Gemm g{XB, (const bf16*)(wl + WL_IN), MROWS, PROJ_N, DM}; pg8::StaticOrder S; S.init(MROWS, PROJ_N, G, (int)blockIdx.x);
                pg8::EpiProj E{SSQ, DQ, DK, DV, NQ, NKV, MQ, MG, MROWS}; pg8::NoHook nh;
                pg8::gemm_phase<pg8::EpiProj, pg8::StaticOrder, pg8::NoHook, true, true>(lds + RING_OFF, g, S, E, nh);
                SEAM(sb);
            }
            if (SITE(5) && RUN(sb + 1)) {
                SITE_IDS SITE_ARGS
                naive_cmp1(NKV, args.in[I_CW1] + (size_t)l * 2 * 4096 * 128, BIAS1 + l * 256, HC, gtid, NT);
                naive_ng(XB, (const bf16*)(wl + WL_NG), SSQ, NG, gtid, NT);
                SEAM(sb + 1);
            }
            if (SITE(6) && RUN(sb + 2)) { SITE_IDS SITE_ARGS naive_cmp2(HC, args.in[I_CW2] + (size_t)l * 2 * 128 * 128, KCMP, gtid, NT); SEAM(sb + 2); }
            if (SITE(7) && RUN(sb + 3)) {
                SITE_IDS SITE_ARGS
                const float lam_init = 0.8f - 0.6f * expf(-0.3f * (float)l);
                if (SITE(10)) naive_nsa(NQ, NKV, KCMP, NG, ACAT, (LAS float*)(lds + RING_OFF), tid, gtid, NT);
                if (SITE(11)) naive_diff(DQ, DK, DV, ACAT, args.in[I_SUBLN] + l * 128, LAMV[l], lam_init, gtid, NT);
                if (SITE(12)) naive_mem(MQ, (const bf16*)(ws + WS_MEMKV) + (size_t)l * 1024, ACAT, gtid, NT);
                SEAM(sb + 3);
            }
            if (SITE(8) && RUN(sb + 4)) {
                pg8::Gemm g{ACAT, (const bf16*)(wl + WL_UP), MROWS, DM, 2560}; pg8::StaticOrder S; S.init(MROWS, DM, G, (int)blockIdx.x);
                pg8::MergeGate mgk{MG}; pg8::EpiMerge E{MERGED, mgk};
                pg8::gemm_phase<pg8::EpiMerge, pg8::StaticOrder, pg8::MergeGate, true, true>(lds + RING_OFF, g, S, E, mgk);
                SEAM(sb + 4);
            }
            if (SITE(9) && RUN(sb + 5)) {
                pg8::Gemm g{MERGED, (const bf16*)(wl + WL_O), MROWS, DM, DM}; pg8::StaticOrder S; S.init(MROWS, DM, G, (int)blockIdx.x);
                pg8::EpiResid E{X, XB, SSQ, 1.0f, epi_scr}; pg8::NoHook nh;
                pg8::gemm_phase<pg8::EpiResid, pg8::StaticOrder, pg8::NoHook, true, true>(lds + RING_OFF, g, S, E, nh);
                SEAM(sb + 5);
            }
        }
    }
    if (RUN(N_STEPS - 1)) {
        SITE_IDS SITE_ARGS
        const float* gn = args.in[I_FINN];
        for (int m = gw; m < MROWS; m += NGW) { const f32x4* xr = (const f32x4*)(X + (size_t)m * DM) + lane; f32x4 v[8]; float s = 0.f;
#pragma unroll
            for (int j = 0; j < 8; ++j) { v[j] = xr[64 * j]; s += (v[j][0] * v[j][0] + v[j][1] * v[j][1]) + (v[j][2] * v[j][2] + v[j][3] * v[j][3]); }
            const float rs = 1.0f / sqrtf(wave_sum(s) * (1.0f / DM) + NORM_EPS);
#pragma unroll
            for (int j = 0; j < 8; ++j) { const f32x4 gv = *((const f32x4*)gn + lane + 64 * j); *((f32x4*)(args.out + (size_t)m * DM) + lane + 64 * j) = v[j] * rs * gv; } }
    }
#undef RUN
#undef SEAM
#undef SITE_IDS
#undef SITE_ARGS
}

#ifndef MK_PER_STEP
#define MK_PER_STEP 1
#endif
extern "C" void kernel_launch(void* const* d_in, const int* in_sizes, int n_in, void* d_out, int out_size, void* d_ws, size_t ws_size, hipStream_t stream) {
    static int grid = 0;
    if (grid == 0) {
        if (n_in != N_IN || in_sizes[0] != MROWS * DM || out_size != MROWS * DM || ws_size < WS_END) {
            fprintf(stderr, "kernel_launch: shape/workspace mismatch: n_in %d in0 %d out %d ws %zu (need %zu)\n", n_in, n_in > 0 ? in_sizes[0] : -1, out_size, ws_size, (size_t)WS_END); grid = -1; return; }
        int dev = 0, cus = 0, per_cu = 0;
        if (hipGetDevice(&dev) != hipSuccess || hipDeviceGetAttribute(&cus, hipDeviceAttributeMultiprocessorCount, dev) != hipSuccess) { grid = -1; return; }
        if (hipFuncSetAttribute((const void*)trunk_fwd, hipFuncAttributeMaxDynamicSharedMemorySize, LDS_BYTES) != hipSuccess) { fprintf(stderr, "kernel_launch: hipFuncSetAttribute failed\n"); grid = -1; return; }
        if (hipOccupancyMaxActiveBlocksPerMultiprocessor(&per_cu, (const void*)trunk_fwd, NTHREADS, LDS_BYTES) != hipSuccess || per_cu < 1)
            fprintf(stderr, "kernel_launch: note: occupancy query reports %d workgroups per CU\n", per_cu);
        (void)hipGetLastError();
        grid = cus;
    }
    if (grid < 0) return;
    if (hipMemsetAsync((char*)d_ws + WS_CTL, 0, CTL_ZERO_BYTES, stream) != hipSuccess) return;
    Args a{};
    for (int i = 0; i < N_IN; ++i) a.in[i] = (const float*)d_in[i];
    a.out = (float*)d_out; a.ws = (unsigned char*)d_ws;
#if MK_PER_STEP
    for (int s = 0; s < N_STEPS; ++s) { a.step_lo = s; a.step_hi = s + 1; hipLaunchKernelGGL(trunk_fwd, dim3(grid), dim3(NTHREADS), LDS_BYTES, stream, a); }
#else
    a.step_lo = 0; a.step_hi = N_STEPS; hipLaunchKernelGGL(trunk_fwd, dim3(grid), dim3(NTHREADS), LDS_BYTES, stream, a);
#endif
    const hipError_t le = hipPeekAtLastError();
    if (le != hipSuccess) fprintf(stderr, "kernel_launch: launch failed: %s\n", hipGetErrorName(le));
}
```

```cpp
#include <hip/hip_runtime.h>
#include <cstdio>
#include <cstdint>

__device__ __forceinline__ int lane_id_fresh() { int l; asm volatile("v_mbcnt_lo_u32_b32 %0, -1, 0\n\tv_mbcnt_hi_u32_b32 %0, -1, %0" : "=v"(l)); return l; }
namespace pg8 {
#define PG8_LAS __attribute__((address_space(3)))
#ifndef GAS
#define GAS __attribute__((address_space(1)))
#endif
typedef unsigned short bf16_t;
typedef short bf16x8 __attribute__((ext_vector_type(8)));
typedef float f32x4 __attribute__((ext_vector_type(4)));
typedef unsigned u32x4 __attribute__((ext_vector_type(4)));
typedef unsigned u32x2 __attribute__((ext_vector_type(2)));
constexpr int BM = 256, BK = 64, HALF = 128, HTB = HALF * BK * 2  , STAGE_BYTES = 8 * HTB, NXCD = 8, WGM = 4;

__host__ __device__ __forceinline__ int lds_byte(int r, int c) { const int st = (r >> 4) * 2 + (c >> 5), rr = r & 15, cc = c & 31, ob = rr * 64 + cc * 2; return st * 1024 + (ob ^ (((ob >> 9) & 1) << 5)); }
__host__ __device__ __forceinline__ void stage_rc(int b, int& R, int& C) { const int st = b / 1024, sb = b % 1024, swz = sb ^ (((sb >> 9) & 1) << 5); R = (st >> 1) * 16 + swz / 64; C = (st & 1) * 32 + (swz % 64) / 2; }
__host__ __device__ __forceinline__ int perm32(int rho) { const int n = rho >> 4, i = rho & 15; return 8 * (i >> 2) + 4 * n + (i & 3); }

struct Unit { int pm, pn; };
struct Gemm { const bf16_t* A; const bf16_t* Bt; int M, N, K; };

struct StaticOrder {
    int nM, nN, nwg, G, c;
    __host__ __device__ void init(int M, int N, int G_, int c_) { nM = M / BM; nN = N / BM; nwg = nM * nN; G = G_; c = c_; }
    __host__ __device__ bool next(int i, Unit& u) const {
        const long L = (long)i * G + c; if (L >= nwg) return false;
        int wgid = (int)L; { const int q = nwg / NXCD, r = nwg % NXCD, xcd = wgid % NXCD, off = wgid / NXCD; wgid = (xcd < r ? xcd * (q + 1) : r * (q + 1) + (xcd - r) * q) + off; }
        const int nig = WGM * nN, gid = wgid / nig, fm = gid * WGM, gsz = (nM - fm) < WGM ? (nM - fm) : WGM;
        u.pm = fm + ((wgid % nig) % gsz); u.pn = (wgid % nig) / gsz; return true;
    }
    __device__ __forceinline__ void a_ready(const Unit&) const {}
    __device__ __forceinline__ void done(const Unit&) const {}
};

typedef float f32x2_cv __attribute__((ext_vector_type(2))); typedef __bf16 bf16x2_cv __attribute__((ext_vector_type(2)));
__device__ __forceinline__ unsigned cvt_pk_bf16(float lo, float hi) { const f32x2_cv v = {lo, hi}; const bf16x2_cv b = __builtin_convertvector(v, bf16x2_cv); return __builtin_bit_cast(unsigned, b); }
__device__ __forceinline__ float bflo(unsigned w) { return __uint_as_float(w << 16); }
__device__ __forceinline__ float bfhi(unsigned w) { return __uint_as_float(w & 0xffff0000u); }
struct NoHook { static constexpr bool ON = false; static constexpr int T1 = -1, T2 = -1;
    __device__ __forceinline__ void apply(f32x4 (&)[2][2][4][2], const Unit&, int, int, int, int, int) const {} };

__device__ __forceinline__ float row_rstd(const float* ssq, int row) {
    const f32x4 a = *(const f32x4*)(ssq + (size_t)row * 8), b = *(const f32x4*)(ssq + (size_t)row * 8 + 4);
    const float s = ((a[0] + a[1]) + (a[2] + a[3])) + ((b[0] + b[1]) + (b[2] + b[3]));
    return __builtin_amdgcn_rsqf(s * (1.0f / 2048.0f) + 1e-6f);
}
__device__ __forceinline__ float row_rstd_lds(const PG8_LAS float* img, int rl) {
    const f32x4 a = *(const PG8_LAS f32x4*)(img + rl * 8), b = *(const PG8_LAS f32x4*)(img + rl * 8 + 4);
    const float s = ((a[0] + a[1]) + (a[2] + a[3])) + ((b[0] + b[1]) + (b[2] + b[3]));
    return __builtin_amdgcn_rsqf(s * (1.0f / 2048.0f) + 1e-6f);
}
__device__ __forceinline__ float fast_sigmoid(float v) { return __builtin_amdgcn_rcpf(1.0f + __builtin_amdgcn_exp2f(-1.4426950408889634f * v)); }

struct EpiSwiGLU { static constexpr bool PERM = true, AFTER_DRAIN = false, NEED_SSQ = true;
    bf16_t* H; const float* ssq; int ldh; const PG8_LAS float* img;
    __device__ __forceinline__ void operator()(const f32x4 (&acc)[2][2][4][2], const Unit& u, int wr, int wc, int fr, int fq, int, int) const {
        const int row0 = u.pm * BM + wr * 64 + fr, col0 = u.pn * 128 + wc * 32 + 8 * fq;
#pragma unroll
        for (int ai = 0; ai < 2; ++ai)
#pragma unroll
            for (int m = 0; m < 4; ++m) { const int row = row0 + ai * HALF + m * 16; const float rs = row_rstd_lds(img, wr * 64 + fr + ai * HALF + m * 16);
                const float kk = rs * -1.4426950408889634f, rs2 = rs * rs;
                float hv[8];
#pragma unroll
                for (int n = 0; n < 2; ++n)
#pragma unroll
                    for (int e = 0; e < 4; ++e) { const float G_ = acc[ai][0][m][n][e], U_ = acc[ai][1][m][n][e]; const float t_ = G_ * kk, gu_ = G_ * U_;
                        const float r_ = __builtin_amdgcn_rcpf(1.0f + __builtin_amdgcn_exp2f(t_)); hv[n * 4 + e] = gu_ * (r_ * rs2); }
                u32x4 w; w.x = cvt_pk_bf16(hv[0], hv[1]); w.y = cvt_pk_bf16(hv[2], hv[3]); w.z = cvt_pk_bf16(hv[4], hv[5]); w.w = cvt_pk_bf16(hv[6], hv[7]);
                *(u32x4*)(H + (size_t)row * ldh + col0) = w; }
    }
};
struct EpiResid { static constexpr bool PERM = true, AFTER_DRAIN = false, NEED_SSQ = false;
    bf16_t* XB; float* ssq; float scale; PG8_LAS float* scr;
    __device__ __forceinline__ void operator()(const f32x4 (&acc)[2][2][4][2], const Unit& u, int wr, int wc, int fr_in, int fq_in, int wid, int lane_in) const {
        const int lane = lane_id_fresh(), fr = lane & 15, fq = lane >> 4; (void)fr_in; (void)fq_in; (void)lane_in;
        const int col0 = u.pn * BM + wc * 32 + 8 * fq;
#pragma unroll
        for (int ai = 0; ai < 2; ++ai) {
            size_t off0 = (size_t)(u.pm * BM + ai * HALF + wr * 64 + fr) * 2048 + col0; asm volatile("" : "+v"(off0));
            GAS bf16_t* bp = (GAS bf16_t*)XB + off0;
            u32x4 xo[4][2];
#pragma unroll
            for (int m = 0; m < 4; ++m)
#pragma unroll
                for (int bj = 0; bj < 2; ++bj) xo[m][bj] = *(const GAS u32x4*)(bp + (size_t)(m * 16) * 2048 + bj * HALF);
            asm volatile("" ::: "memory");
#pragma unroll
            for (int m = 0; m < 4; ++m) { float q = 0.f;
#pragma unroll
                for (int bj = 0; bj < 2; ++bj) { const u32x4 xi = xo[m][bj];
                    const f32x4 i0 = {bflo(xi.x), bfhi(xi.x), bflo(xi.y), bfhi(xi.y)}, i1 = {bflo(xi.z), bfhi(xi.z), bflo(xi.w), bfhi(xi.w)};
                    const f32x4 x0 = i0 + acc[ai][bj][m][0] * scale, x1 = i1 + acc[ai][bj][m][1] * scale;
                    u32x4 w; w.x = cvt_pk_bf16(x0[0], x0[1]); w.y = cvt_pk_bf16(x0[2], x0[3]); w.z = cvt_pk_bf16(x1[0], x1[1]); w.w = cvt_pk_bf16(x1[2], x1[3]); *(GAS u32x4*)(bp + (size_t)(m * 16) * 2048 + bj * HALF) = w;
                    q += ((x0[0] * x0[0] + x0[1] * x0[1]) + (x0[2] * x0[2] + x0[3] * x0[3])) + ((x1[0] * x1[0] + x1[1] * x1[1]) + (x1[2] * x1[2] + x1[3] * x1[3])); }
                q += __shfl_xor(q, 16); q += __shfl_xor(q, 32);
                if (fq == 0) scr[(ai * HALF + wr * 64 + m * 16 + fr) * 4 + wc] = q; }
            asm volatile("" ::: "memory"); }
        asm volatile("s_waitcnt lgkmcnt(0)\n\ts_barrier" ::: "memory");
        const int tid = wid * 64 + lane;
        if (tid < 256) { const float s = (scr[tid * 4 + 0] + scr[tid * 4 + 1]) + (scr[tid * 4 + 2] + scr[tid * 4 + 3]); ssq[(size_t)(u.pm * BM + tid) * 8 + u.pn] = s; }
        asm volatile("s_waitcnt lgkmcnt(0)" ::: "memory");
    }
};
struct EpiScaleBf16 { static constexpr bool PERM = true, AFTER_DRAIN = false, NEED_SSQ = true;
    bf16_t* O; int ldc; const float* ssq; const PG8_LAS float* img;
    __device__ __forceinline__ void operator()(const f32x4 (&acc)[2][2][4][2], const Unit& u, int wr, int wc, int fr, int fq, int, int) const {
        const int row0 = u.pm * BM + wr * 64 + fr, col0 = u.pn * BM + wc * 32 + 8 * fq;
#pragma unroll
        for (int ai = 0; ai < 2; ++ai)
#pragma unroll
            for (int m = 0; m < 4; ++m) { const int row = row0 + ai * HALF + m * 16; const float rs = row_rstd_lds(img, wr * 64 + fr + ai * HALF + m * 16);
#pragma unroll
                for (int bj = 0; bj < 2; ++bj) { const f32x4 v0 = acc[ai][bj][m][0] * rs, v1 = acc[ai][bj][m][1] * rs;
                    u32x4 w; w.x = cvt_pk_bf16(v0[0], v0[1]); w.y = cvt_pk_bf16(v0[2], v0[3]); w.z = cvt_pk_bf16(v1[0], v1[1]); w.w = cvt_pk_bf16(v1[2], v1[3]);
                    *(u32x4*)(O + (size_t)row * ldc + col0 + bj * HALF) = w; } }
    }
};
__device__ __forceinline__ size_t mg_off(int s_, int pm, int pn, int wid, int ai) { return ((((size_t)(s_ * 32 + pm) * 8 + pn) * 8 + wid) * 2 + ai) * 4096; }
constexpr size_t MG_SET = (size_t)8192 * 2048;
struct EpiProj { static constexpr bool PERM = true, AFTER_DRAIN = false, NEED_SSQ = true;
    const PG8_LAS float* img; const float* ssq; bf16_t *DQ, *DK, *DV, *NQ, *NKV, *MQ, *MG; int Mrows;
    __device__ __forceinline__ void operator()(const f32x4 (&acc)[2][2][4][2], const Unit& u, int wr, int wc, int fr, int fq, int, int) const {
        const int pn = u.pn; bf16_t* base; int ldc, c0; size_t bjs = HALF;
        float qs = 1.0f;
        if (pn < 4) { base = DQ; ldc = 1024; c0 = 256 * pn; qs = 0.125f * 1.4426950408889634f; }
        else if (pn < 8) { base = DK; ldc = 1024; c0 = 256 * (pn - 4); }
        else if (pn < 12) { base = DV; ldc = 1024; c0 = 256 * (pn - 8); }
        else if (pn < 16) { base = NQ; ldc = 1024; c0 = 256 * (pn - 12); qs = 0.08838834764831845f * 1.4426950408889634f; }
        else if (pn < 22) { base = NKV + (size_t)(2 * (pn - 16)) * Mrows * 128; ldc = 128; c0 = 0; bjs = (size_t)Mrows * 128; }
        else if (pn < 24) { base = MQ; ldc = 512; c0 = 256 * (pn - 22); qs = 0.08838834764831845f * 1.4426950408889634f; }
        else { base = MG; ldc = 6144; c0 = 256 * (pn - 24); }
        const bool gate_tile = pn >= 24;
        const int row0 = u.pm * BM + wr * 64 + fr, col0 = c0 + wc * 32 + 8 * fq;
        if (gate_tile) {
#pragma unroll
            for (int ai = 0; ai < 2; ++ai)
#pragma unroll
                for (int m = 0; m < 4; ++m) { const int row = row0 + ai * HALF + m * 16; const float rs = row_rstd_lds(img, wr * 64 + fr + ai * HALF + m * 16) * -1.4426950408889634f;
#pragma unroll
                    for (int bj = 0; bj < 2; ++bj) { f32x4 v0 = acc[ai][bj][m][0] * rs, v1 = acc[ai][bj][m][1] * rs;
#pragma unroll
                        for (int e = 0; e < 4; ++e) { v0[e] = 1.0f + __builtin_amdgcn_exp2f(fminf(v0[e], 43.28085123f)); v1[e] = 1.0f + __builtin_amdgcn_exp2f(fminf(v1[e], 43.28085123f)); }
                        u32x4 w; w.x = cvt_pk_bf16(v0[0], v0[1]); w.y = cvt_pk_bf16(v0[2], v0[3]); w.z = cvt_pk_bf16(v1[0], v1[1]); w.w = cvt_pk_bf16(v1[2], v1[3]);
                        *(u32x4*)(MG + mg_off((pn - 24) >> 3, u.pm, (pn - 24) & 7, wr * 4 + wc, ai) + (m * 2 + bj) * 512 + (fr + 16 * fq) * 8) = w; } }
        } else {
#pragma unroll
            for (int ai = 0; ai < 2; ++ai)
#pragma unroll
                for (int m = 0; m < 4; ++m) { const int row = row0 + ai * HALF + m * 16; const float rs = row_rstd_lds(img, wr * 64 + fr + ai * HALF + m * 16) * qs;
#pragma unroll
                    for (int bj = 0; bj < 2; ++bj) { const f32x4 v0 = acc[ai][bj][m][0] * rs, v1 = acc[ai][bj][m][1] * rs;
                        u32x4 w; w.x = cvt_pk_bf16(v0[0], v0[1]); w.y = cvt_pk_bf16(v0[2], v0[3]); w.z = cvt_pk_bf16(v1[0], v1[1]); w.w = cvt_pk_bf16(v1[2], v1[3]);
                        *(u32x4*)(base + bj * bjs + (size_t)row * ldc + col0) = w; } }
        }
    }
};
struct MergeGate { static constexpr bool ON = true; static constexpr int T1 = 16, T2 = 32;
    const bf16_t* MG;
    __device__ __forceinline__ void apply(f32x4 (&acc)[2][2][4][2], const Unit& u, int wr, int wc, int fr_in, int fq_in, int which) const {
        const int lane = lane_id_fresh(), fr = lane & 15, fq = lane >> 4; (void)fr_in; (void)fq_in;
        const GAS bf16_t* gbase = (const GAS bf16_t*)MG + mg_off(which, u.pm, u.pn, wr * 4 + wc, 0) + lane * 8;
#pragma unroll
        for (int ai = 0; ai < 2; ++ai) { u32x4 wa[4][2], wb[4][2];
            const GAS bf16_t* gp = gbase + (size_t)ai * 4096; asm volatile("" : "+v"(gp));
#pragma unroll
            for (int m = 0; m < 4; ++m)
#pragma unroll
                for (int bj = 0; bj < 2; ++bj) { wa[m][bj] = *(const GAS u32x4*)(gp + (m * 2 + bj) * 512);
                    if (which < 2) wb[m][bj] = *(const GAS u32x4*)(gp + MG_SET + (m * 2 + bj) * 512); }
#pragma unroll
            for (int m = 0; m < 4; ++m)
#pragma unroll
                for (int bj = 0; bj < 2; ++bj) { float f[8];
#pragma unroll
                    for (int e = 0; e < 4; ++e) { f[2 * e] = __builtin_amdgcn_rcpf(bflo(wa[m][bj][e])); f[2 * e + 1] = __builtin_amdgcn_rcpf(bfhi(wa[m][bj][e])); }
                    if (which < 2) {
#pragma unroll
                        for (int e = 0; e < 4; ++e) { f[2 * e] *= bflo(wb[m][bj][e]); f[2 * e + 1] *= bfhi(wb[m][bj][e]); } }
#pragma unroll
                    for (int e = 0; e < 4; ++e) { acc[ai][bj][m][0][e] *= f[e]; acc[ai][bj][m][1][e] *= f[4 + e]; } }
            asm volatile("" ::: "memory"); }
    }
};
struct EpiMerge { static constexpr bool PERM = true, AFTER_DRAIN = false, NEED_SSQ = false;
    bf16_t* O; MergeGate G;
    __device__ __forceinline__ void operator()(const f32x4 (&acc_in)[2][2][4][2], const Unit& u, int wr, int wc, int fr_in, int fq_in, int, int) const {
        const int lane = lane_id_fresh(), fr = lane & 15, fq = lane >> 4; (void)fr_in; (void)fq_in;
        const int row0 = u.pm * BM + wr * 64 + fr, col0 = u.pn * BM + wc * 32 + 8 * fq;
#pragma unroll
        for (int ai = 0; ai < 2; ++ai) { u32x4 wa[4][2];
            const GAS bf16_t* gp = (const GAS bf16_t*)G.MG + mg_off(2, u.pm, u.pn, wr * 4 + wc, ai) + lane * 8; asm volatile("" : "+v"(gp));
#pragma unroll
            for (int m = 0; m < 4; ++m)
#pragma unroll
                for (int bj = 0; bj < 2; ++bj) wa[m][bj] = *(const GAS u32x4*)(gp + (m * 2 + bj) * 512);
#pragma unroll
            for (int m = 0; m < 4; ++m) { const int row = row0 + ai * HALF + m * 16;
#pragma unroll
                for (int bj = 0; bj < 2; ++bj) { float g[8];
#pragma unroll
                    for (int e = 0; e < 4; ++e) { g[2 * e] = __builtin_amdgcn_rcpf(bflo(wa[m][bj][e])); g[2 * e + 1] = __builtin_amdgcn_rcpf(bfhi(wa[m][bj][e])); }
                    const f32x4 a0 = acc_in[ai][bj][m][0], a1 = acc_in[ai][bj][m][1];
                    u32x4 w; w.x = cvt_pk_bf16(a0[0] * g[0], a0[1] * g[1]); w.y = cvt_pk_bf16(a0[2] * g[2], a0[3] * g[3]); w.z = cvt_pk_bf16(a1[0] * g[4], a1[1] * g[5]); w.w = cvt_pk_bf16(a1[2] * g[6], a1[3] * g[7]);
                    *(GAS u32x4*)((GAS bf16_t*)O + (size_t)row * 2048 + col0 + bj * HALF) = w; } }
            asm volatile("" ::: "memory"); }
    }
};

template <class Epi, class Sched, class Hook, bool ALIGN_EPI = false, bool SP2 = false>
__device__ __forceinline__ void gemm_phase(PG8_LAS unsigned char* lds, const Gemm g, const Sched& S, const Epi& E, const Hook& Hk, int tid_in) {
    int tid_ = tid_in; asm volatile("" : "+v"(tid_));
    const int tid = tid_, wid = __builtin_amdgcn_readfirstlane(tid >> 6), lane = tid & 63, wr = wid >> 2, wc = wid & 3, fr = lane & 15, fq = lane >> 4;
    const int K = g.K, nt = K / BK;
    unsigned voffA[2], voffB[2];
#pragma unroll
    for (int i = 0; i < 2; ++i) { int R, C; stage_rc(tid * 16 + i * 8192, R, C); const int Rb = Epi::PERM ? ((R & ~31) + perm32(R & 31)) : R;
        voffA[i] = (unsigned)(R * K + C) * 2u; voffB[i] = (unsigned)(Rb * BK + C) * 2u; }
    const size_t kstep = (size_t)(BK * 2), kstepB = (size_t)BM * BK * 2;
    const size_t hstep = (size_t)HALF * K * 2, hstepB = (size_t)HALF * BK * 2;
    const size_t tstep = 2 * hstep, tstepB = (size_t)BM * K * 2;
    const unsigned ldsw = (unsigned)wid * 1024u;
    const int aoff = lds_byte(wr * 64 + fr, fq * 8), boff = lds_byte(wc * 32 + fr, fq * 8);
#define PG8_SA(b, h) (((b) * 2 + (h)) * HTB)
#define PG8_SB(b, h) ((4 + (b) * 2 + (h)) * HTB)
#define PG8_STAGE(bufoff, gbase, voff) do { _Pragma("unroll") for (int _i = 0; _i < 2; ++_i) \
        __builtin_amdgcn_global_load_lds((const unsigned*)((const char*)(gbase) + (voff)[_i]), (PG8_LAS unsigned*)(lds + (bufoff) + ldsw + _i * 8192), 16, 0, 0); } while (0)
#define PG8_LDA(dst, b, h) do { _Pragma("unroll") for (int m = 0; m < 4; ++m) _Pragma("unroll") for (int k = 0; k < 2; ++k) dst[m][k] = *(const PG8_LAS bf16x8*)(lds + PG8_SA(b, h) + aoff + m * 2048 + k * 1024); } while (0)
#define PG8_LDB(dst, b, h) do { _Pragma("unroll") for (int n = 0; n < 2; ++n) _Pragma("unroll") for (int k = 0; k < 2; ++k) dst[n][k] = *(const PG8_LAS bf16x8*)(lds + PG8_SB(b, h) + boff + n * 2048 + k * 1024); } while (0)
#define PG8_MMA(ai, bj, At, Bt) do { __builtin_amdgcn_s_setprio(1); _Pragma("unroll") for (int m = 0; m < 4; ++m) _Pragma("unroll") for (int n = 0; n < 2; ++n) _Pragma("unroll") for (int k = 0; k < 2; ++k) \
        acc[ai][bj][m][n] = __builtin_amdgcn_mfma_f32_16x16x32_bf16(Bt[n][k], At[m][k], acc[ai][bj][m][n], 0, 0, 0); __builtin_amdgcn_s_setprio(0); } while (0)
#define PG8_WAIT_V(n) asm volatile("s_waitcnt vmcnt(" #n ")" ::: "memory")
#define PG8_WAIT_L(n) asm volatile("s_waitcnt lgkmcnt(" #n ")" ::: "memory")
#define PG8_BAR __builtin_amdgcn_s_barrier()
#define PG8_SCHED __builtin_amdgcn_sched_barrier(0)
    Unit cur, nxt; int ui = 0;
    if (!S.next(0, cur)) return;
    f32x4 acc[2][2][4][2];
#pragma unroll
    for (int a = 0; a < 2; ++a)
#pragma unroll
        for (int b = 0; b < 2; ++b)
#pragma unroll
            for (int m = 0; m < 4; ++m)
#pragma unroll
                for (int n = 0; n < 2; ++n) acc[a][b][m][n] = (f32x4){0.f, 0.f, 0.f, 0.f};
    bf16x8 At[4][2], B0[2][2], B1[2][2];
    const char* cA = (const char*)g.A + (size_t)cur.pm * tstep; const char* cB = (const char*)g.Bt + (size_t)cur.pn * tstepB;
    S.a_ready(cur);
    if constexpr (SP2) {
        PG8_STAGE(PG8_SB(0, 0), cB, voffB); PG8_STAGE(PG8_SB(0, 1), cB + hstepB, voffB); PG8_STAGE(PG8_SA(0, 0), cA, voffA); PG8_STAGE(PG8_SA(0, 1), cA + hstep, voffA);
        if (wr == 1) PG8_BAR;
        PG8_WAIT_V(2); PG8_BAR;
        PG8_STAGE(PG8_SB(1, 0), cB + kstepB, voffB); PG8_STAGE(PG8_SA(1, 0), cA + kstep, voffA); PG8_STAGE(PG8_SB(1, 1), cB + hstepB + kstepB, voffB);
        PG8_WAIT_V(6); PG8_BAR;
    } else {
        PG8_STAGE(PG8_SB(0, 0), cB, voffB); PG8_STAGE(PG8_SA(0, 0), cA, voffA); PG8_STAGE(PG8_SB(0, 1), cB + hstepB, voffB); PG8_STAGE(PG8_SA(0, 1), cA + hstep, voffA);
        if (wr == 1) PG8_BAR;
        PG8_WAIT_V(4); PG8_BAR;
        PG8_STAGE(PG8_SB(1, 0), cB + kstepB, voffB); PG8_STAGE(PG8_SA(1, 0), cA + kstep, voffA); PG8_STAGE(PG8_SB(1, 1), cB + hstepB + kstepB, voffB);
        PG8_WAIT_V(6); PG8_BAR;
    }
    for (;;) {
        const bool has_next = S.next(ui + 1, nxt);
        const char* nA = has_next ? (const char*)g.A + (size_t)nxt.pm * tstep : cA; const char* nB = has_next ? (const char*)g.Bt + (size_t)nxt.pn * tstepB : cB;
#pragma unroll
        for (int seg = 0; seg < (Hook::ON ? 3 : 1); ++seg) {
        const int tb = Hook::ON ? (seg == 0 ? 0 : (seg == 1 ? Hook::T1 : Hook::T2)) : 0, te = Hook::ON ? (seg == 0 ? Hook::T1 : (seg == 1 ? Hook::T2 : nt)) : nt;
        if constexpr (Hook::ON) { if (seg > 0) Hk.apply(acc, cur, wr, wc, fr, fq, seg - 1); }
        for (int t = tb; t < te; t += 2) {
            const bool last = (t == nt - 2);
            const char* a1 = cA + (size_t)(t + 1) * kstep;
            const char* a2 = last ? nA : cA + (size_t)(t + 2) * kstep; const char* b2 = last ? nB : cB + (size_t)(t + 2) * kstepB;
            const char* a3 = a2 + kstep; const char* b3 = b2 + kstepB;
            if (last && has_next) S.a_ready(nxt);
            if constexpr (Epi::NEED_SSQ) { if (last) {
                __builtin_amdgcn_global_load_lds((const unsigned*)(E.ssq + ((size_t)cur.pm * BM + wid * 32 + (lane >> 1)) * 8 + (lane & 1) * 4), (PG8_LAS unsigned*)((PG8_LAS unsigned char*)E.img + wid * 1024), 16, 0, 0); } }
            if constexpr (SP2) {
            PG8_LDB(B0, 0, 0); PG8_LDB(B1, 0, 1); PG8_SCHED; PG8_LDA(At, 0, 0); PG8_STAGE(PG8_SA(1, 1), a1 + hstep, voffA);
            PG8_WAIT_V(8); PG8_WAIT_L(0); PG8_BAR; PG8_MMA(0, 0, At, B0); PG8_MMA(0, 1, At, B1); PG8_BAR; PG8_SCHED;
            PG8_LDA(At, 0, 1); PG8_STAGE(PG8_SB(0, 0), b2, voffB); PG8_STAGE(PG8_SB(0, 1), b2 + hstepB, voffB); PG8_STAGE(PG8_SA(0, 0), a2, voffA);
            PG8_WAIT_V(8); PG8_WAIT_L(0); PG8_BAR; PG8_MMA(1, 0, At, B0); PG8_MMA(1, 1, At, B1); PG8_BAR; PG8_SCHED;
            PG8_LDB(B0, 1, 0); PG8_LDB(B1, 1, 1); PG8_SCHED; PG8_LDA(At, 1, 0); PG8_STAGE(PG8_SA(0, 1), a2 + hstep, voffA);
            PG8_WAIT_V(8); PG8_WAIT_L(0); PG8_BAR; PG8_MMA(0, 0, At, B0); PG8_MMA(0, 1, At, B1); PG8_BAR; PG8_SCHED;
            PG8_LDA(At, 1, 1); PG8_STAGE(PG8_SB(1, 0), b3, voffB); PG8_STAGE(PG8_SB(1, 1), b3 + hstepB, voffB); PG8_STAGE(PG8_SA(1, 0), a3, voffA);
            PG8_WAIT_V(8); PG8_WAIT_L(0); PG8_BAR; PG8_MMA(1, 0, At, B0); PG8_MMA(1, 1, At, B1); PG8_BAR; PG8_SCHED;
            } else {
            PG8_LDB(B0, 0, 0); PG8_SCHED; PG8_LDA(At, 0, 0); PG8_STAGE(PG8_SA(1, 1), a1 + hstep, voffA);
            PG8_WAIT_L(8); PG8_BAR; PG8_WAIT_L(0); PG8_MMA(0, 0, At, B0); PG8_BAR; PG8_SCHED;
            PG8_LDB(B1, 0, 1); PG8_STAGE(PG8_SB(0, 0), b2, voffB);
            PG8_BAR; PG8_WAIT_L(0); PG8_MMA(0, 1, At, B1); PG8_BAR;
            PG8_LDA(At, 0, 1); PG8_STAGE(PG8_SA(0, 0), a2, voffA);
            PG8_BAR; PG8_WAIT_L(0); PG8_MMA(1, 0, At, B0); PG8_BAR; PG8_SCHED;
            PG8_STAGE(PG8_SB(0, 1), b2 + hstepB, voffB);
            PG8_WAIT_V(6); PG8_BAR; PG8_MMA(1, 1, At, B1); PG8_BAR;
            PG8_LDB(B0, 1, 0); PG8_SCHED; PG8_LDA(At, 1, 0); PG8_STAGE(PG8_SA(0, 1), a2 + hstep, voffA);
            PG8_WAIT_L(8); PG8_BAR; PG8_WAIT_L(0); PG8_MMA(0, 0, At, B0); PG8_BAR; PG8_SCHED;
            PG8_LDB(B1, 1, 1); PG8_STAGE(PG8_SB(1, 0), b3, voffB);
            PG8_BAR; PG8_WAIT_L(0); PG8_MMA(0, 1, At, B1); PG8_BAR;
            PG8_LDA(At, 1, 1); PG8_STAGE(PG8_SA(1, 0), a3, voffA);
            PG8_BAR; PG8_WAIT_L(0); PG8_MMA(1, 0, At, B0); PG8_BAR; PG8_SCHED;
            PG8_STAGE(PG8_SB(1, 1), b3 + hstepB, voffB);
            PG8_WAIT_V(6); PG8_BAR; PG8_MMA(1, 1, At, B1); PG8_BAR;
            }
        }
        }
        if constexpr (ALIGN_EPI) { if (wr == 0) PG8_BAR; }
        if constexpr (!Epi::AFTER_DRAIN) { E(acc, cur, wr, wc, fr, fq, wid, lane); S.done(cur); }
        if (!has_next) break;
#pragma unroll
        for (int a = 0; a < 2; ++a)
#pragma unroll
            for (int b = 0; b < 2; ++b)
#pragma unroll
                for (int m = 0; m < 4; ++m)
#pragma unroll
                    for (int n = 0; n < 2; ++n) acc[a][b][m][n] = (f32x4){0.f, 0.f, 0.f, 0.f};
        cur = nxt; cA = nA; cB = nB; ++ui;
        if constexpr (ALIGN_EPI) { if (wr == 1) PG8_BAR; }
    }
    PG8_WAIT_V(0);
    if constexpr (!ALIGN_EPI) { if (wr == 0) PG8_BAR; }
    PG8_BAR;
    if constexpr (Epi::AFTER_DRAIN) { E.fused(acc, cur, wr, wc, fr, fq, lds, wid, lane); S.done(cur); }
#undef PG8_SA
#undef PG8_SB
#undef PG8_STAGE
#undef PG8_LDA
#undef PG8_LDB
#undef PG8_MMA
#undef PG8_WAIT_V
#undef PG8_WAIT_L
#undef PG8_BAR
#undef PG8_SCHED
}
}

constexpr int NWAVES = 8, NTHREADS = 512;
constexpr int BATCH = 2, SEQ = 4096, DM = 2048, DFF = 5632, DEPTH = 4, MROWS = BATCH * SEQ;
constexpr int MEM_LEN = 256, MEMROWS = BATCH * MEM_LEN;
constexpr int IN_COLS = 12312, PROJ_N = 12288, NG_COL0 = 5632;
constexpr int NCMP = 255;
constexpr float NORM_EPS = 1e-6f;
enum { I_X = 0, I_MEM, I_F1N, I_F1G, I_F1U, I_F1D, I_MIXN, I_WIN, I_LAM, I_SUBLN, I_CPOS, I_CW1, I_CW2, I_MEMN, I_WMKV, I_WUD, I_WUN, I_WUM, I_WO, I_F2N, I_F2G, I_F2U, I_F2D, I_FINN, N_IN };

constexpr size_t MiB = 1u << 20;
constexpr size_t WS_CTL = 0, CTL_ZERO_BYTES = 64 * 1024;
constexpr size_t WS_WL = 2 * MiB, WL_STRIDE = 202 * MiB;
constexpr size_t WL_GU1 = 0, WL_D1 = 44 * MiB, WL_IN = 66 * MiB, WL_NG = 114 * MiB, WL_C1 = 115 * MiB, WL_C2 = 117 * MiB, WL_UP = 118 * MiB, WL_O = 128 * MiB, WL_GU2 = 136 * MiB, WL_D2 = 180 * MiB;
constexpr size_t WS_WMKV = WS_WL + DEPTH * WL_STRIDE;
constexpr size_t WS_X = WS_WMKV + 16 * MiB;
constexpr size_t WS_XB = WS_X + 64 * MiB;
constexpr size_t WS_SSQ = WS_XB + 32 * MiB;
constexpr size_t WS_H = WS_SSQ + 1 * MiB;
constexpr size_t WS_DQ = WS_H + 88 * MiB, WS_DK = WS_DQ + 16 * MiB, WS_DV = WS_DK + 16 * MiB, WS_NQ = WS_DV + 16 * MiB;
constexpr size_t WS_NKV = WS_NQ + 16 * MiB;
constexpr size_t WS_MQ = WS_NKV + 24 * MiB;
constexpr size_t WS_MG = WS_MQ + 8 * MiB;
constexpr size_t WS_NG = WS_MG + 96 * MiB;
constexpr size_t WS_KCMP = WS_NG + 1 * MiB;
constexpr size_t WS_HC = WS_KCMP + 1 * MiB;
constexpr size_t WS_MEMB = WS_HC + 1 * MiB;
constexpr size_t WS_MEMSSQ = WS_MEMB + 2 * MiB;
constexpr size_t WS_MEMKV = WS_MEMSSQ + 1 * MiB;
constexpr size_t WS_ACAT = WS_MEMKV + 4 * MiB;
constexpr size_t WS_MERGED = WS_ACAT + 40 * MiB;
constexpr size_t WS_MISC = WS_MERGED + 32 * MiB;
constexpr size_t WS_ACC = WS_MISC + 1 * MiB;
constexpr size_t WS_END = WS_ACC + 32 * MiB;
constexpr int CW_BAR = 4096;
constexpr int CW_CVT = 12288;
constexpr int CW_NRM = 13312;
constexpr int CW_Q = 8192;

constexpr int RING_OFF = 0, RING_BYTES = 131072;
constexpr int EPI_OFF = RING_BYTES, EPI_BYTES = 4096;
constexpr int SSQI_OFF = EPI_OFF + EPI_BYTES, SSQI_BYTES = 8192;
constexpr int LDSCTL_OFF = SSQI_OFF + SSQI_BYTES, MISC_OFF = LDSCTL_OFF + 320;
constexpr int LDS_BYTES = 147456;

#define GAS __attribute__((address_space(1)))
#define LAS __attribute__((address_space(3)))
typedef unsigned short bf16;
typedef unsigned v4u __attribute__((ext_vector_type(4)));
typedef float f32x4 __attribute__((ext_vector_type(4)));
typedef short bf16x8 __attribute__((ext_vector_type(8)));
typedef GAS unsigned gu32;
typedef GAS unsigned long long gu64;
#define RLX_AGENT __ATOMIC_RELAXED, __HIP_MEMORY_SCOPE_AGENT
#define LDS_WAIT() asm volatile("s_waitcnt lgkmcnt(0)" ::: "memory")
#define VM_WAIT() asm volatile("s_waitcnt vmcnt(0)" ::: "memory")
__device__ __forceinline__ unsigned long long rt() { return __builtin_amdgcn_s_memrealtime(); }
__device__ __forceinline__ unsigned f2bf(float f) { unsigned u = __builtin_bit_cast(unsigned, f); return (u + 0x7fffu + ((u >> 16) & 1u)) >> 16; }
__device__ __forceinline__ unsigned pk2(float lo, float hi) { return f2bf(lo) | (f2bf(hi) << 16); }

#define XB_TMO      128
#define XB_XCNT(j)  (256  + 64 * (j))
#define XB_XSUB(j)  (1280 + 64 * (j))
#define XB_XGEN(j)  (2304 + 64 * (j))
#define XB_TOP      3328
#define XB_TOPGEN   3392
#define XCD_BAR_WORDS 3456
#define XB_SPIN_CAP (1u << 18)

__device__ __forceinline__ unsigned xb_ld(unsigned* p)              { return __hip_atomic_load(p, __ATOMIC_RELAXED, __HIP_MEMORY_SCOPE_AGENT); }
__device__ __forceinline__ unsigned xb_add(unsigned* p, unsigned v) { return __hip_atomic_fetch_add(p, v, __ATOMIC_RELAXED, __HIP_MEMORY_SCOPE_AGENT); }
__device__ __forceinline__ unsigned xb_xcc_id() { return (unsigned)__builtin_amdgcn_s_getreg((3 << 11) | 20) & 0xFu; }
#define XB_SPIN(cond, bar) do { unsigned _sp = 0; while (cond) { __builtin_amdgcn_s_sleep(1); \
    if ((++_sp & 255u) == 0u) { if (xb_ld(&(bar)[XB_TMO])) break; if (_sp > XB_SPIN_CAP) { atomicAdd(&(bar)[XB_TMO], 1u); break; } } } } while (0)

struct XcdBarrier {
    unsigned* bar; unsigned x;
    volatile LAS unsigned* st;
};

__device__ __forceinline__ XcdBarrier xcd_barrier_post(unsigned* bar, volatile LAS unsigned* st) {
    XcdBarrier b; b.bar = bar; b.x = xb_xcc_id(); b.st = st;
    if (threadIdx.x == 0) (void)xb_add(&bar[XB_XCNT(b.x)], 1u);
    return b;
}
__device__ __forceinline__ void xcd_barrier_complete(unsigned* bar, unsigned x, unsigned& nloc, unsigned& nx) {
    const unsigned G = gridDim.x * gridDim.y * gridDim.z;
    unsigned sum, cnt, mine, sp = 0u;
    for (;;) {
        sum = 0u; cnt = 0u; mine = 0u;
#pragma unroll
        for (unsigned j = 0; j < 16; ++j) { const unsigned c = xb_ld(&bar[XB_XCNT(j)]); sum += c; cnt += (c > 0u) ? 1u : 0u; mine = (j == x) ? c : mine; }
        if (sum == G) break;
        __builtin_amdgcn_s_sleep(1);
        if ((++sp & 255u) == 0u) { if (xb_ld(&bar[XB_TMO])) break; if (sp > XB_SPIN_CAP) { atomicAdd(&bar[XB_TMO], 1u); break; } }
    }
    nloc = mine > 0u ? mine : 1u; nx = cnt > 0u ? cnt : 1u;
}

__device__ __forceinline__ void xcd_barrier(const XcdBarrier& b) {
    asm volatile("s_waitcnt vmcnt(0)" ::: "memory");
    __syncthreads();
    if (threadIdx.x == 0) {
        unsigned* bar = b.bar;
        __builtin_amdgcn_s_waitcnt(0);
        unsigned nloc = b.st[0], nx = b.st[1];
        if (nloc == 0u) { xcd_barrier_complete(bar, b.x, nloc, nx); b.st[0] = nloc; b.st[1] = nx; }
        const unsigned old = xb_add(&bar[XB_XSUB(b.x)], 1u);
        const unsigned gen = old / nloc;
        if (old + 1u == (gen + 1u) * nloc) {
            __builtin_amdgcn_fence(__ATOMIC_RELEASE, "agent");
            asm volatile("s_waitcnt vmcnt(0)" ::: "memory");
            const unsigned og = xb_add(&bar[XB_TOP], 1u);
            const unsigned tg = og / nx;
            if (og + 1u == (tg + 1u) * nx) xb_add(&bar[XB_TOPGEN], 1u);
            else XB_SPIN(xb_ld(&bar[XB_TOPGEN]) == tg, bar);
            __builtin_amdgcn_fence(__ATOMIC_ACQUIRE, "agent");
            xb_add(&bar[XB_XGEN(b.x)], 1u);
            asm volatile("s_waitcnt vmcnt(0)" ::: "memory");
        } else {
            XB_SPIN(xb_ld(&bar[XB_XGEN(b.x)]) == gen, bar);
            __builtin_amdgcn_fence(__ATOMIC_ACQUIRE, "agent");
            asm volatile("s_waitcnt vmcnt(0)" ::: "memory");
        }
    }
    __syncthreads();
}

__device__ __forceinline__ float wave_sum(float v) {
#pragma unroll
    for (int o = 1; o < 64; o <<= 1) v += __shfl_xor(v, o);
    return v;
}
__device__ __forceinline__ float bf2f(unsigned short u) { return __uint_as_float(((unsigned)u) << 16); }
__device__ __forceinline__ float blo(unsigned w) { return __uint_as_float(w << 16); }
__device__ __forceinline__ float bhi(unsigned w) { return __uint_as_float(w & 0xffff0000u); }
__device__ __forceinline__ float gelu_tanh(float v) { const float u = 0.7978845608028654f * (v + 0.044715f * v * v * v); return 0.5f * v * (1.0f + tanhf(u)); }

constexpr size_t FRAG_FLAG = (size_t)1 << 41;
constexpr size_t TILED_FLAG = (size_t)1 << 40;
__device__ __forceinline__ void cvt_item(const float* W, size_t ldw, int k0, int c0, int ncv, int nrv, const float* scale, bf16* WT, size_t ldt, int r0, int kd0, int lane) {
    const int n4 = (lane & 15) * 4, kr = lane >> 4; f32x4 v[16];
#pragma unroll
    for (int i = 0; i < 16; ++i) { const int k = k0 + 16 * kr + i; v[i] = (n4 < ncv) ? *(const GAS f32x4*)(W + (size_t)k * ldw + c0 + n4) : (f32x4){0.f, 0.f, 0.f, 0.f}; }
    if (scale) {
#pragma unroll
        for (int i = 0; i < 16; ++i) v[i] = v[i] * scale[k0 + 16 * kr + i]; }
    if (n4 < nrv) {
#pragma unroll
        for (int e = 0; e < 4; ++e) { v4u o0, o1; o0.x = pk2(v[0][e], v[1][e]); o0.y = pk2(v[2][e], v[3][e]); o0.z = pk2(v[4][e], v[5][e]); o0.w = pk2(v[6][e], v[7][e]);
            o1.x = pk2(v[8][e], v[9][e]); o1.y = pk2(v[10][e], v[11][e]); o1.z = pk2(v[12][e], v[13][e]); o1.w = pk2(v[14][e], v[15][e]);
            const int n = r0 + n4 + e; GAS v4u* dp;
            if (ldt & TILED_FLAG) { const size_t KT = (size_t)(ldt & ~TILED_FLAG) / 64;
                dp = (GAS v4u*)(WT + ((((size_t)(n >> 8) * KT + (size_t)((kd0 + k0) >> 6)) * 256 + (n & 255)) * 64 + 16 * kr)); }
            else if (ldt & FRAG_FLAG) { const int k = k0 + 16 * kr;
                GAS bf16* fp = (GAS bf16*)WT + ((((size_t)((k >> 9) * 16 + ((k >> 5) & 15)) * 8 + (size_t)(n >> 4)) * 64 + (size_t)((n & 15) + 16 * ((k >> 3) & 3))) * 8);
                *(GAS v4u*)fp = o0; *(GAS v4u*)(fp + 128) = o1; continue; }
            else dp = (GAS v4u*)(WT + (size_t)n * ldt + kd0 + k0 + 16 * kr);
            dp[0] = o0; dp[1] = o1; } }
}
__device__ __forceinline__ void cvt_item_t(const float* W, size_t ldw, int k0, int c0, const float* scale, bf16* WT, size_t KT, int r0, int kd0, int lane, LAS unsigned char* scr) {
    const int n4 = (lane & 15) * 4, kr = lane >> 4; f32x4 v[16];
#pragma unroll
    for (int i = 0; i < 16; ++i) { const int k = k0 + 16 * kr + i; v[i] = *(const GAS f32x4*)(W + (size_t)k * ldw + c0 + n4); }
    if (scale) {
#pragma unroll
        for (int i = 0; i < 16; ++i) v[i] = v[i] * scale[k0 + 16 * kr + i]; }
#pragma unroll
    for (int e = 0; e < 4; ++e) { v4u o0, o1; o0.x = pk2(v[0][e], v[1][e]); o0.y = pk2(v[2][e], v[3][e]); o0.z = pk2(v[4][e], v[5][e]); o0.w = pk2(v[6][e], v[7][e]);
        o1.x = pk2(v[8][e], v[9][e]); o1.y = pk2(v[10][e], v[11][e]); o1.z = pk2(v[12][e], v[13][e]); o1.w = pk2(v[14][e], v[15][e]);
        LAS v4u* lp = (LAS v4u*)(scr + (n4 + e) * 144 + kr * 32); lp[0] = o0; lp[1] = o1; }
    asm volatile("s_waitcnt lgkmcnt(0)" ::: "memory");
    const int rr = lane >> 3, p = lane & 7;
    GAS v4u* dp = (GAS v4u*)(WT + (((size_t)(r0 >> 8) * KT + (size_t)((kd0 + k0) >> 6)) * 256 + (r0 & 255)) * 64) + lane;
    v4u t[8];
#pragma unroll
    for (int j = 0; j < 8; ++j) t[j] = *(const LAS v4u*)(scr + (8 * j + rr) * 144 + p * 16);
#pragma unroll
    for (int j = 0; j < 8; ++j) dp[64 * j] = t[j];
    asm volatile("s_waitcnt lgkmcnt(0)" ::: "memory");
}
__device__ __forceinline__ void cvt_dispatch(const float* W, int ldw, int nblk, const float* scale, bf16* WT, size_t ldt, int kd0, int mode, int it, int lane, LAS unsigned char* scr) {
    const int kb = it / nblk, nb = it % nblk, n0 = 64 * nb; int c0 = n0, r0 = n0, ncv = 64, nrv = 64;
    if (mode == 1) r0 = 256 * (n0 >> 7) + (n0 & 127);
    else if (mode == 2) r0 = 256 * (n0 >> 7) + 128 + (n0 & 127);
    else if (mode == 3) c0 = (n0 < NG_COL0) ? n0 : n0 + 24;
    else if (mode == 4) { c0 = NG_COL0; ncv = 24; nrv = 32; }
    if ((ldt & TILED_FLAG) && mode != 4) cvt_item_t(W, (size_t)ldw, 64 * kb, c0, scale, WT, (size_t)(ldt & ~TILED_FLAG) / 64, r0, kd0, lane, scr);
    else cvt_item(W, (size_t)ldw, 64 * kb, c0, ncv, nrv, scale, WT, ldt, r0, kd0, lane);
}
__device__ __forceinline__ void cvt_job(const float* W, int K, int ldw, int nblk, const float* scale, bf16* WT, size_t ldt, int kd0, int mode, LAS float* scr, int gw, int NGW, int lane) {
    const int nit = (K / 64) * nblk;
    for (int it = gw; it < nit; it += NGW) cvt_dispatch(W, ldw, nblk, scale, WT, ldt, kd0, mode, it, lane, (LAS unsigned char*)scr);
}

constexpr int CI_U1 = 2816, CI_D1 = 5632, CI_IN = 8448, CI_NG = 14592, CI_C1 = 14624, CI_C2 = 14880, CI_UD = 14888, CI_UN = 15400, CI_UM = 15912, CI_O = 16168, CI_G2 = 17192, CI_U2 = 20008, CI_D2 = 22824, CVT_ITEMS = 25640;
template <class ArgsT> __device__ __forceinline__ void cvt_layer_item(const ArgsT& args, unsigned char* ws, int l, int item, int lane, LAS unsigned char* scr) {
    unsigned char* wl = ws + WS_WL + (size_t)l * WL_STRIDE;
    const float* W; const float* scale = nullptr; bf16* WT; int ldw, nblk, it, kd0 = 0, mode = 0; size_t ldt;
    if (item < CI_U1)      { it = item;         W = args.in[I_F1G] + (size_t)l * DM * DFF; ldw = DFF; nblk = DFF / 64; scale = args.in[I_F1N] + l * DM; WT = (bf16*)(wl + WL_GU1); ldt = DM | TILED_FLAG; mode = 1; }
    else if (item < CI_D1) { it = item - CI_U1; W = args.in[I_F1U] + (size_t)l * DM * DFF; ldw = DFF; nblk = DFF / 64; scale = args.in[I_F1N] + l * DM; WT = (bf16*)(wl + WL_GU1); ldt = DM | TILED_FLAG; mode = 2; }
    else if (item < CI_IN) { it = item - CI_D1; W = args.in[I_F1D] + (size_t)l * DM * DFF; ldw = DM; nblk = DM / 64; WT = (bf16*)(wl + WL_D1); ldt = DFF | TILED_FLAG; }
    else if (item < CI_NG) { it = item - CI_IN; W = args.in[I_WIN] + (size_t)l * DM * IN_COLS; ldw = IN_COLS; nblk = PROJ_N / 64; scale = args.in[I_MIXN] + l * DM; WT = (bf16*)(wl + WL_IN); ldt = DM | TILED_FLAG; mode = 3; }
    else if (item < CI_C1) { it = item - CI_NG; W = args.in[I_WIN] + (size_t)l * DM * IN_COLS; ldw = IN_COLS; nblk = 1; scale = args.in[I_MIXN] + l * DM; WT = (bf16*)(wl + WL_NG); ldt = DM; mode = 4; }
    else if (item < CI_C2) { it = item - CI_C1; const int kv = it >> 7; it &= 127; W = args.in[I_CW1] + (size_t)(l * 2 + kv) * 4096 * 128; ldw = 128; nblk = 2; WT = (bf16*)(wl + WL_C1) + (size_t)kv * 128 * 4096; ldt = 4096 | FRAG_FLAG; }
    else if (item < CI_UD) { it = item - CI_C2; const int kv = it >> 2; it &= 3; W = args.in[I_CW2] + (size_t)(l * 2 + kv) * 128 * 128; ldw = 128; nblk = 2; WT = (bf16*)(wl + WL_C2) + (size_t)kv * 128 * 128; ldt = 128; }
    else if (item < CI_UN) { it = item - CI_UD; W = args.in[I_WUD] + (size_t)l * 1024 * DM; ldw = DM; nblk = 32; WT = (bf16*)(wl + WL_UP); ldt = 2560 | TILED_FLAG; }
    else if (item < CI_UM) { it = item - CI_UN; W = args.in[I_WUN] + (size_t)l * 1024 * DM; ldw = DM; nblk = 32; WT = (bf16*)(wl + WL_UP); ldt = 2560 | TILED_FLAG; kd0 = 1024; }
    else if (item < CI_O)  { it = item - CI_UM; W = args.in[I_WUM] + (size_t)l * 512 * DM; ldw = DM; nblk = 32; WT = (bf16*)(wl + WL_UP); ldt = 2560 | TILED_FLAG; kd0 = 2048; }
    else if (item < CI_G2) { it = item - CI_O;  W = args.in[I_WO] + (size_t)l * DM * DM; ldw = DM; nblk = 32; WT = (bf16*)(wl + WL_O); ldt = DM | TILED_FLAG; }
    else if (item < CI_U2) { it = item - CI_G2; W = args.in[I_F2G] + (size_t)l * DM * DFF; ldw = DFF; nblk = DFF / 64; scale = args.in[I_F2N] + l * DM; WT = (bf16*)(wl + WL_GU2); ldt = DM | TILED_FLAG; mode = 1; }
    else if (item < CI_D2) { it = item - CI_U2; W = args.in[I_F2U] + (size_t)l * DM * DFF; ldw = DFF; nblk = DFF / 64; scale = args.in[I_F2N] + l * DM; WT = (bf16*)(wl + WL_GU2); ldt = DM | TILED_FLAG; mode = 2; }
    else                   { it = item - CI_D2; W = args.in[I_F2D] + (size_t)l * DM * DFF; ldw = DM; nblk = DM / 64; WT = (bf16*)(wl + WL_D2); ldt = DFF | TILED_FLAG; }
    cvt_dispatch(W, ldw, nblk, scale, WT, ldt, kd0, mode, it, lane, scr);
}

struct CvtD { const float* W; const float* scale; bf16* WT; size_t ldt; int ldw, kd0, k0, c0, r0, ncv, nrv, tiled, sidx; };
template <class ArgsT> __device__ __forceinline__ void cvt_desc(const ArgsT& args, unsigned char* ws, int l, int item, CvtD& d) {
    unsigned char* wl = ws + WS_WL + (size_t)l * WL_STRIDE;
    const float* W; const float* scale = nullptr; bf16* WT; int ldw, nblk, it, kd0 = 0, mode = 0; size_t ldt;
    if (item < CI_U1)      { it = item;         W = args.in[I_F1G] + (size_t)l * DM * DFF; ldw = DFF; nblk = DFF / 64; scale = args.in[I_F1N] + l * DM; WT = (bf16*)(wl + WL_GU1); ldt = DM | TILED_FLAG; mode = 1; }
    else if (item < CI_D1) { it = item - CI_U1; W = args.in[I_F1U] + (size_t)l * DM * DFF; ldw = DFF; nblk = DFF / 64; scale = args.in[I_F1N] + l * DM; WT = (bf16*)(wl + WL_GU1); ldt = DM | TILED_FLAG; mode = 2; }
    else if (item < CI_IN) { it = item - CI_D1; W = args.in[I_F1D] + (size_t)l * DM * DFF; ldw = DM; nblk = DM / 64; WT = (bf16*)(wl + WL_D1); ldt = DFF | TILED_FLAG; }
    else if (item < CI_NG) { it = item - CI_IN; W = args.in[I_WIN] + (size_t)l * DM * IN_COLS; ldw = IN_COLS; nblk = PROJ_N / 64; scale = args.in[I_MIXN] + l * DM; WT = (bf16*)(wl + WL_IN); ldt = DM | TILED_FLAG; mode = 3; }
    else if (item < CI_C1) { it = item - CI_NG; W = args.in[I_WIN] + (size_t)l * DM * IN_COLS; ldw = IN_COLS; nblk = 1; scale = args.in[I_MIXN] + l * DM; WT = (bf16*)(wl + WL_NG); ldt = DM; mode = 4; }
    else if (item < CI_C2) { it = item - CI_C1; const int kv = it >> 7; it &= 127; W = args.in[I_CW1] + (size_t)(l * 2 + kv) * 4096 * 128; ldw = 128; nblk = 2; WT = (bf16*)(wl + WL_C1) + (size_t)kv * 128 * 4096; ldt = 4096 | FRAG_FLAG; }
    else if (item < CI_UD) { it = item - CI_C2; const int kv = it >> 2; it &= 3; W = args.in[I_CW2] + (size_t)(l * 2 + kv) * 128 * 128; ldw = 128; nblk = 2; WT = (bf16*)(wl + WL_C2) + (size_t)kv * 128 * 128; ldt = 128; }
    else if (item < CI_UN) { it = item - CI_UD; W = args.in[I_WUD] + (size_t)l * 1024 * DM; ldw = DM; nblk = 32; WT = (bf16*)(wl + WL_UP); ldt = 2560 | TILED_FLAG; }
    else if (item < CI_UM) { it = item - CI_UN; W = args.in[I_WUN] + (size_t)l * 1024 * DM; ldw = DM; nblk = 32; WT = (bf16*)(wl + WL_UP); ldt = 2560 | TILED_FLAG; kd0 = 1024; }
    else if (item < CI_O)  { it = item - CI_UM; W = args.in[I_WUM] + (size_t)l * 512 * DM; ldw = DM; nblk = 32; WT = (bf16*)(wl + WL_UP); ldt = 2560 | TILED_FLAG; kd0 = 2048; }
    else if (item < CI_G2) { it = item - CI_O;  W = args.in[I_WO] + (size_t)l * DM * DM; ldw = DM; nblk = 32; WT = (bf16*)(wl + WL_O); ldt = DM | TILED_FLAG; }
    else if (item < CI_U2) { it = item - CI_G2; W = args.in[I_F2G] + (size_t)l * DM * DFF; ldw = DFF; nblk = DFF / 64; scale = args.in[I_F2N] + l * DM; WT = (bf16*)(wl + WL_GU2); ldt = DM | TILED_FLAG; mode = 1; }
    else if (item < CI_D2) { it = item - CI_U2; W = args.in[I_F2U] + (size_t)l * DM * DFF; ldw = DFF; nblk = DFF / 64; scale = args.in[I_F2N] + l * DM; WT = (bf16*)(wl + WL_GU2); ldt = DM | TILED_FLAG; mode = 2; }
    else                   { it = item - CI_D2; W = args.in[I_F2D] + (size_t)l * DM * DFF; ldw = DM; nblk = DM / 64; WT = (bf16*)(wl + WL_D2); ldt = DFF | TILED_FLAG; }
    const int kb = it / nblk, nb = it % nblk, n0 = 64 * nb; int c0 = n0, r0 = n0, ncv = 64, nrv = 64;
    if (mode == 1) r0 = 256 * (n0 >> 7) + (n0 & 127);
    else if (mode == 2) r0 = 256 * (n0 >> 7) + 128 + (n0 & 127);
    else if (mode == 3) c0 = (n0 < NG_COL0) ? n0 : n0 + 24;
    else if (mode == 4) { c0 = NG_COL0; ncv = 24; nrv = 32; }
    d.sidx = (scale == nullptr) ? 0 : ((item < CI_D1) ? 1 : ((item < CI_C1) ? 2 : 3));
    d.W = W; d.scale = scale; d.WT = WT; d.ldt = ldt; d.ldw = ldw; d.kd0 = kd0; d.k0 = 64 * kb; d.c0 = c0; d.r0 = r0; d.ncv = ncv; d.nrv = nrv; d.tiled = ((ldt & TILED_FLAG) && mode != 4) ? 1 : 0;
}
__device__ __forceinline__ void cvt_ld(const CvtD& d, int lane, f32x4 (&v)[16]) {
    if (!d.tiled) return;
    const int n4 = (lane & 15) * 4, kr = lane >> 4; const GAS float* p = (const GAS float*)d.W + (size_t)(d.k0 + 16 * kr) * d.ldw + d.c0 + n4;
#pragma unroll
    for (int i = 0; i < 16; ++i) v[i] = __builtin_nontemporal_load((const GAS f32x4*)(p + (size_t)i * d.ldw));
}
__device__ __forceinline__ void cvt_fin(const CvtD& d, int lane, const f32x4 (&v)[16], LAS unsigned char* scr, const LAS float* gains  ) {
    if (!d.tiled) { cvt_item(d.W, (size_t)d.ldw, d.k0, d.c0, d.ncv, d.nrv, d.scale, d.WT, d.ldt, d.r0, d.kd0, lane); return; }
    const int n4 = (lane & 15) * 4, kr = lane >> 4; f32x4 sv[4];
    if (d.sidx) {
#pragma unroll
        for (int q = 0; q < 4; ++q) sv[q] = *(const LAS f32x4*)(gains + (d.sidx - 1) * 2048 + d.k0 + 16 * kr + 4 * q); }
    else {
#pragma unroll
        for (int q = 0; q < 4; ++q) sv[q] = (f32x4){1.f, 1.f, 1.f, 1.f}; }
#pragma unroll
    for (int e = 0; e < 4; ++e) { v4u o0, o1;
#define CP_(a) pg8::cvt_pk_bf16(v[a][e] * sv[(a) >> 2][(a) & 3], v[(a) + 1][e] * sv[((a) + 1) >> 2][((a) + 1) & 3])
        o0.x = CP_(0); o0.y = CP_(2); o0.z = CP_(4); o0.w = CP_(6); o1.x = CP_(8); o1.y = CP_(10); o1.z = CP_(12); o1.w = CP_(14);
#undef CP_
        LAS v4u* lp = (LAS v4u*)(scr + (n4 + e) * 144 + kr * 32); lp[0] = o0; lp[1] = o1; }
    asm volatile("s_waitcnt lgkmcnt(0)" ::: "memory");
    const int rr = lane >> 3, p = lane & 7; const size_t KT = (size_t)(d.ldt & ~TILED_FLAG) / 64;
    GAS v4u* dp = (GAS v4u*)(d.WT + (((size_t)(d.r0 >> 8) * KT + (size_t)((d.kd0 + d.k0) >> 6)) * 256 + (d.r0 & 255)) * 64) + lane;
    v4u t[8];
#pragma unroll
    for (int q = 0; q < 8; ++q) t[q] = *(const LAS v4u*)(scr + (8 * q + rr) * 144 + p * 16);
#pragma unroll
    for (int q = 0; q < 8; ++q) __builtin_nontemporal_store(t[q], dp + 64 * q);
    asm volatile("s_waitcnt lgkmcnt(0)" ::: "memory");
}
template <class ArgsT> __device__ __forceinline__ void cvt_pull(const ArgsT& args, unsigned char* ws, int L, gu32* ctr, int tid, LAS unsigned char* ring) {
    static_assert(CVT_ITEMS % 8 == 0, "cvt_pull takes eight items per pull");
    const int lane = tid & 63, wave = __builtin_amdgcn_readfirstlane(tid >> 6);
    LAS unsigned char* scr = ring + wave * 9216; LAS float* gains = (LAS float*)(ring + 8 * 9216);
    for (int i = tid; i < 3 * 2048; i += NTHREADS) { const int g = i >> 11, k = i & 2047; gains[i] = (g == 0 ? args.in[I_F1N] : (g == 1 ? args.in[I_MIXN] : args.in[I_F2N]))[L * DM + k]; }
    __syncthreads();
    for (;;) { unsigned b0 = 0u; if (lane == 0) b0 = __hip_atomic_fetch_add(ctr, 8u, __ATOMIC_RELAXED, __HIP_MEMORY_SCOPE_AGENT);
        const int base = (int)__builtin_amdgcn_readfirstlane((int)b0); if (base >= CVT_ITEMS) break;
        CvtD dA, dB; f32x4 vA[16], vB[16];
        cvt_desc(args, ws, L, base, dA); cvt_ld(dA, lane, vA);
#pragma unroll 1
        for (int jj = 0; jj < 4; ++jj) {
            cvt_desc(args, ws, L, base + 2 * jj + 1, dB); cvt_ld(dB, lane, vB);
            cvt_fin(dA, lane, vA, scr, gains);
            if (jj < 3) { cvt_desc(args, ws, L, base + 2 * jj + 2, dA); cvt_ld(dA, lane, vA); }
            cvt_fin(dB, lane, vB, scr, gains); } }
    __syncthreads();
}

namespace att {
typedef short bf16x8 __attribute__((ext_vector_type(8)));
typedef short s16x4 __attribute__((ext_vector_type(4)));
typedef float f32x16 __attribute__((ext_vector_type(16)));
typedef unsigned u32x4 __attribute__((ext_vector_type(4)));
#define KSWZ(row, colB) ((row) * 256 + ((colB) ^ (((row) & 7) << 4)))
#define SBAR() __builtin_amdgcn_sched_barrier(0)
constexpr int SHM_T = 16384;
constexpr int L_V = 0, L_K = 3 * SHM_T, L_WS = 6 * SHM_T, L_IMP = L_WS + 8 * 256, L_SEL = L_IMP + 64 * 65 * 4, L_MISC = L_SEL + 512, L_END = L_MISC + 64, L_STG = 65536  , L_TOP = L_STG + 4 * 8192;
static_assert(L_END <= 131072 && L_TOP <= L_WS, "attention LDS map");
constexpr float LOG2E = 1.4426950408889634f;
__device__ __forceinline__ int crow(int r, int hi) { return (r & 3) + 8 * (r >> 2) + 4 * hi; }
__device__ __forceinline__ unsigned cvtpk(float lo, float hi) { return pg8::cvt_pk_bf16(lo, hi); }
__device__ __forceinline__ int v_st(int k, int c) { const int kk = (k & ~0xC) | ((k & 4) << 1) | ((k & 8) >> 1); return ((kk >> 3) * 4 + (c >> 5)) * 512 + ((kk & 7) * 32 + (c & 31)) * 2; }
__device__ __forceinline__ int v_rd_base(int lane) { return ((lane & 3) << 3) | (((lane >> 2) & 3) << 6) | (((lane >> 4) & 1) << 5) | (((lane >> 5) & 1) << 8); }
constexpr int v_rd_off(int d0, int ks, int half) { return d0 * 512 + ks * 4096 + half * 2048; }
template <int OFF> __device__ __forceinline__ s16x4 tr_read(int vb) { s16x4 r; asm volatile("ds_read_b64_tr_b16 %0, %1 offset:%2" : "=&v"(r) : "v"(vb), "i"(OFF) : "memory"); return r; }
template <int D0> __device__ __forceinline__ void pv_one(f32x16& od, int vb, bf16x8 pa0, bf16x8 pa1, bf16x8 pa2, bf16x8 pa3) {
  const s16x4 l0 = tr_read<v_rd_off(D0, 0, 0)>(vb), h0 = tr_read<v_rd_off(D0, 0, 1)>(vb), l1 = tr_read<v_rd_off(D0, 1, 0)>(vb), h1 = tr_read<v_rd_off(D0, 1, 1)>(vb);
  const s16x4 l2 = tr_read<v_rd_off(D0, 2, 0)>(vb), h2 = tr_read<v_rd_off(D0, 2, 1)>(vb), l3 = tr_read<v_rd_off(D0, 3, 0)>(vb), h3 = tr_read<v_rd_off(D0, 3, 1)>(vb);
  asm volatile("s_waitcnt lgkmcnt(0)" ::: "memory"); SBAR();
#define PK(L, H) (bf16x8){L[0], L[1], L[2], L[3], H[0], H[1], H[2], H[3]}
  od = __builtin_amdgcn_mfma_f32_32x32x16_bf16(pa0, PK(l0, h0), od, 0, 0, 0);
  od = __builtin_amdgcn_mfma_f32_32x32x16_bf16(pa1, PK(l1, h1), od, 0, 0, 0);
  od = __builtin_amdgcn_mfma_f32_32x32x16_bf16(pa2, PK(l2, h2), od, 0, 0, 0);
  od = __builtin_amdgcn_mfma_f32_32x32x16_bf16(pa3, PK(l3, h3), od, 0, 0, 0);
#undef PK
}
__device__ __forceinline__ void pv_d0(f32x16 (&o)[4], int vb, bf16x8 pa0, bf16x8 pa1, bf16x8 pa2, bf16x8 pa3) {
  pv_one<0>(o[0], vb, pa0, pa1, pa2, pa3); pv_one<1>(o[1], vb, pa0, pa1, pa2, pa3); pv_one<2>(o[2], vb, pa0, pa1, pa2, pa3); pv_one<3>(o[3], vb, pa0, pa1, pa2, pa3);
}
typedef float f32x4_t __attribute__((ext_vector_type(4)));
typedef __attribute__((address_space(3))) const bf16x8* lds_frag_ptr;
typedef __attribute__((address_space(3))) float lds_f32;
typedef __attribute__((address_space(3))) unsigned short lds_u16;
typedef __attribute__((address_space(3))) unsigned long long lds_u64;
typedef __attribute__((address_space(3))) char lds_char;
__device__ __forceinline__ void k_addr(int (&ka)[4], int kbase  , int r32, int hi) {
#pragma unroll
  for (int j = 0; j < 4; ++j) ka[j] = kbase + r32 * 256 + ((j * 32 + hi * 16) ^ ((r32 & 7) << 4));
}
template <int ND0> __device__ __forceinline__ void qkt(f32x16& p0, f32x16& p1, const int (&ka)[4], const bf16x8 (&qr)[ND0]) {
#pragma unroll
  for (int h = 0; h < ND0; h += 4) { bf16x8 kb0[4], kb1[4];
#pragma unroll
    for (int j = 0; j < 4; ++j) { kb0[j] = *(lds_frag_ptr)(unsigned)(ka[(h + j) & 3] + ((h + j) >> 2) * 128); kb1[j] = *(lds_frag_ptr)(unsigned)(ka[(h + j) & 3] + ((h + j) >> 2) * 128 + 8192); }
    SBAR();
#pragma unroll
    for (int j = 0; j < 4; ++j) { p0 = __builtin_amdgcn_mfma_f32_32x32x16_bf16(kb0[j], qr[h + j], p0, 0, 0, 0); p1 = __builtin_amdgcn_mfma_f32_32x32x16_bf16(kb1[j], qr[h + j], p1, 0, 0, 0); }
  }
}
template <int ND0, bool BIAS, bool SELM>
__device__ __forceinline__ void run_tiles(char* lds, const bf16* Kg, const bf16* Vg, size_t ldk, size_t ldv, unsigned long long tmask, const bf16x8 (&qr)[ND0], int dbase,
                                          float slope2, int q, int klo, int khi, int klo_max, int khi_min, unsigned long long selq,
                                          f32x16 (&o)[4], float& m_reg, float& l_reg, int tid_in) {
  int tid = tid_in; asm volatile("" : "+v"(tid)); const int lane = tid & 63;
  const int r32 = lane & 31, hi = lane >> 5, wid = __builtin_amdgcn_readfirstlane(tid >> 6);
  const int vb0 = (int)(uintptr_t)(lds + L_V) + v_rd_base(lane);
  int kinv[4]; k_addr(kinv, (int)(uintptr_t)(lds + L_K) + (dbase >> 2) * 128, r32, hi);
  lds_f32* al_l = (lds_f32*)(lds + L_WS) + wid * 64;
  if (tmask == 0ull) return;
  m_reg = 0.f;
  const int wu = wid;
  unsigned koff[2], voff[2];
#pragma unroll
  for (int i = 0; i < 2; ++i) { const int pc = wu + 8 * i;
    const int krow = pc * 4 + (lane >> 4), kcol = ((lane & 15) ^ (krow & 7)) * 8; koff[i] = (unsigned)(krow * (int)ldk + kcol);
    const int sub = pc * 2 + (lane >> 5), kk = (sub >> 2) * 8 + ((lane & 31) >> 2), vk = (kk & ~0xC) | ((kk & 4) << 1) | ((kk & 8) >> 1), vc = (sub & 3) * 32 + (lane & 3) * 8; voff[i] = (unsigned)(vk * (int)ldv + vc); }
  typedef __attribute__((address_space(3))) unsigned lds_u32;
  lds_u32* ldsa = (lds_u32*)lds;
#define DMA_K(key0, b) do { _Pragma("unroll") for (int i_ = 0; i_ < 2; ++i_) \
    __builtin_amdgcn_global_load_lds((const unsigned*)(Kg + (size_t)(key0) * ldk + koff[i_]), (lds_u32*)((__attribute__((address_space(3))) char*)ldsa + L_K + (b) * SHM_T + (wu + 8 * i_) * 1024), 16, 0, 0); } while (0)
#define DMA_V(key0, b) do { _Pragma("unroll") for (int i_ = 0; i_ < 2; ++i_) \
    __builtin_amdgcn_global_load_lds((const unsigned*)(Vg + (size_t)(key0) * ldv + voff[i_]), (lds_u32*)((__attribute__((address_space(3))) char*)ldsa + L_V + (b) * SHM_T + (wu + 8 * i_) * 1024), 16, 0, 0); } while (0)
#define QK(P0, P1, tt, kb) do { const float b0_ = (BIAS ? slope2 * (float)((tt) * 64 + 4 * hi - q) : 0.f) - m_reg;     \
    _Pragma("unroll") for (int r = 0; r < 16; ++r) { const int cr = (r & 3) + 8 * (r >> 2); P0[r] = BIAS ? fmaf(slope2, (float)cr, b0_) : b0_; P1[r] = BIAS ? fmaf(slope2, (float)(cr + 32), b0_) : b0_; } \
    int ka_[4]; _Pragma("unroll") for (int j = 0; j < 4; ++j) ka_[j] = kinv[j] + (kb) * SHM_T; \
    qkt<ND0>(P0, P1, ka_, qr); } while (0)
#define SM_PV(P0, P1, tt, vbuf, Q0, Q1) do { const int tb = (tt) * 64;     \
    bool selb = true; if (SELM) selb = ((selq >> (tt)) & 1ull) != 0ull; \
    if ((tb < klo_max) || (tb + 63 > khi_min)) { \
      const bool lv = selb && (khi >= klo); const unsigned span = lv ? (unsigned)(khi - klo) : 0u; const int lo_t = lv ? (klo - tb - 4 * hi) : 1000000; \
      _Pragma("unroll") for (int r = 0; r < 16; ++r) { const int cr = (r & 3) + 8 * (r >> 2); \
        P0[r] = ((unsigned)(cr - lo_t) <= span) ? P0[r] : -INFINITY; P1[r] = ((unsigned)(cr + 32 - lo_t) <= span) ? P1[r] : -INFINITY; } } \
    else if (SELM && !__all(selb)) {   \
      _Pragma("unroll") for (int r = 0; r < 16; ++r) { P0[r] = selb ? P0[r] : -INFINITY; P1[r] = selb ? P1[r] : -INFINITY; } } \
    float pmax = fmaxf(P0[0], P1[0]); \
    _Pragma("unroll") for (int r = 1; r < 16; ++r) pmax = fmaxf(fmaxf(pmax, P0[r]), P1[r]); \
    { auto rr = __builtin_amdgcn_permlane32_swap(__float_as_uint(pmax), __float_as_uint(pmax), false, false); pmax = fmaxf(__uint_as_float(rr[0]), __uint_as_float(rr[1])); } \
      \
    const bool fresh_ = (l_reg == 0.f), move_ = (pmax > 8.0f) || (fresh_ && pmax > -INFINITY); \
    const float d_ = move_ ? pmax : 0.f, alpha = (move_ && !fresh_) ? __builtin_amdgcn_exp2f(-d_) : 1.f; m_reg += d_; \
    if (__any(move_)) { _Pragma("unroll") for (int r = 0; r < 16; ++r) { P0[r] -= d_; P1[r] -= d_; Q0[r] -= d_; Q1[r] -= d_; } } \
    _Pragma("unroll") for (int r = 0; r < 16; ++r) { P0[r] = __builtin_amdgcn_exp2f(P0[r]); P1[r] = __builtin_amdgcn_exp2f(P1[r]); } \
    float ps; { typedef float f32x2_ __attribute__((ext_vector_type(2))); f32x2_ s2 = {0.f, 0.f}; \
      _Pragma("unroll") for (int r = 0; r < 16; r += 2) { s2 += (f32x2_){P0[r], P0[r + 1]}; s2 += (f32x2_){P1[r], P1[r + 1]}; } ps = s2.x + s2.y; } \
    { auto rr = __builtin_amdgcn_permlane32_swap(__float_as_uint(ps), __float_as_uint(ps), false, false); ps = __uint_as_float(rr[0]) + __uint_as_float(rr[1]); } \
    l_reg = l_reg * alpha + ps; \
    bf16x8 pa0, pa1, pa2, pa3; \
    PK4(P0, 0, pa0); PK4(P0, 8, pa1); PK4(P1, 0, pa2); PK4(P1, 8, pa3); \
    if (__any(alpha < 1.f)) { if (hi == 0) al_l[r32] = alpha; asm volatile("s_waitcnt lgkmcnt(0)" ::: "memory"); \
      _Pragma("unroll") for (int d = 0; d < 4; ++d) _Pragma("unroll") for (int r = 0; r < 16; ++r) o[d][r] *= al_l[crow(r, hi)]; } \
    pv_d0(o, vb0 + (vbuf) * SHM_T, pa0, pa1, pa2, pa3); } while (0)
#define PK4(P, BASE, OUT) do { unsigned a0 = cvtpk(P[BASE + 0], P[BASE + 1]), a1 = cvtpk(P[BASE + 2], P[BASE + 3]);   \
    unsigned b0_ = cvtpk(P[BASE + 4], P[BASE + 5]), b1_ = cvtpk(P[BASE + 6], P[BASE + 7]);                              \
    auto r0 = __builtin_amdgcn_permlane32_swap(a0, b0_, false, false); auto r1 = __builtin_amdgcn_permlane32_swap(a1, b1_, false, false); \
    u32x4 w = {r0[0], r1[0], r0[1], r1[1]}; OUT = *reinterpret_cast<bf16x8*>(&w); } while (0)
#define NEXT_TILE(var) do { var = -1; if (tmask != 0ull) { var = 63 - (int)__builtin_clzll(tmask); tmask &= ~(1ull << var); } } while (0)
#define WAIT_BAR() do { asm volatile("s_waitcnt vmcnt(0)" ::: "memory"); __syncthreads(); } while (0)
#define STEP_WAIT(nk, nv) do { if ((nk) && (nv)) asm volatile("s_waitcnt vmcnt(4)" ::: "memory"); else if ((nk) || (nv)) asm volatile("s_waitcnt vmcnt(2)" ::: "memory"); else asm volatile("s_waitcnt vmcnt(0)" ::: "memory"); \
    asm volatile("s_waitcnt lgkmcnt(0)" ::: "memory"); __builtin_amdgcn_s_barrier(); asm volatile("" ::: "memory"); } while (0)
  int t0, t1, t2, t3; NEXT_TILE(t0); NEXT_TILE(t1); NEXT_TILE(t2);
  DMA_K(t0 * 64, 0); DMA_V(t0 * 64, 0); if (t1 >= 0) { DMA_K(t1 * 64, 1); DMA_V(t1 * 64, 1); } if (t2 >= 0) DMA_K(t2 * 64, 2);
  if (t2 >= 0) asm volatile("s_waitcnt vmcnt(4)" ::: "memory"); else if (t1 >= 0) asm volatile("s_waitcnt vmcnt(2)" ::: "memory"); else asm volatile("s_waitcnt vmcnt(0)" ::: "memory");
  asm volatile("s_waitcnt lgkmcnt(0)" ::: "memory"); __builtin_amdgcn_s_barrier(); asm volatile("" ::: "memory");
  f32x16 pA0, pA1, pB0 = {}, pB1 = {};
  QK(pA0, pA1, t0, 0);
  asm volatile("s_waitcnt lgkmcnt(0)" ::: "memory"); __builtin_amdgcn_s_barrier(); asm volatile("" ::: "memory");
  int s0 = 0, s1 = 1, s2 = 2;
  for (;;) {
    NEXT_TILE(t3);
    if (t3 >= 0) DMA_K(t3 * 64, s0);
    if (t2 >= 0) DMA_V(t2 * 64, s2);
    if (t1 >= 0) QK(pB0, pB1, t1, s1);
    SM_PV(pA0, pA1, t0, s0, pB0, pB1);
    STEP_WAIT(t3 >= 0, t2 >= 0);
    if (t1 < 0) break;
    t0 = t1; t1 = t2; t2 = t3; { const int r_ = s0; s0 = s1; s1 = s2; s2 = r_; }
    NEXT_TILE(t3);
    if (t3 >= 0) DMA_K(t3 * 64, s0);
    if (t2 >= 0) DMA_V(t2 * 64, s2);
    if (t1 >= 0) QK(pA0, pA1, t1, s1);
    SM_PV(pB0, pB1, t0, s0, pA0, pA1);
    STEP_WAIT(t3 >= 0, t2 >= 0);
    if (t1 < 0) break;
    t0 = t1; t1 = t2; t2 = t3; { const int r_ = s0; s0 = s1; s1 = s2; s2 = r_; }
  }
  asm volatile("s_waitcnt vmcnt(0) lgkmcnt(0)" ::: "memory"); __syncthreads();
#undef STEP_WAIT
#undef DMA_K
#undef DMA_V
#undef QK
#undef SM_PV
#undef PK4
#undef NEXT_TILE
#undef WAIT_BAR
}
__device__ __forceinline__ void row_bcast(lds_f32* wl, float sc, float (&out)[16], int r32_in, int hi_in) {
  int r32 = r32_in, hi = hi_in; asm volatile("" : "+v"(r32), "+v"(hi));
  asm volatile("s_waitcnt lgkmcnt(0)" ::: "memory");
  if (hi == 0) wl[r32] = sc; asm volatile("s_waitcnt lgkmcnt(0)" ::: "memory");
#pragma unroll
  for (int r = 0; r < 16; ++r) out[r] = wl[crow(r, hi)];
  asm volatile("s_waitcnt lgkmcnt(0)" ::: "memory");
}
template <int N> __device__ __forceinline__ void load_q(bf16x8 (&qr)[N], const bf16* qp  , int hi) {
#pragma unroll
  for (int d0 = 0; d0 < N; ++d0) qr[d0] = *reinterpret_cast<const bf16x8*>(qp + d0 * 16 + hi * 8);
}

__device__ __forceinline__ void store_rows(const f32x16 (&o)[4], const float (&sc)[16], char* stg, bf16* gp  , size_t pitch, int lane_in) {
  int lane = lane_in; asm volatile("" : "+v"(lane));
  const int r32 = lane & 31, hi = lane >> 5;
  lds_u16* sp = (lds_u16*)stg + hi * 4 * 128 + r32;
#pragma unroll
  for (int r = 0; r < 16; ++r)
#pragma unroll
    for (int d0 = 0; d0 < 4; ++d0) sp[((r & 3) + 8 * (r >> 2)) * 128 + d0 * 32] = (unsigned short)f2bf(o[d0][r] * sc[r]);
  asm volatile("s_waitcnt lgkmcnt(0)" ::: "memory");
  const int ch = lane & 15, rr = lane >> 4;
#pragma unroll
  for (int i = 0; i < 8; ++i) { const int row = i * 4 + rr; const u32x4 v = *(const __attribute__((address_space(3))) u32x4*)((lds_char*)stg + row * 256 + ch * 16); *(u32x4*)(gp + (size_t)row * pitch + ch * 8) = v; }
  asm volatile("s_waitcnt lgkmcnt(0)" ::: "memory");
}

__device__ __forceinline__ void mem_unit(char* lds, int b, int hm, int qb, const bf16* MQ, const bf16* MKV  , bf16* ACAT, int tid_in) {
  int tid = tid_in; asm volatile("" : "+v"(tid)); const int lane = tid & 63;
  const int r32 = lane & 31, hi = lane >> 5, wid = __builtin_amdgcn_readfirstlane(tid >> 6);
  const size_t row0 = (size_t)b * SEQ + qb * 256 + wid * 32;
  bf16x8 qr[8]; load_q<8>(qr, MQ + (row0 + r32) * 512 + hm * 128, hi);
  f32x16 o[4] = {}; float m_reg = -1e30f, l_reg = 0.f;
  const bf16* Kg = MKV + (size_t)(b * MEM_LEN) * 4096 + hm * 128;
  run_tiles<8, false, false>(lds, Kg, Kg + 512, 4096, 4096, 0xFull, qr, 0, 0.f, 0, 0, 1 << 30, 0, 1 << 30, 0ull, o, m_reg, l_reg, tid);
  int lane2 = tid_in; asm volatile("" : "+v"(lane2)); lane2 &= 63;
  float sc[16]; row_bcast((lds_f32*)(lds + L_WS) + wid * 64, 1.0f / fmaxf(l_reg, 1e-30f), sc, lane2 & 31, lane2 >> 5);
  store_rows(o, sc, lds + wid * 8192, ACAT + row0 * 2560 + 2048 + hm * 128, 2560, lane2);
  __syncthreads();
}

__device__ __forceinline__ void diff_unit(char* lds, int b, int h, int qb, const bf16* DQ, const bf16* DK, const bf16* DV, bf16* ACAT, const float* subln, float lam, float lam_init, unsigned* nrm, int tid_in) {
  int tid = tid_in; asm volatile("" : "+v"(tid)); const int lane = tid & 63;
  int r32 = lane & 31, hi = lane >> 5; const int wid = __builtin_amdgcn_readfirstlane(tid >> 6), mp = wid >> 2, qs = wid & 3;
  const int q0w = qb * 128 + qs * 32, q = q0w + r32; const size_t rowb = (size_t)b * SEQ;
  bf16x8 qr[4]; load_q<4>(qr, DQ + (rowb + q) * 1024 + h * 128 + mp * 64, hi);
  f32x16 o[4] = {}; float m_reg = -1e30f, l_reg = 0.f;
  const int nt = (qb * 128 + 128) / 64; unsigned long long tmask = (nt >= 64) ? ~0ull : ((1ull << nt) - 1ull);
  const float slope2 = exp2f(-(float)(h + 1)) * LOG2E;
  { const float q2a = __uint_as_float(__hip_atomic_load(nrm + (h * 2) * 16, __ATOMIC_RELAXED, __HIP_MEMORY_SCOPE_AGENT)), q2b = __uint_as_float(__hip_atomic_load(nrm + (h * 2 + 1) * 16, __ATOMIC_RELAXED, __HIP_MEMORY_SCOPE_AGENT));
    const float k2a = __uint_as_float(__hip_atomic_load(nrm + (16 + h * 2) * 16, __ATOMIC_RELAXED, __HIP_MEMORY_SCOPE_AGENT)), k2b = __uint_as_float(__hip_atomic_load(nrm + (16 + h * 2 + 1) * 16, __ATOMIC_RELAXED, __HIP_MEMORY_SCOPE_AGENT));
    const float bqk = sqrtf(fmaxf(q2a * k2a, q2b * k2b)), dcut = (2.05f * bqk + 153.0f) / slope2;
    int ns = (dcut < 8192.f) ? (qb * 128 - (int)dcut - 1) / 64 : 0; ns = __builtin_amdgcn_readfirstlane(ns);
    if (ns > 0) tmask &= ~((1ull << ns) - 1ull); }
  run_tiles<4, true, false>(lds, DK + rowb * 1024 + h * 128, DV + rowb * 1024 + h * 128, 1024, 1024, tmask, qr, mp * 4, slope2, q, 0, q, 0, q0w, 0ull, o, m_reg, l_reg, tid);
  int lane2 = tid_in; asm volatile("" : "+v"(lane2)); lane2 &= 63; r32 = lane2 & 31; hi = lane2 >> 5;
  float sc[16]; row_bcast((lds_f32*)(lds + L_WS) + wid * 64, 1.0f / fmaxf(l_reg, 1e-30f), sc, r32, hi);
  lds_f32* X = (lds_f32*)lds + qs * 4096;
  if (mp == 1) {
#pragma unroll
    for (int r = 0; r < 16; ++r)
#pragma unroll
      for (int d0 = 0; d0 < 4; ++d0) X[crow(r, hi) * 128 + d0 * 32 + r32] = o[d0][r] * sc[r]; }
  __syncthreads();
  if (mp == 0) {
    const float kk = 1.0f - lam_init; float g4[4];
#pragma unroll
    for (int d0 = 0; d0 < 4; ++d0) g4[d0] = subln[d0 * 32 + r32] * kk;
#pragma unroll
    for (int r = 0; r < 16; ++r) { float ss = 0.f;
#pragma unroll
      for (int d0 = 0; d0 < 4; ++d0) { const float v = o[d0][r] * sc[r] - lam * X[crow(r, hi) * 128 + d0 * 32 + r32]; o[d0][r] = v * g4[d0]; ss += v * v; }
      ss += __shfl_xor(ss, 1); ss += __shfl_xor(ss, 2); ss += __shfl_xor(ss, 4); ss += __shfl_xor(ss, 8); ss += __shfl_xor(ss, 16);
      sc[r] = 1.0f / sqrtf(ss * (1.0f / 128.0f) + NORM_EPS); }
    store_rows(o, sc, lds + L_STG + qs * 8192, ACAT + (rowb + q0w) * 2560 + h * 128, 2560, lane2);
  }
  __syncthreads();
}

template <int MODE> __device__ __forceinline__ void acc_rows(f32x16 (&o)[4], const float (&sc)[16], float* ap  , int lane_in) {
  int lane = lane_in; asm volatile("" : "+v"(lane));
  GAS f32x4_t* p = (GAS f32x4_t*)ap + lane;
  if (MODE != 0) { f32x4_t t[16];
#pragma unroll
    for (int i = 0; i < 16; ++i) t[i] = p[i * 64];
#pragma unroll
    for (int i = 0; i < 16; ++i)
#pragma unroll
      for (int e = 0; e < 4; ++e) o[i >> 2][4 * (i & 3) + e] = o[i >> 2][4 * (i & 3) + e] * sc[4 * (i & 3) + e] + t[i][e];
    asm volatile("" ::: "memory");
    if (MODE == 1) {
#pragma unroll
      for (int i = 0; i < 16; ++i) p[i * 64] = (f32x4_t){o[i >> 2][4 * (i & 3)], o[i >> 2][4 * (i & 3) + 1], o[i >> 2][4 * (i & 3) + 2], o[i >> 2][4 * (i & 3) + 3]}; }
  } else {
#pragma unroll
    for (int i = 0; i < 16; ++i) p[i * 64] = (f32x4_t){o[i >> 2][4 * (i & 3)] * sc[4 * (i & 3)], o[i >> 2][4 * (i & 3) + 1] * sc[4 * (i & 3) + 1], o[i >> 2][4 * (i & 3) + 2] * sc[4 * (i & 3) + 2], o[i >> 2][4 * (i & 3) + 3] * sc[4 * (i & 3) + 3]}; }
}
__device__ __forceinline__ void imp_pass(char* lds, const bf16* Kc, int ntc, const bf16x8 (&qr)[8], int cmax, float m_reg, float il, float (&impa)[32], int tid, int lane) {
  const int r32 = lane & 31, hi = lane >> 5, sr = tid >> 4, sc = (tid & 15) * 8;
  for (int t = 0; t < ntc; ++t) { const bf16x8 k0 = *(const bf16x8*)(Kc + (size_t)(t * 64 + sr) * 128 + sc), k1 = *(const bf16x8*)(Kc + (size_t)(t * 64 + 32 + sr) * 128 + sc);
    *(bf16x8*)(lds + t * SHM_T + KSWZ(sr, sc * 2)) = k0; *(bf16x8*)(lds + t * SHM_T + KSWZ(32 + sr, sc * 2)) = k1; }
  __syncthreads();
  float carry = 0.f;
#pragma unroll
  for (int t = 0; t < 4; ++t) {
    if (t < ntc) {
      f32x16 p0 = f32x16{}, p1 = f32x16{}; { int ka[4]; k_addr(ka, (int)(uintptr_t)lds + t * SHM_T, r32, hi); qkt<8>(p0, p1, ka, qr); }
      const int kb = t * 64 + 4 * hi;
#pragma unroll
      for (int r = 0; r < 16; ++r) { const int cr = (r & 3) + 8 * (r >> 2);
        p0[r] = (kb + cr <= cmax) ? __builtin_amdgcn_exp2f(p0[r] - m_reg) * il : 0.f; p1[r] = (kb + cr + 32 <= cmax) ? __builtin_amdgcn_exp2f(p1[r] - m_reg) * il : 0.f; }
      float xp0[4], xp1[4], c0[4], c1[4];
#pragma unroll
      for (int a = 0; a < 4; ++a) { xp0[a] = __shfl_xor(p0[4 * a + 3], 32); xp1[a] = __shfl_xor(p1[4 * a + 3], 32);
        c0[a] = (p0[4 * a] + p0[4 * a + 1]) + (p0[4 * a + 2] + p0[4 * a + 3]); c1[a] = (p1[4 * a] + p1[4 * a + 1]) + (p1[4 * a + 2] + p1[4 * a + 3]); }
#pragma unroll
      for (int a = 0; a < 4; ++a) { const float e0 = hi ? xp0[a] : (a ? xp0[a > 0 ? a - 1 : 0] : carry), e1 = hi ? xp1[a] : (a ? xp1[a > 0 ? a - 1 : 0] : xp0[3]);
        impa[t * 8 + a] = c0[a] + e0; impa[t * 8 + 4 + a] = c1[a] + e1; }
      carry = xp1[3];
    } else {
#pragma unroll
      for (int i = 0; i < 8; ++i) impa[t * 8 + i] = 0.f; }
  }
  __syncthreads();
}
__device__ __forceinline__ void nsa_unit(char* lds, int b, int g, int cur, const bf16* NQ, const bf16* NKV, const bf16* KCMP, const float* NG, float* ACC, bf16* ACAT, int tid_in) {
  int tid = tid_in; asm volatile("" : "+v"(tid)); const int lane = tid & 63;
  const int r32 = lane & 31, hi = lane >> 5, wid = __builtin_amdgcn_readfirstlane(tid >> 6), hh = wid & 3, qh = wid >> 2, head = g * 4 + hh;
  const int q0w = cur * 64 + qh * 32, q = q0w + r32; const size_t rowb = (size_t)b * SEQ;
  bf16x8 qr[8]; load_q<8>(qr, NQ + (rowb + q) * 1024 + head * 128, hi);
  const float slope2 = exp2f(-(float)(head + 1)) * LOG2E;
  lds_f32* wl = (lds_f32*)(lds + L_WS) + wid * 64; lds_f32* imp_sh = (lds_f32*)(lds + L_IMP); lds_u64* sel_sh = (lds_u64*)(lds + L_SEL); lds_u64* misc = (lds_u64*)(lds + L_MISC);
  float* accp = ACC + ((size_t)(((b * 2 + g) * 64 + cur) * 8 + wid)) * 4096;
  const float* ngp = NG + (rowb + q) * 24 + head * 3;
  f32x16 o[4] = {}; float m_reg = -1e30f, l_reg = 0.f; float sc[16];
  { const int cmax = (q >= 31) ? ((q - 31) >> 4) : -1, cmin_w = (q0w >= 31) ? ((q0w - 31) >> 4) : -1;
    const int ntc = ((4 * cur + 2) >> 6) + 1; const unsigned long long tmc = (1ull << ntc) - 1ull;
    const bf16* Kc = KCMP + ((size_t)((0 * BATCH + b) * 2 + g) * 256) * 128; const bf16* Vc = KCMP + ((size_t)((1 * BATCH + b) * 2 + g) * 256) * 128;
    run_tiles<8, false, false>(lds, Kc, Vc, 128, 128, tmc, qr, 0, 0.f, q, 0, cmax, 0, cmin_w, 0ull, o, m_reg, l_reg, tid);
    const float il = 1.0f / fmaxf(l_reg, 1e-30f);
    row_bcast(wl, ngp[0] * il, sc, r32, hi); acc_rows<0>(o, sc, accp, lane);
    float impa[32]; imp_pass(lds, Kc, ntc, qr, cmax, m_reg, il, impa, tid, lane);
    for (int h4 = 0; h4 < 4; ++h4) {
      if (hh == h4) { lds_f32* ir = imp_sh + (qh * 32 + r32) * 65 + hi;
#pragma unroll
        for (int t = 0; t < 4; ++t)
#pragma unroll
          for (int a = 0; a < 4; ++a) { const float v0 = impa[t * 8 + a], v1 = impa[t * 8 + 4 + a];
            if (h4 == 0) { ir[16 * t + 2 * a] = v0; ir[16 * t + 8 + 2 * a] = v1; } else { ir[16 * t + 2 * a] += v0; ir[16 * t + 8 + 2 * a] += v1; } } }
      __syncthreads(); }
  }
  { const int ql = tid >> 3, sub = tid & 7; const lds_f32* ir = imp_sh + ql * 65;
    float myv[8]; int rank[8];
#pragma unroll
    for (int i = 0; i < 8; ++i) { const int j = sub * 8 + i; myv[i] = (j == 0 || j == cur || j == cur - 1) ? 1e9f : (j > cur ? -1e9f : ir[j]); rank[i] = 0; }
    for (int j2 = 0; j2 < 64; ++j2) { const float v2 = (j2 == 0 || j2 == cur || j2 == cur - 1) ? 1e9f : (j2 > cur ? -1e9f : ir[j2]);
#pragma unroll
      for (int i = 0; i < 8; ++i) rank[i] += ((v2 > myv[i]) || (v2 == myv[i] && j2 < sub * 8 + i)) ? 1 : 0; }
    unsigned bits = 0u;
#pragma unroll
    for (int i = 0; i < 8; ++i) bits |= (rank[i] < 8 ? 1u : 0u) << i;
    unsigned slo = (sub < 4) ? (bits << (8 * sub)) : 0u, shi = (sub >= 4) ? (bits << (8 * (sub - 4))) : 0u;
    slo |= __shfl_xor(slo, 1); slo |= __shfl_xor(slo, 2); slo |= __shfl_xor(slo, 4); shi |= __shfl_xor(shi, 1); shi |= __shfl_xor(shi, 2); shi |= __shfl_xor(shi, 4);
    if (sub == 0) sel_sh[ql] = ((unsigned long long)shi << 32) | slo;
    __syncthreads();
    if (wid == 0) { const unsigned long long v = sel_sh[lane]; unsigned a = (unsigned)v, c = (unsigned)(v >> 32);
#pragma unroll
      for (int s = 1; s < 64; s <<= 1) { a |= __shfl_xor(a, s); c |= __shfl_xor(c, s); }
      if (lane == 0) misc[0] = ((unsigned long long)c << 32) | a; }
    __syncthreads();
  }
  const unsigned long long selq = sel_sh[qh * 32 + r32];
  unsigned long long usel; { const unsigned long long v = misc[0]; usel = ((unsigned long long)(unsigned)__builtin_amdgcn_readfirstlane((int)(unsigned)(v >> 32)) << 32) | (unsigned)__builtin_amdgcn_readfirstlane((int)(unsigned)v); }
  { const unsigned long long upto = (cur >= 63) ? ~0ull : ((2ull << cur) - 1ull);
    const bf16* Ks = NKV + ((size_t)(1 * 4 + 0 * 2 + g) * MROWS + rowb) * 128; const bf16* Vs = NKV + ((size_t)(1 * 4 + 1 * 2 + g) * MROWS + rowb) * 128;
#pragma unroll
    for (int d = 0; d < 4; ++d) o[d] = f32x16{};
    m_reg = -1e30f; l_reg = 0.f;
    run_tiles<8, true, true>(lds, Ks, Vs, 128, 128, usel & upto, qr, 0, slope2, q, 0, q, 0, q0w, selq, o, m_reg, l_reg, tid);
    row_bcast(wl, ngp[1] / fmaxf(l_reg, 1e-30f), sc, r32, hi); acc_rows<1>(o, sc, accp, lane);
  }
  { const int tlo = cur >= 8 ? cur - 8 : 0; const unsigned long long upto = (cur >= 63) ? ~0ull : ((2ull << cur) - 1ull); const unsigned long long tmw = upto & ~((1ull << tlo) - 1ull);
    const bf16* Kw = NKV + ((size_t)(2 * 4 + 0 * 2 + g) * MROWS + rowb) * 128; const bf16* Vw = NKV + ((size_t)(2 * 4 + 1 * 2 + g) * MROWS + rowb) * 128;
#pragma unroll
    for (int d = 0; d < 4; ++d) o[d] = f32x16{};
    m_reg = -1e30f; l_reg = 0.f;
    run_tiles<8, true, false>(lds, Kw, Vw, 128, 128, tmw, qr, 0, slope2, q, q - 511, q, q0w + 31 - 511, q0w, 0ull, o, m_reg, l_reg, tid);
    int lane2 = tid_in; asm volatile("" : "+v"(lane2)); lane2 &= 63;
    row_bcast(wl, ngp[2] / fmaxf(l_reg, 1e-30f), sc, lane2 & 31, lane2 >> 5); acc_rows<2>(o, sc, accp, lane2);
#pragma unroll
    for (int r = 0; r < 16; ++r) sc[r] = 1.0f;
    store_rows(o, sc, lds + wid * 8192, ACAT + (rowb + q0w) * 2560 + 1024 + head * 128, 2560, lane2);
  }
  __syncthreads();
}
#undef KSWZ
#undef SBAR
}

namespace cmpx {
typedef short bf16x8 __attribute__((ext_vector_type(8)));
typedef float f32x4 __attribute__((ext_vector_type(4)));
typedef __attribute__((address_space(3))) float lds_f32;
typedef __attribute__((address_space(3))) unsigned short lds_u16;
__device__ __forceinline__ void cmp_unit(char* lds, int u, const bf16* NKV, const bf16* W1t  , const bf16* W2t  , const float* bias1  , bf16* KCMP, int tid_in) {
  int tid = tid_in; asm volatile("" : "+v"(tid)); const int lane = tid & 63, wid = __builtin_amdgcn_readfirstlane(tid >> 6), li = lane & 15, kq = lane >> 4;
  const int ct = u & 15, g = (u >> 4) & 1, b = (u >> 5) & 1, kv = u >> 6, c0 = ct * 16;
  const bf16* A = NKV + ((size_t)(0 * 4 + kv * 2 + g) * MROWS + (size_t)b * SEQ + 16 * (c0 + li)) * 128 + wid * 512 + 8 * kq;
  const bf16* B = W1t + (size_t)kv * 128 * 4096 + (size_t)wid * 16 * 8 * 512 + lane * 8;
  bf16x8 w2[4]; { const bf16* B2p = W2t + ((size_t)kv * 128 + wid * 16 + li) * 128 + 8 * kq;
#pragma unroll
    for (int ks = 0; ks < 4; ++ks) w2[ks] = *(const bf16x8*)(B2p + ks * 32); }
  f32x4 acc[8];
#pragma unroll
  for (int n = 0; n < 8; ++n) acc[n] = (f32x4){0.f, 0.f, 0.f, 0.f};
#pragma unroll 4
  for (int ks = 0; ks < 16; ++ks) { const bf16x8 a = *(const bf16x8*)(A + ks * 32);
#pragma unroll
    for (int n = 0; n < 8; ++n) { const bf16x8 w = *(const bf16x8*)(B + (size_t)(ks * 8 + n) * 512); acc[n] = __builtin_amdgcn_mfma_f32_16x16x32_bf16(a, w, acc[n], 0, 0, 0); } }
  lds_f32* P = (lds_f32*)lds; lds_u16* Hs = (lds_u16*)(lds + 65536);
#pragma unroll
  for (int n = 0; n < 8; ++n)
#pragma unroll
    for (int r = 0; r < 4; ++r) P[wid * 2048 + (4 * kq + r) * 128 + 16 * n + li] = acc[n][r];
  __syncthreads();
  { const int c = tid >> 5, n4 = (tid & 31) * 4; float v[4];
#pragma unroll
    for (int e = 0; e < 4; ++e) { float sacc = bias1[kv * 128 + n4 + e];
#pragma unroll
      for (int w = 0; w < 8; ++w) sacc += P[w * 2048 + c * 128 + n4 + e];
      v[e] = gelu_tanh(sacc); }
#pragma unroll
    for (int e = 0; e < 4; ++e) Hs[c * 128 + n4 + e] = (unsigned short)f2bf(v[e]); }
  __syncthreads();
  { f32x4 o2 = (f32x4){0.f, 0.f, 0.f, 0.f};
#pragma unroll
    for (int ks = 0; ks < 4; ++ks) { const bf16x8 a = *(const __attribute__((address_space(3))) bf16x8*)(Hs + li * 128 + ks * 32 + 8 * kq);
      o2 = __builtin_amdgcn_mfma_f32_16x16x32_bf16(a, w2[ks], o2, 0, 0, 0); }
    bf16* op = KCMP + ((size_t)((kv * BATCH + b) * 2 + g) * 256 + c0) * 128 + wid * 16 + li;
#pragma unroll
    for (int r = 0; r < 4; ++r) { const int c = 4 * kq + r; op[(size_t)c * 128] = (c0 + c < NCMP) ? (bf16)f2bf(o2[r]) : (bf16)0; } }
  __syncthreads();
}
__device__ __forceinline__ void ng_unit(char* lds, int u, const bf16* XB, const bf16* WNG, const float* ssq, float* NG, int tid_in) {
  int tid = tid_in; asm volatile("" : "+v"(tid)); const int lane = tid & 63, wid = __builtin_amdgcn_readfirstlane(tid >> 6), li = lane & 15, kq = lane >> 4;
  const bf16* A = XB + ((size_t)u * 32 + li) * DM + wid * 256 + 8 * kq; const bf16* B = WNG + (size_t)li * DM + wid * 256 + 8 * kq;
  f32x4 acc[2][2];
#pragma unroll
  for (int i = 0; i < 2; ++i)
#pragma unroll
    for (int j = 0; j < 2; ++j) acc[i][j] = (f32x4){0.f, 0.f, 0.f, 0.f};
#pragma unroll
  for (int ks = 0; ks < 8; ++ks) { bf16x8 a[2], w[2];
#pragma unroll
    for (int i = 0; i < 2; ++i) { a[i] = *(const bf16x8*)(A + (size_t)i * 16 * DM + ks * 32); w[i] = *(const bf16x8*)(B + (size_t)i * 16 * DM + ks * 32); }
#pragma unroll
    for (int i = 0; i < 2; ++i)
#pragma unroll
      for (int j = 0; j < 2; ++j) acc[i][j] = __builtin_amdgcn_mfma_f32_16x16x32_bf16(a[i], w[j], acc[i][j], 0, 0, 0); }
  lds_f32* P = (lds_f32*)lds;
#pragma unroll
  for (int i = 0; i < 2; ++i)
#pragma unroll
    for (int j = 0; j < 2; ++j)
#pragma unroll
      for (int r = 0; r < 4; ++r) P[wid * 1024 + (16 * i + 4 * kq + r) * 32 + 16 * j + li] = acc[i][j][r];
  __syncthreads();
  { const int row = tid >> 4, j0 = (tid & 15) * 2; const float rs = pg8::row_rstd(ssq, u * 32 + row);
#pragma unroll
    for (int e = 0; e < 2; ++e) { const int j = j0 + e; float sacc = 0.f;
#pragma unroll
      for (int w = 0; w < 8; ++w) sacc += P[w * 1024 + row * 32 + j];
      if (j < 24) NG[(size_t)(u * 32 + row) * 24 + j] = 1.0f / (1.0f + __expf(-sacc * rs)); } }
  __syncthreads();
}

__device__ __forceinline__ void qk_norm_max(char* lds, const bf16* DQ, const bf16* DK, unsigned* nrm  , int wg, int nwg, int tid_in) {
  int tid = tid_in; asm volatile("" : "+v"(tid)); const int lane = tid & 63, wid = __builtin_amdgcn_readfirstlane(tid >> 6);
  float qm = 0.f, km = 0.f;
  for (int r = wg * 8 + wid; r < MROWS; r += nwg * 8) {
    const v4u a0 = *(const __attribute__((address_space(1))) v4u*)(DQ + (size_t)r * 1024 + lane * 16), a1 = *(const __attribute__((address_space(1))) v4u*)(DQ + (size_t)r * 1024 + lane * 16 + 8);
    const v4u b0 = *(const __attribute__((address_space(1))) v4u*)(DK + (size_t)r * 1024 + lane * 16), b1 = *(const __attribute__((address_space(1))) v4u*)(DK + (size_t)r * 1024 + lane * 16 + 8);
    float sq = 0.f, sk = 0.f;
#pragma unroll
    for (int e = 0; e < 4; ++e) { const float q0 = blo(a0[e]), q1 = bhi(a0[e]), q2 = blo(a1[e]), q3 = bhi(a1[e]); sq += (q0 * q0 + q1 * q1) + (q2 * q2 + q3 * q3);
      const float k0 = blo(b0[e]), k1 = bhi(b0[e]), k2 = blo(b1[e]), k3 = bhi(b1[e]); sk += (k0 * k0 + k1 * k1) + (k2 * k2 + k3 * k3); }
    sq += __shfl_xor(sq, 1); sq += __shfl_xor(sq, 2); sk += __shfl_xor(sk, 1); sk += __shfl_xor(sk, 2);
    qm = fmaxf(qm, sq); km = fmaxf(km, sk); }
  lds_f32* red = (lds_f32*)lds;
  __syncthreads();
  if ((lane & 3) == 0) { red[wid * 32 + (lane >> 2)] = qm; red[wid * 32 + 16 + (lane >> 2)] = km; }
  __syncthreads();
  if (tid < 32) { float m = red[tid];
#pragma unroll
    for (int w = 1; w < 8; ++w) m = fmaxf(m, red[w * 32 + tid]);
    (void)__hip_atomic_fetch_max(nrm + tid * 16, __float_as_uint(m), __ATOMIC_RELAXED, __HIP_MEMORY_SCOPE_AGENT); }
  __syncthreads();
}
}


#ifndef SITE_MASK
#define SITE_MASK 0xffffffffu
#endif
#define SITE(k) ((SITE_MASK >> (k)) & 1u)
struct Args { const float* in[N_IN]; float* out; unsigned char* ws; int step_lo, step_hi; };
constexpr int N_STEPS = 1 + DEPTH * 9 + 1;

__global__ void __launch_bounds__(NTHREADS, 2) trunk_fwd(Args args_unused) {
#define SITE_ARGS const __attribute__((address_space(4))) Args* argp_ = (const __attribute__((address_space(4))) Args*)__builtin_amdgcn_kernarg_segment_ptr(); asm volatile("" : "+s"(argp_)); const __attribute__((address_space(4))) Args& args = *argp_;
    unsigned char* ws; int lo, hi; { SITE_ARGS ws = args.ws; lo = args.step_lo; hi = args.step_hi; }
    extern __shared__ __attribute__((aligned(16))) unsigned char lds_raw[];
    LAS unsigned char* lds = (LAS unsigned char*)lds_raw;
    volatile LAS unsigned* MISC = (volatile LAS unsigned*)(lds + MISC_OFF);
    const int G = gridDim.x, NT = G * NTHREADS, NGW = G * NWAVES;
    const int wave_u = __builtin_amdgcn_readfirstlane((int)(threadIdx.x >> 6));
#define MYTID (wave_u * 64 + lane_id_fresh())
#define SITE_IDS int tid = MYTID; asm volatile("" : "+v"(tid)); const int lane = tid & 63, wave = __builtin_amdgcn_readfirstlane(tid >> 6), gtid = blockIdx.x * NTHREADS + tid, gw = blockIdx.x * NWAVES + wave; (void)lane; (void)gtid; (void)gw;
    gu32* ctl = (gu32*)(ws + WS_CTL);
    for (int u = threadIdx.x; u < (LDS_BYTES - LDSCTL_OFF) / 4; u += NTHREADS) ((LAS unsigned*)(lds + LDSCTL_OFF))[u] = 0u;
    __syncthreads();
    if (hi - lo > 1) (void)xcd_barrier_post((unsigned*)(ctl + CW_BAR), MISC + 8);
#define RUN(s) ((s) >= lo && (s) < hi)
#define SEAM(s) do { if ((s) + 1 < hi) { XcdBarrier bar_; bar_.bar = (unsigned*)((gu32*)(ws + WS_CTL) + CW_BAR); bar_.x = xb_xcc_id(); bar_.st = (volatile LAS unsigned*)(lds + MISC_OFF) + 8; xcd_barrier(bar_); } } while (0)
    bf16* XB = (bf16*)(ws + WS_XB); float* SSQ = (float*)(ws + WS_SSQ);
    bf16* Hb = (bf16*)(ws + WS_H);
    float* BIAS1 = (float*)(ws + WS_MISC); float* LAMV = (float*)(ws + WS_MISC + 4096);
    LAS float* epi_scr = (LAS float*)(lds + EPI_OFF);

    if (SITE(0) && RUN(0)) {
        SITE_IDS SITE_ARGS
        LAS float* scr = (LAS float*)(lds + RING_OFF + wave * 16384);
        const bool halfsplit = (G & 15) == 0; const int Gs = halfsplit ? G / 2 : G, sidx = halfsplit ? (int)(((blockIdx.x >> 4) << 3) | (blockIdx.x & 7u)) : (int)blockIdx.x;
        if (!halfsplit || ((blockIdx.x >> 3) & 1u) == 0u) {
        const int gws = sidx * NWAVES + wave, NGWs = Gs * NWAVES;
        for (int l = 0; l < DEPTH; ++l) cvt_job(args.in[I_WMKV] + (size_t)l * DM * 1024, DM, 1024, 16, args.in[I_MEMN] + l * DM, (bf16*)(ws + WS_WMKV) + (size_t)l * 1024 * DM, DM | TILED_FLAG, 0, 0, scr, gws, NGWs, lane);
        for (int m = gws; m < MROWS + MEMROWS; m += NGWs) {
            const bool isx = m < MROWS; const int r = isx ? m : m - MROWS;
            const float* src = isx ? args.in[I_X] + (size_t)r * DM : args.in[I_MEM] + (size_t)r * DM;
            bf16* db = isx ? XB + (size_t)r * DM : (bf16*)(ws + WS_MEMB) + (size_t)r * DM;
            float* dq = isx ? SSQ + (size_t)r * 8 : (float*)(ws + WS_MEMSSQ) + (size_t)r * 8;
            float s = 0.f; f32x4 v[8];
#pragma unroll
            for (int j = 0; j < 8; ++j) v[j] = *((const GAS f32x4*)src + lane + 64 * j);
#pragma unroll
            for (int j = 0; j < 8; ++j) { s += (v[j][0] * v[j][0] + v[j][1] * v[j][1]) + (v[j][2] * v[j][2] + v[j][3] * v[j][3]);
                *((GAS unsigned long long*)db + lane + 64 * j) = (unsigned long long)pk2(v[j][0], v[j][1]) | ((unsigned long long)pk2(v[j][2], v[j][3]) << 32); }
            s = wave_sum(s);
            if (lane < 8) dq[lane] = (lane == 0) ? s : 0.f;
        }
        for (int o4 = sidx; o4 < DEPTH * 2 * 32; o4 += Gs) { const int n4 = (o4 & 31) * 4, lk = o4 >> 5;
            const float* pos = args.in[I_CPOS] + (size_t)lk * 4096; const float* w = args.in[I_CW1] + (size_t)lk * 4096 * 128 + n4; f32x4 s4 = {0.f, 0.f, 0.f, 0.f};
#pragma unroll
            for (int i = 0; i < 8; ++i) { const int k = wave * 512 + i * 64 + lane; s4 += *(const GAS f32x4*)(w + (size_t)k * 128) * pos[k]; }
            const float s0 = wave_sum(s4[0]), s1 = wave_sum(s4[1]), s2 = wave_sum(s4[2]), s3 = wave_sum(s4[3]);
            LAS float* red = (LAS float*)(lds + EPI_OFF);
            __syncthreads();
            if (lane == 0) { red[wave * 4 + 0] = s0; red[wave * 4 + 1] = s1; red[wave * 4 + 2] = s2; red[wave * 4 + 3] = s3; }
            __syncthreads();
            if (tid < 4) { float t = red[tid];
#pragma unroll
                for (int w8 = 1; w8 < 8; ++w8) t += red[w8 * 4 + tid];
                BIAS1[lk * 128 + n4 + tid] = t; } }
        if (blockIdx.x == 0 && wave >= 1 && wave <= DEPTH) { const int ll = wave - 1; const float* lp = args.in[I_LAM] + ll * 256;
            const float a = wave_sum(lp[lane] * lp[64 + lane]), b2 = wave_sum(lp[128 + lane] * lp[192 + lane]);
            if (lane == 0) LAMV[ll] = expf(a) - expf(b2) + (0.8f - 0.6f * expf(-0.3f * (float)ll)); }
        __syncthreads();
        }
        cvt_pull(args, ws, 0, (gu32*)(ws + WS_CTL) + CW_CVT + 3 * 128, tid, lds + RING_OFF);
        SEAM(0);
    }

    for (int it = 0; it < 3 * DEPTH; ++it) {
        const int l = it / 3, r3 = it - 3 * l; const int sb = 1 + 9 * l + (r3 == 0 ? 0 : (r3 == 1 ? 2 : 7));
        unsigned char* wl = ws + WS_WL + (size_t)l * WL_STRIDE;
        if (r3 != 1) {
            if (SITE(1) && RUN(sb)) {
                pg8::Gemm g{XB, (const bf16*)(wl + (r3 == 0 ? WL_GU1 : WL_GU2)), MROWS, 2 * DFF, DM}; pg8::StaticOrder S; S.init(MROWS, 2 * DFF, G, (int)blockIdx.x);
                pg8::EpiSwiGLU E{Hb, SSQ, DFF, (const LAS float*)(lds + SSQI_OFF)}; pg8::NoHook nh;
                pg8::gemm_phase<pg8::EpiSwiGLU, pg8::StaticOrder, pg8::NoHook, true, true>(lds + RING_OFF, g, S, E, nh, MYTID);
                if (SITE(2) && it == 0) {
                    pg8::Gemm g2{(const bf16*)(ws + WS_MEMB), (const bf16*)(ws + WS_WMKV), MEMROWS, DEPTH * 1024, DM}; pg8::StaticOrder S2; S2.init(MEMROWS, DEPTH * 1024, G, (int)((blockIdx.x + G / 2) % G));
                    pg8::EpiScaleBf16 E2{(bf16*)(ws + WS_MEMKV), DEPTH * 1024, (const float*)(ws + WS_MEMSSQ), (const LAS float*)(lds + SSQI_OFF)};
                    pg8::gemm_phase<pg8::EpiScaleBf16, pg8::StaticOrder, pg8::NoHook, true, true>(lds + RING_OFF, g2, S2, E2, nh, MYTID);
                }
                SEAM(sb);
            }
            if (SITE(3) && RUN(sb + 1)) {
                pg8::Gemm g{Hb, (const bf16*)(wl + (r3 == 0 ? WL_D1 : WL_D2)), MROWS, DM, DFF}; pg8::StaticOrder S; S.init(MROWS, DM, G, (int)blockIdx.x);
                pg8::EpiResid E{XB, SSQ, 0.5f, epi_scr}; pg8::NoHook nh;
                pg8::gemm_phase<pg8::EpiResid, pg8::StaticOrder, pg8::NoHook, true, true>(lds + RING_OFF, g, S, E, nh, MYTID);
                SEAM(sb + 1);
            }
        } else {
            bf16* DQ = (bf16*)(ws + WS_DQ); bf16* DK = (bf16*)(ws + WS_DK); bf16* DV = (bf16*)(ws + WS_DV); bf16* NQ = (bf16*)(ws + WS_NQ);
            bf16* NKV = (bf16*)(ws + WS_NKV); bf16* MQ = (bf16*)(ws + WS_MQ); bf16* MG = (bf16*)(ws + WS_MG); float* NG = (float*)(ws + WS_NG);
            bf16* KCMP = (bf16*)(ws + WS_KCMP); float* HC = (float*)(ws + WS_HC); bf16* ACAT = (bf16*)(ws + WS_ACAT); bf16* MERGED = (bf16*)(ws + WS_MERGED);
            if (SITE(4) && RUN(sb)) {
                pg8::Gemm g{XB, (const bf16*)(wl + WL_IN), MROWS, PROJ_N, DM}; pg8::StaticOrder S; S.init(MROWS, PROJ_N, G, (int)blockIdx.x);
                pg8::EpiProj E{(const LAS float*)(lds + SSQI_OFF), SSQ, DQ, DK, DV, NQ, NKV, MQ, MG, MROWS}; pg8::NoHook nh;
                pg8::gemm_phase<pg8::EpiProj, pg8::StaticOrder, pg8::NoHook, true, true>(lds + RING_OFF, g, S, E, nh, MYTID);
                SEAM(sb);
            }
            if (SITE(5) && RUN(sb + 1)) {
                SITE_IDS SITE_ARGS
                char* alds = (char*)lds_raw + RING_OFF;
                if (G >= 256 && (int)blockIdx.x >= G - 128) { cmpx::cmp_unit(alds, G - 1 - (int)blockIdx.x, NKV, (const bf16*)(wl + WL_C1), (const bf16*)(wl + WL_C2), BIAS1 + l * 256, KCMP, tid); }
                else if (G >= 256) { for (int u = (int)blockIdx.x; u < MROWS / 32; u += G - 128) cmpx::ng_unit(alds, u, XB, (const bf16*)(wl + WL_NG), SSQ, NG, tid);
                                     cmpx::qk_norm_max(alds, DQ, DK, (unsigned*)((gu32*)(ws + WS_CTL) + CW_NRM + l * 512), (int)blockIdx.x, G - 128, tid); }
                else { cmpx::qk_norm_max(alds, DQ, DK, (unsigned*)((gu32*)(ws + WS_CTL) + CW_NRM + l * 512), (int)blockIdx.x, G, tid);
                       for (int u = (int)blockIdx.x; u < MROWS / 32; u += G) cmpx::ng_unit(alds, u, XB, (const bf16*)(wl + WL_NG), SSQ, NG, tid);
                       for (int u = (int)blockIdx.x; u < 128; u += G) cmpx::cmp_unit(alds, u, NKV, (const bf16*)(wl + WL_C1), (const bf16*)(wl + WL_C2), BIAS1 + l * 256, KCMP, tid); }
                SEAM(sb + 1);
            }
#define CVT_PULL() do { SITE_IDS SITE_ARGS cvt_pull(args, ws, l + 1, (gu32*)(ws + WS_CTL) + CW_CVT + l * 128, tid, lds + RING_OFF); } while (0)
            if (SITE(7) && RUN(sb + 2) && l + 1 < DEPTH && (int)(blockIdx.x >> 3) >= (G >> 3) - 5) CVT_PULL();
            if (SITE(7) && RUN(sb + 2)) {
                SITE_IDS SITE_ARGS
                const float lam_init = 0.8f - 0.6f * expf(-0.3f * (float)l);
                { char* alds = (char*)lds_raw + RING_OFF; volatile LAS unsigned* qslot = (volatile LAS unsigned*)(lds + MISC_OFF) + 16; const float lam = LAMV[l]; const float* subln = args.in[I_SUBLN] + l * 128;
                  gu32* qh = (gu32*)(ws + WS_CTL) + CW_Q + (l * 4) * 64;
                  for (;;) {
                      if (tid == 0) qslot[0] = __hip_atomic_fetch_add(qh, 1u, __ATOMIC_RELAXED, __HIP_MEMORY_SCOPE_AGENT);
                      __syncthreads(); const int u = (int)qslot[0]; __syncthreads();
                      if (u >= BATCH * 2 * 64) break;
                      att::nsa_unit(alds, (u >> 1) & 1, u & 1, 63 - (u >> 2), NQ, NKV, KCMP, NG, (float*)(ws + WS_ACC), ACAT, tid); }
                  for (;;) {
                      if (tid == 0) qslot[0] = __hip_atomic_fetch_add(qh + 64, 1u, __ATOMIC_RELAXED, __HIP_MEMORY_SCOPE_AGENT);
                      __syncthreads(); const int u = (int)qslot[0]; __syncthreads();
                      if (u >= BATCH * 8 * 32) break;
                      att::diff_unit(alds, (u >> 3) & 1, u & 7, 31 - (u >> 4), DQ, DK, DV, ACAT, subln, lam, lam_init, (unsigned*)((gu32*)(ws + WS_CTL) + CW_NRM + l * 512), tid); }
                  for (;;) {
                      if (tid == 0) qslot[0] = __hip_atomic_fetch_add(qh + 128, 1u, __ATOMIC_RELAXED, __HIP_MEMORY_SCOPE_AGENT);
                      __syncthreads(); const int u = (int)qslot[0]; __syncthreads();
                      if (u >= BATCH * 4 * 16) break;
                      att::mem_unit(alds, (u >> 2) & 1, u & 3, u >> 3, MQ, (const bf16*)(ws + WS_MEMKV) + (size_t)l * 1024, ACAT, tid); } }
            }
            if (SITE(7) && RUN(sb + 2)) {
                if (l + 1 < DEPTH) CVT_PULL();
                SEAM(sb + 2);
            }
#undef CVT_PULL
            if (SITE(8) && RUN(sb + 3)) {
                pg8::Gemm g{ACAT, (const bf16*)(wl + WL_UP), MROWS, DM, 2560}; pg8::StaticOrder S; S.init(MROWS, DM, G, (int)blockIdx.x);
                pg8::MergeGate mgk{MG}; pg8::EpiMerge E{MERGED, mgk};
                pg8::gemm_phase<pg8::EpiMerge, pg8::StaticOrder, pg8::MergeGate, false, true>(lds + RING_OFF, g, S, E, mgk, MYTID);
                SEAM(sb + 3);
            }
            if (SITE(9) && RUN(sb + 4)) {
                pg8::Gemm g{MERGED, (const bf16*)(wl + WL_O), MROWS, DM, DM}; pg8::StaticOrder S; S.init(MROWS, DM, G, (int)blockIdx.x);
                pg8::EpiResid E{XB, SSQ, 1.0f, epi_scr}; pg8::NoHook nh;
                pg8::gemm_phase<pg8::EpiResid, pg8::StaticOrder, pg8::NoHook, true, true>(lds + RING_OFF, g, S, E, nh, MYTID);
                SEAM(sb + 4);
            }
        }
    }
    if (RUN(N_STEPS - 1)) {
        SITE_IDS SITE_ARGS
        const float* gn = args.in[I_FINN];
        for (int m = gw; m < MROWS; m += NGW) { const GAS unsigned long long* xr = (const GAS unsigned long long*)(XB + (size_t)m * DM) + lane; f32x4 v[8]; float s = 0.f;
#pragma unroll
            for (int j = 0; j < 8; ++j) { const unsigned long long w = xr[64 * j]; const unsigned w0 = (unsigned)w, w1 = (unsigned)(w >> 32); v[j] = (f32x4){blo(w0), bhi(w0), blo(w1), bhi(w1)};
                s += (v[j][0] * v[j][0] + v[j][1] * v[j][1]) + (v[j][2] * v[j][2] + v[j][3] * v[j][3]); }
            const float rs = 1.0f / sqrtf(wave_sum(s) * (1.0f / DM) + NORM_EPS);
#pragma unroll
            for (int j = 0; j < 8; ++j) { const f32x4 gv = *((const f32x4*)gn + lane + 64 * j); *((f32x4*)(args.out + (size_t)m * DM) + lane + 64 * j) = v[j] * rs * gv; } }
    }
#undef RUN
#undef SEAM
#undef SITE_IDS
#undef SITE_ARGS
#undef MYTID
}

#ifndef MK_PER_STEP
#define MK_PER_STEP 0
#endif
extern "C" void kernel_launch(void* const* d_in, const int* in_sizes, int n_in, void* d_out, int out_size, void* d_ws, size_t ws_size, hipStream_t stream) {
    static int grid = 0;
    if (grid == 0) {
        if (n_in != N_IN || in_sizes[0] != MROWS * DM || out_size != MROWS * DM || ws_size < WS_END) {
            fprintf(stderr, "kernel_launch: shape/workspace mismatch: n_in %d in0 %d out %d ws %zu (need %zu)\n", n_in, n_in > 0 ? in_sizes[0] : -1, out_size, ws_size, (size_t)WS_END); grid = -1; return; }
        int dev = 0, cus = 0, per_cu = 0;
        if (hipGetDevice(&dev) != hipSuccess || hipDeviceGetAttribute(&cus, hipDeviceAttributeMultiprocessorCount, dev) != hipSuccess) { grid = -1; return; }
        if (hipFuncSetAttribute((const void*)trunk_fwd, hipFuncAttributeMaxDynamicSharedMemorySize, LDS_BYTES) != hipSuccess) { fprintf(stderr, "kernel_launch: hipFuncSetAttribute failed\n"); grid = -1; return; }
        if (hipOccupancyMaxActiveBlocksPerMultiprocessor(&per_cu, (const void*)trunk_fwd, NTHREADS, LDS_BYTES) != hipSuccess || per_cu < 1)
            fprintf(stderr, "kernel_launch: note: occupancy query reports %d workgroups per CU\n", per_cu);
        (void)hipGetLastError();
        grid = cus;
    }
    if (grid < 0) return;
    if (hipMemsetAsync((char*)d_ws + WS_CTL, 0, CTL_ZERO_BYTES, stream) != hipSuccess) return;
    Args a{};
    for (int i = 0; i < N_IN; ++i) a.in[i] = (const float*)d_in[i];
    a.out = (float*)d_out; a.ws = (unsigned char*)d_ws;
#if MK_PER_STEP
    for (int s = 0; s < N_STEPS; ++s) { a.step_lo = s; a.step_hi = s + 1; hipLaunchKernelGGL(trunk_fwd, dim3(grid), dim3(NTHREADS), LDS_BYTES, stream, a); }
#else
    a.step_lo = 0; a.step_hi = N_STEPS; hipLaunchKernelGGL(trunk_fwd, dim3(grid), dim3(NTHREADS), LDS_BYTES, stream, a);
#endif
    const hipError_t le = hipPeekAtLastError();
    if (le != hipSuccess) fprintf(stderr, "kernel_launch: launch failed: %s\n", hipGetErrorName(le));
}
```

```cpp
#include <hip/hip_runtime.h>
#include <cstdio>
#include <cstdint>

__device__ __forceinline__ int lane_id_fresh() { int l; asm volatile("v_mbcnt_lo_u32_b32 %0, -1, 0\n\tv_mbcnt_hi_u32_b32 %0, -1, %0" : "=v"(l)); return l; }
namespace pg8 {
#define PG8_LAS __attribute__((address_space(3)))
#ifndef GAS
#define GAS __attribute__((address_space(1)))
#endif
typedef unsigned short bf16_t;
typedef short bf16x8 __attribute__((ext_vector_type(8)));
typedef float f32x4 __attribute__((ext_vector_type(4)));
typedef unsigned u32x4 __attribute__((ext_vector_type(4)));
typedef unsigned u32x2 __attribute__((ext_vector_type(2)));
constexpr int BM = 256, BK = 64, HALF = 128, HTB = HALF * BK * 2  , STAGE_BYTES = 8 * HTB, NXCD = 8, WGM = 4;

__host__ __device__ __forceinline__ int lds_byte(int r, int c) { const int st = (r >> 4) * 2 + (c >> 5), rr = r & 15, cc = c & 31, ob = rr * 64 + cc * 2; return st * 1024 + (ob ^ (((ob >> 9) & 1) << 5)); }
__host__ __device__ __forceinline__ void stage_rc(int b, int& R, int& C) { const int st = b / 1024, sb = b % 1024, swz = sb ^ (((sb >> 9) & 1) << 5); R = (st >> 1) * 16 + swz / 64; C = (st & 1) * 32 + (swz % 64) / 2; }
__host__ __device__ __forceinline__ int perm32(int rho) { const int n = rho >> 4, i = rho & 15; return 8 * (i >> 2) + 4 * n + (i & 3); }

struct Unit { int pm, pn; };
struct Gemm { const bf16_t* A; const bf16_t* Bt; int M, N, K; };

struct StaticOrder {
    int nM, nN, nwg, G, c;
    __host__ __device__ void init(int M, int N, int G_, int c_) { nM = M / BM; nN = N / BM; nwg = nM * nN; G = G_; c = c_; }
    __host__ __device__ bool next(int i, Unit& u) const {
        const long L = (long)i * G + c; if (L >= nwg) return false;
        int wgid = (int)L; { const int q = nwg / NXCD, r = nwg % NXCD, xcd = wgid % NXCD, off = wgid / NXCD; wgid = (xcd < r ? xcd * (q + 1) : r * (q + 1) + (xcd - r) * q) + off; }
        const int nig = WGM * nN, gid = wgid / nig, fm = gid * WGM, gsz = (nM - fm) < WGM ? (nM - fm) : WGM;
        u.pm = fm + ((wgid % nig) % gsz); u.pn = (wgid % nig) / gsz; return true;
    }
    __device__ __forceinline__ void a_ready(const Unit&) const {}
    __device__ __forceinline__ void done(const Unit&) const {}
};

typedef float f32x2_cv __attribute__((ext_vector_type(2))); typedef __bf16 bf16x2_cv __attribute__((ext_vector_type(2)));
__device__ __forceinline__ unsigned cvt_pk_bf16(float lo, float hi) { const f32x2_cv v = {lo, hi}; const bf16x2_cv b = __builtin_convertvector(v, bf16x2_cv); return __builtin_bit_cast(unsigned, b); }
__device__ __forceinline__ float bflo(unsigned w) { return __uint_as_float(w << 16); }
__device__ __forceinline__ float bfhi(unsigned w) { return __uint_as_float(w & 0xffff0000u); }
struct NoHook { static constexpr bool ON = false; static constexpr int T1 = -1, T2 = -1;
    __device__ __forceinline__ void apply(f32x4 (&)[2][2][4][2], const Unit&, int, int, int, int, int) const {} };

__device__ __forceinline__ float row_rstd(const float* ssq, int row) {
    const f32x4 a = *(const f32x4*)(ssq + (size_t)row * 8), b = *(const f32x4*)(ssq + (size_t)row * 8 + 4);
    const float s = ((a[0] + a[1]) + (a[2] + a[3])) + ((b[0] + b[1]) + (b[2] + b[3]));
    return __builtin_amdgcn_rsqf(s * (1.0f / 2048.0f) + 1e-6f);
}
__device__ __forceinline__ float row_rstd_lds(const PG8_LAS float* img, int rl) {
    const f32x4 a = *(const PG8_LAS f32x4*)(img + rl * 8), b = *(const PG8_LAS f32x4*)(img + rl * 8 + 4);
    const float s = ((a[0] + a[1]) + (a[2] + a[3])) + ((b[0] + b[1]) + (b[2] + b[3]));
    return __builtin_amdgcn_rsqf(s * (1.0f / 2048.0f) + 1e-6f);
}
__device__ __forceinline__ float fast_sigmoid(float v) { return __builtin_amdgcn_rcpf(1.0f + __builtin_amdgcn_exp2f(-1.4426950408889634f * v)); }

struct EpiSwiGLU { static constexpr bool PERM = true, AFTER_DRAIN = false, NEED_SSQ = true;
    bf16_t* H; const float* ssq; int ldh; const PG8_LAS float* img;
    __device__ __forceinline__ void operator()(const f32x4 (&acc)[2][2][4][2], const Unit& u, int wr, int wc, int fr, int fq, int, int) const {
        const int row0 = u.pm * BM + wr * 64 + fr, col0 = u.pn * 128 + wc * 32 + 8 * fq;
#pragma unroll
        for (int ai = 0; ai < 2; ++ai)
#pragma unroll
            for (int m = 0; m < 4; ++m) { const int row = row0 + ai * HALF + m * 16; const float rs = row_rstd_lds(img, wr * 64 + fr + ai * HALF + m * 16);
                const float kk = rs * -1.4426950408889634f, rs2 = rs * rs;
                float hv[8];
#pragma unroll
                for (int n = 0; n < 2; ++n)
#pragma unroll
                    for (int e = 0; e < 4; ++e) { const float G_ = acc[ai][0][m][n][e], U_ = acc[ai][1][m][n][e]; const float t_ = G_ * kk, gu_ = G_ * U_;
                        const float r_ = __builtin_amdgcn_rcpf(1.0f + __builtin_amdgcn_exp2f(t_)); hv[n * 4 + e] = gu_ * (r_ * rs2); }
                u32x4 w; w.x = cvt_pk_bf16(hv[0], hv[1]); w.y = cvt_pk_bf16(hv[2], hv[3]); w.z = cvt_pk_bf16(hv[4], hv[5]); w.w = cvt_pk_bf16(hv[6], hv[7]);
                *(u32x4*)(H + (size_t)row * ldh + col0) = w; }
    }
};
struct EpiResid { static constexpr bool PERM = true, AFTER_DRAIN = false, NEED_SSQ = false;
    bf16_t* XB; float* ssq; float scale; PG8_LAS float* scr;
    __device__ __forceinline__ void operator()(const f32x4 (&acc)[2][2][4][2], const Unit& u, int wr, int wc, int fr_in, int fq_in, int wid, int lane_in) const {
        const int lane = lane_id_fresh(), fr = lane & 15, fq = lane >> 4; (void)fr_in; (void)fq_in; (void)lane_in;
        const int col0 = u.pn * BM + wc * 32 + 8 * fq;
#pragma unroll
        for (int ai = 0; ai < 2; ++ai) {
            size_t off0 = (size_t)(u.pm * BM + ai * HALF + wr * 64 + fr) * 2048 + col0; asm volatile("" : "+v"(off0));
            GAS bf16_t* bp = (GAS bf16_t*)XB + off0;
            u32x4 xo[4][2];
#pragma unroll
            for (int m = 0; m < 4; ++m)
#pragma unroll
                for (int bj = 0; bj < 2; ++bj) xo[m][bj] = *(const GAS u32x4*)(bp + (size_t)(m * 16) * 2048 + bj * HALF);
            asm volatile("" ::: "memory");
#pragma unroll
            for (int m = 0; m < 4; ++m) { float q = 0.f;
#pragma unroll
                for (int bj = 0; bj < 2; ++bj) { const u32x4 xi = xo[m][bj];
                    const f32x4 i0 = {bflo(xi.x), bfhi(xi.x), bflo(xi.y), bfhi(xi.y)}, i1 = {bflo(xi.z), bfhi(xi.z), bflo(xi.w), bfhi(xi.w)};
                    const f32x4 x0 = i0 + acc[ai][bj][m][0] * scale, x1 = i1 + acc[ai][bj][m][1] * scale;
                    u32x4 w; w.x = cvt_pk_bf16(x0[0], x0[1]); w.y = cvt_pk_bf16(x0[2], x0[3]); w.z = cvt_pk_bf16(x1[0], x1[1]); w.w = cvt_pk_bf16(x1[2], x1[3]); *(GAS u32x4*)(bp + (size_t)(m * 16) * 2048 + bj * HALF) = w;
                    q += ((x0[0] * x0[0] + x0[1] * x0[1]) + (x0[2] * x0[2] + x0[3] * x0[3])) + ((x1[0] * x1[0] + x1[1] * x1[1]) + (x1[2] * x1[2] + x1[3] * x1[3])); }
                q += __shfl_xor(q, 16); q += __shfl_xor(q, 32);
                if (fq == 0) scr[(ai * HALF + wr * 64 + m * 16 + fr) * 4 + wc] = q; }
            asm volatile("" ::: "memory"); }
        asm volatile("s_waitcnt lgkmcnt(0)\n\ts_barrier" ::: "memory");
        const int tid = wid * 64 + lane;
        if (tid < 256) { const float s = (scr[tid * 4 + 0] + scr[tid * 4 + 1]) + (scr[tid * 4 + 2] + scr[tid * 4 + 3]); ssq[(size_t)(u.pm * BM + tid) * 8 + u.pn] = s; }
        asm volatile("s_waitcnt lgkmcnt(0)" ::: "memory");
    }
};
struct EpiScaleBf16 { static constexpr bool PERM = true, AFTER_DRAIN = false, NEED_SSQ = true;
    bf16_t* O; int ldc; const float* ssq; const PG8_LAS float* img;
    __device__ __forceinline__ void operator()(const f32x4 (&acc)[2][2][4][2], const Unit& u, int wr, int wc, int fr, int fq, int, int) const {
        const int row0 = u.pm * BM + wr * 64 + fr, col0 = u.pn * BM + wc * 32 + 8 * fq;
#pragma unroll
        for (int ai = 0; ai < 2; ++ai)
#pragma unroll
            for (int m = 0; m < 4; ++m) { const int row = row0 + ai * HALF + m * 16; const float rs = row_rstd_lds(img, wr * 64 + fr + ai * HALF + m * 16);
#pragma unroll
                for (int bj = 0; bj < 2; ++bj) { const f32x4 v0 = acc[ai][bj][m][0] * rs, v1 = acc[ai][bj][m][1] * rs;
                    u32x4 w; w.x = cvt_pk_bf16(v0[0], v0[1]); w.y = cvt_pk_bf16(v0[2], v0[3]); w.z = cvt_pk_bf16(v1[0], v1[1]); w.w = cvt_pk_bf16(v1[2], v1[3]);
                    *(u32x4*)(O + (size_t)row * ldc + col0 + bj * HALF) = w; } }
    }
};
__device__ __forceinline__ size_t mg_off(int s_, int pm, int pn, int wid, int ai) { return ((((size_t)(s_ * 32 + pm) * 8 + pn) * 8 + wid) * 2 + ai) * 4096; }
constexpr size_t MG_SET = (size_t)8192 * 2048;
struct EpiProj { static constexpr bool PERM = true, AFTER_DRAIN = false, NEED_SSQ = true;
    const PG8_LAS float* img; const float* ssq; bf16_t *DQ, *DK, *DV, *NQ, *NKV, *MQ, *MG; int Mrows;
    __device__ __forceinline__ void operator()(const f32x4 (&acc)[2][2][4][2], const Unit& u, int wr, int wc, int fr, int fq, int, int) const {
        const int pn = u.pn; bf16_t* base; int ldc, c0; size_t bjs = HALF;
        float qs = 1.0f;
        if (pn < 4) { base = DQ; ldc = 1024; c0 = 256 * pn; qs = 0.125f * 1.4426950408889634f; }
        else if (pn < 8) { base = DK; ldc = 1024; c0 = 256 * (pn - 4); }
        else if (pn < 12) { base = DV; ldc = 1024; c0 = 256 * (pn - 8); }
        else if (pn < 16) { base = NQ; ldc = 1024; c0 = 256 * (pn - 12); qs = 0.08838834764831845f * 1.4426950408889634f; }
        else if (pn < 22) { base = NKV + (size_t)(2 * (pn - 16)) * Mrows * 128; ldc = 128; c0 = 0; bjs = (size_t)Mrows * 128; }
        else if (pn < 24) { base = MQ; ldc = 512; c0 = 256 * (pn - 22); qs = 0.08838834764831845f * 1.4426950408889634f; }
        else { base = MG; ldc = 6144; c0 = 256 * (pn - 24); }
        const bool gate_tile = pn >= 24;
        const int row0 = u.pm * BM + wr * 64 + fr, col0 = c0 + wc * 32 + 8 * fq;
        if (gate_tile) {
#pragma unroll
            for (int ai = 0; ai < 2; ++ai)
#pragma unroll
                for (int m = 0; m < 4; ++m) { const int row = row0 + ai * HALF + m * 16; const float rs = row_rstd_lds(img, wr * 64 + fr + ai * HALF + m * 16) * -1.4426950408889634f;
#pragma unroll
                    for (int bj = 0; bj < 2; ++bj) { f32x4 v0 = acc[ai][bj][m][0] * rs, v1 = acc[ai][bj][m][1] * rs;
#pragma unroll
                        for (int e = 0; e < 4; ++e) { v0[e] = 1.0f + __builtin_amdgcn_exp2f(fminf(v0[e], 43.28085123f)); v1[e] = 1.0f + __builtin_amdgcn_exp2f(fminf(v1[e], 43.28085123f)); }
                        u32x4 w; w.x = cvt_pk_bf16(v0[0], v0[1]); w.y = cvt_pk_bf16(v0[2], v0[3]); w.z = cvt_pk_bf16(v1[0], v1[1]); w.w = cvt_pk_bf16(v1[2], v1[3]);
                        *(u32x4*)(MG + mg_off((pn - 24) >> 3, u.pm, (pn - 24) & 7, wr * 4 + wc, ai) + (m * 2 + bj) * 512 + (fr + 16 * fq) * 8) = w; } }
        } else {
#pragma unroll
            for (int ai = 0; ai < 2; ++ai)
#pragma unroll
                for (int m = 0; m < 4; ++m) { const int row = row0 + ai * HALF + m * 16; const float rs = row_rstd_lds(img, wr * 64 + fr + ai * HALF + m * 16) * qs;
#pragma unroll
                    for (int bj = 0; bj < 2; ++bj) { const f32x4 v0 = acc[ai][bj][m][0] * rs, v1 = acc[ai][bj][m][1] * rs;
                        u32x4 w; w.x = cvt_pk_bf16(v0[0], v0[1]); w.y = cvt_pk_bf16(v0[2], v0[3]); w.z = cvt_pk_bf16(v1[0], v1[1]); w.w = cvt_pk_bf16(v1[2], v1[3]);
                        *(u32x4*)(base + bj * bjs + (size_t)row * ldc + col0) = w; } }
        }
    }
};
struct MergeGate { static constexpr bool ON = true; static constexpr int T1 = 16, T2 = 32;
    const bf16_t* MG;
    __device__ __forceinline__ void apply(f32x4 (&acc)[2][2][4][2], const Unit& u, int wr, int wc, int fr_in, int fq_in, int which) const {
        const int lane = lane_id_fresh(), fr = lane & 15, fq = lane >> 4; (void)fr_in; (void)fq_in;
        const GAS bf16_t* gbase = (const GAS bf16_t*)MG + mg_off(which, u.pm, u.pn, wr * 4 + wc, 0) + lane * 8;
#pragma unroll
        for (int ai = 0; ai < 2; ++ai) { u32x4 wa[4][2], wb[4][2];
            const GAS bf16_t* gp = gbase + (size_t)ai * 4096; asm volatile("" : "+v"(gp));
#pragma unroll
            for (int m = 0; m < 4; ++m)
#pragma unroll
                for (int bj = 0; bj < 2; ++bj) { wa[m][bj] = *(const GAS u32x4*)(gp + (m * 2 + bj) * 512);
                    if (which < 2) wb[m][bj] = *(const GAS u32x4*)(gp + MG_SET + (m * 2 + bj) * 512); }
#pragma unroll
            for (int m = 0; m < 4; ++m)
#pragma unroll
                for (int bj = 0; bj < 2; ++bj) { float f[8];
#pragma unroll
                    for (int e = 0; e < 4; ++e) { f[2 * e] = __builtin_amdgcn_rcpf(bflo(wa[m][bj][e])); f[2 * e + 1] = __builtin_amdgcn_rcpf(bfhi(wa[m][bj][e])); }
                    if (which < 2) {
#pragma unroll
                        for (int e = 0; e < 4; ++e) { f[2 * e] *= bflo(wb[m][bj][e]); f[2 * e + 1] *= bfhi(wb[m][bj][e]); } }
#pragma unroll
                    for (int e = 0; e < 4; ++e) { acc[ai][bj][m][0][e] *= f[e]; acc[ai][bj][m][1][e] *= f[4 + e]; } }
            asm volatile("" ::: "memory"); }
    }
};
struct EpiMerge { static constexpr bool PERM = true, AFTER_DRAIN = false, NEED_SSQ = false;
    bf16_t* O; MergeGate G;
    __device__ __forceinline__ void operator()(const f32x4 (&acc_in)[2][2][4][2], const Unit& u, int wr, int wc, int fr_in, int fq_in, int, int) const {
        const int lane = lane_id_fresh(), fr = lane & 15, fq = lane >> 4; (void)fr_in; (void)fq_in;
        const int row0 = u.pm * BM + wr * 64 + fr, col0 = u.pn * BM + wc * 32 + 8 * fq;
#pragma unroll
        for (int ai = 0; ai < 2; ++ai) { u32x4 wa[4][2];
            const GAS bf16_t* gp = (const GAS bf16_t*)G.MG + mg_off(2, u.pm, u.pn, wr * 4 + wc, ai) + lane * 8; asm volatile("" : "+v"(gp));
#pragma unroll
            for (int m = 0; m < 4; ++m)
#pragma unroll
                for (int bj = 0; bj < 2; ++bj) wa[m][bj] = *(const GAS u32x4*)(gp + (m * 2 + bj) * 512);
#pragma unroll
            for (int m = 0; m < 4; ++m) { const int row = row0 + ai * HALF + m * 16;
#pragma unroll
                for (int bj = 0; bj < 2; ++bj) { float g[8];
#pragma unroll
                    for (int e = 0; e < 4; ++e) { g[2 * e] = __builtin_amdgcn_rcpf(bflo(wa[m][bj][e])); g[2 * e + 1] = __builtin_amdgcn_rcpf(bfhi(wa[m][bj][e])); }
                    const f32x4 a0 = acc_in[ai][bj][m][0], a1 = acc_in[ai][bj][m][1];
                    u32x4 w; w.x = cvt_pk_bf16(a0[0] * g[0], a0[1] * g[1]); w.y = cvt_pk_bf16(a0[2] * g[2], a0[3] * g[3]); w.z = cvt_pk_bf16(a1[0] * g[4], a1[1] * g[5]); w.w = cvt_pk_bf16(a1[2] * g[6], a1[3] * g[7]);
                    *(GAS u32x4*)((GAS bf16_t*)O + (size_t)row * 2048 + col0 + bj * HALF) = w; } }
            asm volatile("" ::: "memory"); }
    }
};

template <class Epi, class Sched, class Hook, bool ALIGN_EPI = false, bool SP2 = false>
__device__ __forceinline__ void gemm_phase(PG8_LAS unsigned char* lds, const Gemm g, const Sched& S, const Epi& E, const Hook& Hk, int tid_in) {
    int tid_ = tid_in; asm volatile("" : "+v"(tid_));
    const int tid = tid_, wid = __builtin_amdgcn_readfirstlane(tid >> 6), lane = tid & 63, wr = wid >> 2, wc = wid & 3, fr = lane & 15, fq = lane >> 4;
    const int K = g.K, nt = K / BK;
    unsigned voffA[2], voffB[2];
#pragma unroll
    for (int i = 0; i < 2; ++i) { int R, C; stage_rc(tid * 16 + i * 8192, R, C); const int Rb = Epi::PERM ? ((R & ~31) + perm32(R & 31)) : R;
        voffA[i] = (unsigned)(R * K + C) * 2u; voffB[i] = (unsigned)(Rb * BK + C) * 2u; }
    const size_t kstep = (size_t)(BK * 2), kstepB = (size_t)BM * BK * 2;
    const size_t hstep = (size_t)HALF * K * 2, hstepB = (size_t)HALF * BK * 2;
    const size_t tstep = 2 * hstep, tstepB = (size_t)BM * K * 2;
    const unsigned ldsw = (unsigned)wid * 1024u;
    const int aoff = lds_byte(wr * 64 + fr, fq * 8), boff = lds_byte(wc * 32 + fr, fq * 8);
#define PG8_SA(b, h) (((b) * 2 + (h)) * HTB)
#define PG8_SB(b, h) ((4 + (b) * 2 + (h)) * HTB)
#define PG8_STAGE(bufoff, gbase, voff) do { _Pragma("unroll") for (int _i = 0; _i < 2; ++_i) \
        __builtin_amdgcn_global_load_lds((const unsigned*)((const char*)(gbase) + (voff)[_i]), (PG8_LAS unsigned*)(lds + (bufoff) + ldsw + _i * 8192), 16, 0, 0); } while (0)
#define PG8_LDA(dst, b, h) do { _Pragma("unroll") for (int m = 0; m < 4; ++m) _Pragma("unroll") for (int k = 0; k < 2; ++k) dst[m][k] = *(const PG8_LAS bf16x8*)(lds + PG8_SA(b, h) + aoff + m * 2048 + k * 1024); } while (0)
#define PG8_LDB(dst, b, h) do { _Pragma("unroll") for (int n = 0; n < 2; ++n) _Pragma("unroll") for (int k = 0; k < 2; ++k) dst[n][k] = *(const PG8_LAS bf16x8*)(lds + PG8_SB(b, h) + boff + n * 2048 + k * 1024); } while (0)
#define PG8_MMA(ai, bj, At, Bt) do { __builtin_amdgcn_s_setprio(1); _Pragma("unroll") for (int m = 0; m < 4; ++m) _Pragma("unroll") for (int n = 0; n < 2; ++n) _Pragma("unroll") for (int k = 0; k < 2; ++k) \
        acc[ai][bj][m][n] = __builtin_amdgcn_mfma_f32_16x16x32_bf16(Bt[n][k], At[m][k], acc[ai][bj][m][n], 0, 0, 0); __builtin_amdgcn_s_setprio(0); } while (0)
#define PG8_WAIT_V(n) asm volatile("s_waitcnt vmcnt(" #n ")" ::: "memory")
#define PG8_WAIT_L(n) asm volatile("s_waitcnt lgkmcnt(" #n ")" ::: "memory")
#define PG8_BAR __builtin_amdgcn_s_barrier()
#define PG8_SCHED __builtin_amdgcn_sched_barrier(0)
    Unit cur, nxt; int ui = 0;
    if (!S.next(0, cur)) return;
    f32x4 acc[2][2][4][2];
#pragma unroll
    for (int a = 0; a < 2; ++a)
#pragma unroll
        for (int b = 0; b < 2; ++b)
#pragma unroll
            for (int m = 0; m < 4; ++m)
#pragma unroll
                for (int n = 0; n < 2; ++n) acc[a][b][m][n] = (f32x4){0.f, 0.f, 0.f, 0.f};
    bf16x8 At[4][2], B0[2][2], B1[2][2];
    const char* cA = (const char*)g.A + (size_t)cur.pm * tstep; const char* cB = (const char*)g.Bt + (size_t)cur.pn * tstepB;
    S.a_ready(cur);
    if constexpr (SP2) {
        PG8_STAGE(PG8_SB(0, 0), cB, voffB); PG8_STAGE(PG8_SB(0, 1), cB + hstepB, voffB); PG8_STAGE(PG8_SA(0, 0), cA, voffA); PG8_STAGE(PG8_SA(0, 1), cA + hstep, voffA);
        if (wr == 1) PG8_BAR;
        PG8_WAIT_V(2); PG8_BAR;
        PG8_STAGE(PG8_SB(1, 0), cB + kstepB, voffB); PG8_STAGE(PG8_SA(1, 0), cA + kstep, voffA); PG8_STAGE(PG8_SB(1, 1), cB + hstepB + kstepB, voffB);
        PG8_WAIT_V(6); PG8_BAR;
    } else {
        PG8_STAGE(PG8_SB(0, 0), cB, voffB); PG8_STAGE(PG8_SA(0, 0), cA, voffA); PG8_STAGE(PG8_SB(0, 1), cB + hstepB, voffB); PG8_STAGE(PG8_SA(0, 1), cA + hstep, voffA);
        if (wr == 1) PG8_BAR;
        PG8_WAIT_V(4); PG8_BAR;
        PG8_STAGE(PG8_SB(1, 0), cB + kstepB, voffB); PG8_STAGE(PG8_SA(1, 0), cA + kstep, voffA); PG8_STAGE(PG8_SB(1, 1), cB + hstepB + kstepB, voffB);
        PG8_WAIT_V(6); PG8_BAR;
    }
    for (;;) {
        const bool has_next = S.next(ui + 1, nxt);
        const char* nA = has_next ? (const char*)g.A + (size_t)nxt.pm * tstep : cA; const char* nB = has_next ? (const char*)g.Bt + (size_t)nxt.pn * tstepB : cB;
#pragma unroll
        for (int seg = 0; seg < (Hook::ON ? 3 : 1); ++seg) {
        const int tb = Hook::ON ? (seg == 0 ? 0 : (seg == 1 ? Hook::T1 : Hook::T2)) : 0, te = Hook::ON ? (seg == 0 ? Hook::T1 : (seg == 1 ? Hook::T2 : nt)) : nt;
        if constexpr (Hook::ON) { if (seg > 0) Hk.apply(acc, cur, wr, wc, fr, fq, seg - 1); }
        for (int t = tb; t < te; t += 2) {
            const bool last = (t == nt - 2);
            const char* a1 = cA + (size_t)(t + 1) * kstep;
            const char* a2 = last ? nA : cA + (size_t)(t + 2) * kstep; const char* b2 = last ? nB : cB + (size_t)(t + 2) * kstepB;
            const char* a3 = a2 + kstep; const char* b3 = b2 + kstepB;
            if (last && has_next) S.a_ready(nxt);
            if constexpr (Epi::NEED_SSQ) { if (last) {
                __builtin_amdgcn_global_load_lds((const unsigned*)(E.ssq + ((size_t)cur.pm * BM + wid * 32 + (lane >> 1)) * 8 + (lane & 1) * 4), (PG8_LAS unsigned*)((PG8_LAS unsigned char*)E.img + wid * 1024), 16, 0, 0); } }
            if constexpr (SP2) {
            PG8_LDB(B0, 0, 0); PG8_LDB(B1, 0, 1); PG8_SCHED; PG8_LDA(At, 0, 0); PG8_STAGE(PG8_SA(1, 1), a1 + hstep, voffA);
            PG8_WAIT_V(8); PG8_WAIT_L(0); PG8_BAR; PG8_MMA(0, 0, At, B0); PG8_MMA(0, 1, At, B1); PG8_BAR; PG8_SCHED;
            PG8_LDA(At, 0, 1); PG8_STAGE(PG8_SB(0, 0), b2, voffB); PG8_STAGE(PG8_SB(0, 1), b2 + hstepB, voffB); PG8_STAGE(PG8_SA(0, 0), a2, voffA);
            PG8_WAIT_V(8); PG8_WAIT_L(0); PG8_BAR; PG8_MMA(1, 0, At, B0); PG8_MMA(1, 1, At, B1); PG8_BAR; PG8_SCHED;
            PG8_LDB(B0, 1, 0); PG8_LDB(B1, 1, 1); PG8_SCHED; PG8_LDA(At, 1, 0); PG8_STAGE(PG8_SA(0, 1), a2 + hstep, voffA);
            PG8_WAIT_V(8); PG8_WAIT_L(0); PG8_BAR; PG8_MMA(0, 0, At, B0); PG8_MMA(0, 1, At, B1); PG8_BAR; PG8_SCHED;
            PG8_LDA(At, 1, 1); PG8_STAGE(PG8_SB(1, 0), b3, voffB); PG8_STAGE(PG8_SB(1, 1), b3 + hstepB, voffB); PG8_STAGE(PG8_SA(1, 0), a3, voffA);
            PG8_WAIT_V(8); PG8_WAIT_L(0); PG8_BAR; PG8_MMA(1, 0, At, B0); PG8_MMA(1, 1, At, B1); PG8_BAR; PG8_SCHED;
            } else {
            PG8_LDB(B0, 0, 0); PG8_SCHED; PG8_LDA(At, 0, 0); PG8_STAGE(PG8_SA(1, 1), a1 + hstep, voffA);
            PG8_WAIT_L(8); PG8_BAR; PG8_WAIT_L(0); PG8_MMA(0, 0, At, B0); PG8_BAR; PG8_SCHED;
            PG8_LDB(B1, 0, 1); PG8_STAGE(PG8_SB(0, 0), b2, voffB);
            PG8_BAR; PG8_WAIT_L(0); PG8_MMA(0, 1, At, B1); PG8_BAR;
            PG8_LDA(At, 0, 1); PG8_STAGE(PG8_SA(0, 0), a2, voffA);
            PG8_BAR; PG8_WAIT_L(0); PG8_MMA(1, 0, At, B0); PG8_BAR; PG8_SCHED;
            PG8_STAGE(PG8_SB(0, 1), b2 + hstepB, voffB);
            PG8_WAIT_V(6); PG8_BAR; PG8_MMA(1, 1, At, B1); PG8_BAR;
            PG8_LDB(B0, 1, 0); PG8_SCHED; PG8_LDA(At, 1, 0); PG8_STAGE(PG8_SA(0, 1), a2 + hstep, voffA);
            PG8_WAIT_L(8); PG8_BAR; PG8_WAIT_L(0); PG8_MMA(0, 0, At, B0); PG8_BAR; PG8_SCHED;
            PG8_LDB(B1, 1, 1); PG8_STAGE(PG8_SB(1, 0), b3, voffB);
            PG8_BAR; PG8_WAIT_L(0); PG8_MMA(0, 1, At, B1); PG8_BAR;
            PG8_LDA(At, 1, 1); PG8_STAGE(PG8_SA(1, 0), a3, voffA);
            PG8_BAR; PG8_WAIT_L(0); PG8_MMA(1, 0, At, B0); PG8_BAR; PG8_SCHED;
            PG8_STAGE(PG8_SB(1, 1), b3 + hstepB, voffB);
            PG8_WAIT_V(6); PG8_BAR; PG8_MMA(1, 1, At, B1); PG8_BAR;
            }
        }
        }
        if constexpr (ALIGN_EPI) { if (wr == 0) PG8_BAR; }
        if constexpr (!Epi::AFTER_DRAIN) { E(acc, cur, wr, wc, fr, fq, wid, lane); S.done(cur); }
        if (!has_next) break;
#pragma unroll
        for (int a = 0; a < 2; ++a)
#pragma unroll
            for (int b = 0; b < 2; ++b)
#pragma unroll
                for (int m = 0; m < 4; ++m)
#pragma unroll
                    for (int n = 0; n < 2; ++n) acc[a][b][m][n] = (f32x4){0.f, 0.f, 0.f, 0.f};
        cur = nxt; cA = nA; cB = nB; ++ui;
        if constexpr (ALIGN_EPI) { if (wr == 1) PG8_BAR; }
    }
    PG8_WAIT_V(0);
    if constexpr (!ALIGN_EPI) { if (wr == 0) PG8_BAR; }
    PG8_BAR;
    if constexpr (Epi::AFTER_DRAIN) { E.fused(acc, cur, wr, wc, fr, fq, lds, wid, lane); S.done(cur); }
#undef PG8_SA
#undef PG8_SB
#undef PG8_STAGE
#undef PG8_LDA
#undef PG8_LDB
#undef PG8_MMA
#undef PG8_WAIT_V
#undef PG8_WAIT_L
#undef PG8_BAR
#undef PG8_SCHED
}
}

constexpr int NWAVES = 8, NTHREADS = 512;
constexpr int BATCH = 2, SEQ = 4096, DM = 2048, DFF = 5632, DEPTH = 4, MROWS = BATCH * SEQ;
constexpr int MEM_LEN = 256, MEMROWS = BATCH * MEM_LEN;
constexpr int IN_COLS = 12312, PROJ_N = 12288, NG_COL0 = 5632;
constexpr int NCMP = 255;
constexpr float NORM_EPS = 1e-6f;
enum { I_X = 0, I_MEM, I_F1N, I_F1G, I_F1U, I_F1D, I_MIXN, I_WIN, I_LAM, I_SUBLN, I_CPOS, I_CW1, I_CW2, I_MEMN, I_WMKV, I_WUD, I_WUN, I_WUM, I_WO, I_F2N, I_F2G, I_F2U, I_F2D, I_FINN, N_IN };

constexpr size_t MiB = 1u << 20;
constexpr size_t WS_CTL = 0, CTL_ZERO_BYTES = 64 * 1024;
constexpr size_t WS_WL = 2 * MiB, WL_STRIDE = 202 * MiB;
constexpr size_t WL_GU1 = 0, WL_D1 = 44 * MiB, WL_IN = 66 * MiB, WL_NG = 114 * MiB, WL_C1 = 115 * MiB, WL_C2 = 117 * MiB, WL_UP = 118 * MiB, WL_O = 128 * MiB, WL_GU2 = 136 * MiB, WL_D2 = 180 * MiB;
constexpr size_t WS_WMKV = WS_WL + DEPTH * WL_STRIDE;
constexpr size_t WS_X = WS_WMKV + 16 * MiB;
constexpr size_t WS_XB = WS_X + 64 * MiB;
constexpr size_t WS_SSQ = WS_XB + 32 * MiB;
constexpr size_t WS_H = WS_SSQ + 1 * MiB;
constexpr size_t WS_DQ = WS_H + 88 * MiB, WS_DK = WS_DQ + 16 * MiB, WS_DV = WS_DK + 16 * MiB, WS_NQ = WS_DV + 16 * MiB;
constexpr size_t WS_NKV = WS_NQ + 16 * MiB;
constexpr size_t WS_MQ = WS_NKV + 24 * MiB;
constexpr size_t WS_MG = WS_MQ + 8 * MiB;
constexpr size_t WS_NG = WS_MG + 96 * MiB;
constexpr size_t WS_KCMP = WS_NG + 1 * MiB;
constexpr size_t WS_HC = WS_KCMP + 1 * MiB;
constexpr size_t WS_MEMB = WS_HC + 1 * MiB;
constexpr size_t WS_MEMSSQ = WS_MEMB + 2 * MiB;
constexpr size_t WS_MEMKV = WS_MEMSSQ + 1 * MiB;
constexpr size_t WS_ACAT = WS_MEMKV + 4 * MiB;
constexpr size_t WS_MERGED = WS_ACAT + 40 * MiB;
constexpr size_t WS_MISC = WS_MERGED + 32 * MiB;
constexpr size_t WS_ACC = WS_MISC + 1 * MiB;
constexpr size_t WS_END = WS_ACC + 32 * MiB;
constexpr int CW_BAR = 4096;
constexpr int CW_CVT = 12288;
constexpr int CW_NRM = 13312;
constexpr int CW_Q = 8192;

constexpr int RING_OFF = 0, RING_BYTES = 131072;
constexpr int EPI_OFF = RING_BYTES, EPI_BYTES = 4096;
constexpr int SSQI_OFF = EPI_OFF + EPI_BYTES, SSQI_BYTES = 8192;
constexpr int LDSCTL_OFF = SSQI_OFF + SSQI_BYTES, MISC_OFF = LDSCTL_OFF + 320;
constexpr int LDS_BYTES = 147456;

#define GAS __attribute__((address_space(1)))
#define LAS __attribute__((address_space(3)))
typedef unsigned short bf16;
typedef unsigned v4u __attribute__((ext_vector_type(4)));
typedef float f32x4 __attribute__((ext_vector_type(4)));
typedef short bf16x8 __attribute__((ext_vector_type(8)));
typedef GAS unsigned gu32;
typedef GAS unsigned long long gu64;
#define RLX_AGENT __ATOMIC_RELAXED, __HIP_MEMORY_SCOPE_AGENT
#define LDS_WAIT() asm volatile("s_waitcnt lgkmcnt(0)" ::: "memory")
#define VM_WAIT() asm volatile("s_waitcnt vmcnt(0)" ::: "memory")
__device__ __forceinline__ unsigned long long rt() { return __builtin_amdgcn_s_memrealtime(); }
__device__ __forceinline__ unsigned f2bf(float f) { unsigned u = __builtin_bit_cast(unsigned, f); return (u + 0x7fffu + ((u >> 16) & 1u)) >> 16; }
__device__ __forceinline__ unsigned pk2(float lo, float hi) { return f2bf(lo) | (f2bf(hi) << 16); }

#define XB_TMO      128
#define XB_XCNT(j)  (256  + 64 * (j))
#define XB_XSUB(j)  (1280 + 64 * (j))
#define XB_XGEN(j)  (2304 + 64 * (j))
#define XB_TOP      3328
#define XB_TOPGEN   3392
#define XCD_BAR_WORDS 3456
#define XB_SPIN_CAP (1u << 18)

__device__ __forceinline__ unsigned xb_ld(unsigned* p)              { return __hip_atomic_load(p, __ATOMIC_RELAXED, __HIP_MEMORY_SCOPE_AGENT); }
__device__ __forceinline__ unsigned xb_add(unsigned* p, unsigned v) { return __hip_atomic_fetch_add(p, v, __ATOMIC_RELAXED, __HIP_MEMORY_SCOPE_AGENT); }
__device__ __forceinline__ unsigned xb_xcc_id() { return (unsigned)__builtin_amdgcn_s_getreg((3 << 11) | 20) & 0xFu; }
#define XB_SPIN(cond, bar) do { unsigned _sp = 0; while (cond) { __builtin_amdgcn_s_sleep(1); \
    if ((++_sp & 255u) == 0u) { if (xb_ld(&(bar)[XB_TMO])) break; if (_sp > XB_SPIN_CAP) { atomicAdd(&(bar)[XB_TMO], 1u); break; } } } } while (0)

struct XcdBarrier {
    unsigned* bar; unsigned x;
    volatile LAS unsigned* st;
};

__device__ __forceinline__ XcdBarrier xcd_barrier_post(unsigned* bar, volatile LAS unsigned* st) {
    XcdBarrier b; b.bar = bar; b.x = xb_xcc_id(); b.st = st;
    if (threadIdx.x == 0) (void)xb_add(&bar[XB_XCNT(b.x)], 1u);
    return b;
}
__device__ __forceinline__ void xcd_barrier_complete(unsigned* bar, unsigned x, unsigned& nloc, unsigned& nx) {
    const unsigned G = gridDim.x * gridDim.y * gridDim.z;
    unsigned sum, cnt, mine, sp = 0u;
    for (;;) {
        sum = 0u; cnt = 0u; mine = 0u;
#pragma unroll
        for (unsigned j = 0; j < 16; ++j) { const unsigned c = xb_ld(&bar[XB_XCNT(j)]); sum += c; cnt += (c > 0u) ? 1u : 0u; mine = (j == x) ? c : mine; }
        if (sum == G) break;
        __builtin_amdgcn_s_sleep(1);
        if ((++sp & 255u) == 0u) { if (xb_ld(&bar[XB_TMO])) break; if (sp > XB_SPIN_CAP) { atomicAdd(&bar[XB_TMO], 1u); break; } }
    }
    nloc = mine > 0u ? mine : 1u; nx = cnt > 0u ? cnt : 1u;
}

__device__ __forceinline__ void xcd_barrier(const XcdBarrier& b) {
    asm volatile("s_waitcnt vmcnt(0)" ::: "memory");
    __syncthreads();
    if (threadIdx.x == 0) {
        unsigned* bar = b.bar;
        __builtin_amdgcn_s_waitcnt(0);
        unsigned nloc = b.st[0], nx = b.st[1];
        if (nloc == 0u) { xcd_barrier_complete(bar, b.x, nloc, nx); b.st[0] = nloc; b.st[1] = nx; }
        const unsigned old = xb_add(&bar[XB_XSUB(b.x)], 1u);
        const unsigned gen = old / nloc;
        if (old + 1u == (gen + 1u) * nloc) {
            __builtin_amdgcn_fence(__ATOMIC_RELEASE, "agent");
            asm volatile("s_waitcnt vmcnt(0)" ::: "memory");
            const unsigned og = xb_add(&bar[XB_TOP], 1u);
            const unsigned tg = og / nx;
            if (og + 1u == (tg + 1u) * nx) xb_add(&bar[XB_TOPGEN], 1u);
            else XB_SPIN(xb_ld(&bar[XB_TOPGEN]) == tg, bar);
            __builtin_amdgcn_fence(__ATOMIC_ACQUIRE, "agent");
            xb_add(&bar[XB_XGEN(b.x)], 1u);
            asm volatile("s_waitcnt vmcnt(0)" ::: "memory");
        } else {
            XB_SPIN(xb_ld(&bar[XB_XGEN(b.x)]) == gen, bar);
            __builtin_amdgcn_fence(__ATOMIC_ACQUIRE, "agent");
            asm volatile("s_waitcnt vmcnt(0)" ::: "memory");
        }
    }
    __syncthreads();
}

__device__ __forceinline__ float wave_sum(float v) {
#pragma unroll
    for (int o = 1; o < 64; o <<= 1) v += __shfl_xor(v, o);
    return v;
}
__device__ __forceinline__ float bf2f(unsigned short u) { return __uint_as_float(((unsigned)u) << 16); }
__device__ __forceinline__ float blo(unsigned w) { return __uint_as_float(w << 16); }
__device__ __forceinline__ float bhi(unsigned w) { return __uint_as_float(w & 0xffff0000u); }
__device__ __forceinline__ float gelu_tanh(float v) { const float u = 0.7978845608028654f * (v + 0.044715f * v * v * v); return 0.5f * v * (1.0f + tanhf(u)); }

constexpr size_t FRAG_FLAG = (size_t)1 << 41;
constexpr size_t TILED_FLAG = (size_t)1 << 40;
__device__ __forceinline__ void cvt_item(const float* W, size_t ldw, int k0, int c0, int ncv, int nrv, const float* scale, bf16* WT, size_t ldt, int r0, int kd0, int lane) {
    const int n4 = (lane & 15) * 4, kr = lane >> 4; f32x4 v[16];
#pragma unroll
    for (int i = 0; i < 16; ++i) { const int k = k0 + 16 * kr + i; v[i] = (n4 < ncv) ? *(const GAS f32x4*)(W + (size_t)k * ldw + c0 + n4) : (f32x4){0.f, 0.f, 0.f, 0.f}; }
    if (scale) {
#pragma unroll
        for (int i = 0; i < 16; ++i) v[i] = v[i] * scale[k0 + 16 * kr + i]; }
    if (n4 < nrv) {
#pragma unroll
        for (int e = 0; e < 4; ++e) { v4u o0, o1; o0.x = pk2(v[0][e], v[1][e]); o0.y = pk2(v[2][e], v[3][e]); o0.z = pk2(v[4][e], v[5][e]); o0.w = pk2(v[6][e], v[7][e]);
            o1.x = pk2(v[8][e], v[9][e]); o1.y = pk2(v[10][e], v[11][e]); o1.z = pk2(v[12][e], v[13][e]); o1.w = pk2(v[14][e], v[15][e]);
            const int n = r0 + n4 + e; GAS v4u* dp;
            if (ldt & TILED_FLAG) { const size_t KT = (size_t)(ldt & ~TILED_FLAG) / 64;
                dp = (GAS v4u*)(WT + ((((size_t)(n >> 8) * KT + (size_t)((kd0 + k0) >> 6)) * 256 + (n & 255)) * 64 + 16 * kr)); }
            else if (ldt & FRAG_FLAG) { const int k = k0 + 16 * kr;
                GAS bf16* fp = (GAS bf16*)WT + ((((size_t)((k >> 9) * 16 + ((k >> 5) & 15)) * 8 + (size_t)(n >> 4)) * 64 + (size_t)((n & 15) + 16 * ((k >> 3) & 3))) * 8);
                *(GAS v4u*)fp = o0; *(GAS v4u*)(fp + 128) = o1; continue; }
            else dp = (GAS v4u*)(WT + (size_t)n * ldt + kd0 + k0 + 16 * kr);
            dp[0] = o0; dp[1] = o1; } }
}
__device__ __forceinline__ void cvt_item_t(const float* W, size_t ldw, int k0, int c0, const float* scale, bf16* WT, size_t KT, int r0, int kd0, int lane, LAS unsigned char* scr) {
    const int n4 = (lane & 15) * 4, kr = lane >> 4; f32x4 v[16];
#pragma unroll
    for (int i = 0; i < 16; ++i) { const int k = k0 + 16 * kr + i; v[i] = *(const GAS f32x4*)(W + (size_t)k * ldw + c0 + n4); }
    if (scale) {
#pragma unroll
        for (int i = 0; i < 16; ++i) v[i] = v[i] * scale[k0 + 16 * kr + i]; }
#pragma unroll
    for (int e = 0; e < 4; ++e) { v4u o0, o1; o0.x = pk2(v[0][e], v[1][e]); o0.y = pk2(v[2][e], v[3][e]); o0.z = pk2(v[4][e], v[5][e]); o0.w = pk2(v[6][e], v[7][e]);
        o1.x = pk2(v[8][e], v[9][e]); o1.y = pk2(v[10][e], v[11][e]); o1.z = pk2(v[12][e], v[13][e]); o1.w = pk2(v[14][e], v[15][e]);
        LAS v4u* lp = (LAS v4u*)(scr + (n4 + e) * 144 + kr * 32); lp[0] = o0; lp[1] = o1; }
    asm volatile("s_waitcnt lgkmcnt(0)" ::: "memory");
    const int rr = lane >> 3, p = lane & 7;
    GAS v4u* dp = (GAS v4u*)(WT + (((size_t)(r0 >> 8) * KT + (size_t)((kd0 + k0) >> 6)) * 256 + (r0 & 255)) * 64) + lane;
    v4u t[8];
#pragma unroll
    for (int j = 0; j < 8; ++j) t[j] = *(const LAS v4u*)(scr + (8 * j + rr) * 144 + p * 16);
#pragma unroll
    for (int j = 0; j < 8; ++j) dp[64 * j] = t[j];
    asm volatile("s_waitcnt lgkmcnt(0)" ::: "memory");
}
__device__ __forceinline__ void cvt_dispatch(const float* W, int ldw, int nblk, const float* scale, bf16* WT, size_t ldt, int kd0, int mode, int it, int lane, LAS unsigned char* scr) {
    const int kb = it / nblk, nb = it % nblk, n0 = 64 * nb; int c0 = n0, r0 = n0, ncv = 64, nrv = 64;
    if (mode == 1) r0 = 256 * (n0 >> 7) + (n0 & 127);
    else if (mode == 2) r0 = 256 * (n0 >> 7) + 128 + (n0 & 127);
    else if (mode == 3) c0 = (n0 < NG_COL0) ? n0 : n0 + 24;
    else if (mode == 4) { c0 = NG_COL0; ncv = 24; nrv = 32; }
    if ((ldt & TILED_FLAG) && mode != 4) cvt_item_t(W, (size_t)ldw, 64 * kb, c0, scale, WT, (size_t)(ldt & ~TILED_FLAG) / 64, r0, kd0, lane, scr);
    else cvt_item(W, (size_t)ldw, 64 * kb, c0, ncv, nrv, scale, WT, ldt, r0, kd0, lane);
}
__device__ __forceinline__ void cvt_job(const float* W, int K, int ldw, int nblk, const float* scale, bf16* WT, size_t ldt, int kd0, int mode, LAS float* scr, int gw, int NGW, int lane) {
    const int nit = (K / 64) * nblk;
    for (int it = gw; it < nit; it += NGW) cvt_dispatch(W, ldw, nblk, scale, WT, ldt, kd0, mode, it, lane, (LAS unsigned char*)scr);
}

constexpr int CI_U1 = 2816, CI_D1 = 5632, CI_IN = 8448, CI_NG = 14592, CI_C1 = 14624, CI_C2 = 14880, CI_UD = 14888, CI_UN = 15400, CI_UM = 15912, CI_O = 16168, CI_G2 = 17192, CI_U2 = 20008, CI_D2 = 22824, CVT_ITEMS = 25640;
template <class ArgsT> __device__ __forceinline__ void cvt_layer_item(const ArgsT& args, unsigned char* ws, int l, int item, int lane, LAS unsigned char* scr) {
    unsigned char* wl = ws + WS_WL + (size_t)l * WL_STRIDE;
    const float* W; const float* scale = nullptr; bf16* WT; int ldw, nblk, it, kd0 = 0, mode = 0; size_t ldt;
    if (item < CI_U1)      { it = item;         W = args.in[I_F1G] + (size_t)l * DM * DFF; ldw = DFF; nblk = DFF / 64; scale = args.in[I_F1N] + l * DM; WT = (bf16*)(wl + WL_GU1); ldt = DM | TILED_FLAG; mode = 1; }
    else if (item < CI_D1) { it = item - CI_U1; W = args.in[I_F1U] + (size_t)l * DM * DFF; ldw = DFF; nblk = DFF / 64; scale = args.in[I_F1N] + l * DM; WT = (bf16*)(wl + WL_GU1); ldt = DM | TILED_FLAG; mode = 2; }
    else if (item < CI_IN) { it = item - CI_D1; W = args.in[I_F1D] + (size_t)l * DM * DFF; ldw = DM; nblk = DM / 64; WT = (bf16*)(wl + WL_D1); ldt = DFF | TILED_FLAG; }
    else if (item < CI_NG) { it = item - CI_IN; W = args.in[I_WIN] + (size_t)l * DM * IN_COLS; ldw = IN_COLS; nblk = PROJ_N / 64; scale = args.in[I_MIXN] + l * DM; WT = (bf16*)(wl + WL_IN); ldt = DM | TILED_FLAG; mode = 3; }
    else if (item < CI_C1) { it = item - CI_NG; W = args.in[I_WIN] + (size_t)l * DM * IN_COLS; ldw = IN_COLS; nblk = 1; scale = args.in[I_MIXN] + l * DM; WT = (bf16*)(wl + WL_NG); ldt = DM; mode = 4; }
    else if (item < CI_C2) { it = item - CI_C1; const int kv = it >> 7; it &= 127; W = args.in[I_CW1] + (size_t)(l * 2 + kv) * 4096 * 128; ldw = 128; nblk = 2; WT = (bf16*)(wl + WL_C1) + (size_t)kv * 128 * 4096; ldt = 4096 | FRAG_FLAG; }
    else if (item < CI_UD) { it = item - CI_C2; const int kv = it >> 2; it &= 3; W = args.in[I_CW2] + (size_t)(l * 2 + kv) * 128 * 128; ldw = 128; nblk = 2; WT = (bf16*)(wl + WL_C2) + (size_t)kv * 128 * 128; ldt = 128; }
    else if (item < CI_UN) { it = item - CI_UD; W = args.in[I_WUD] + (size_t)l * 1024 * DM; ldw = DM; nblk = 32; WT = (bf16*)(wl + WL_UP); ldt = 2560 | TILED_FLAG; }
    else if (item < CI_UM) { it = item - CI_UN; W = args.in[I_WUN] + (size_t)l * 1024 * DM; ldw = DM; nblk = 32; WT = (bf16*)(wl + WL_UP); ldt = 2560 | TILED_FLAG; kd0 = 1024; }
    else if (item < CI_O)  { it = item - CI_UM; W = args.in[I_WUM] + (size_t)l * 512 * DM; ldw = DM; nblk = 32; WT = (bf16*)(wl + WL_UP); ldt = 2560 | TILED_FLAG; kd0 = 2048; }
    else if (item < CI_G2) { it = item - CI_O;  W = args.in[I_WO] + (size_t)l * DM * DM; ldw = DM; nblk = 32; WT = (bf16*)(wl + WL_O); ldt = DM | TILED_FLAG; }
    else if (item < CI_U2) { it = item - CI_G2; W = args.in[I_F2G] + (size_t)l * DM * DFF; ldw = DFF; nblk = DFF / 64; scale = args.in[I_F2N] + l * DM; WT = (bf16*)(wl + WL_GU2); ldt = DM | TILED_FLAG; mode = 1; }
    else if (item < CI_D2) { it = item - CI_U2; W = args.in[I_F2U] + (size_t)l * DM * DFF; ldw = DFF; nblk = DFF / 64; scale = args.in[I_F2N] + l * DM; WT = (bf16*)(wl + WL_GU2); ldt = DM | TILED_FLAG; mode = 2; }
    else                   { it = item - CI_D2; W = args.in[I_F2D] + (size_t)l * DM * DFF; ldw = DM; nblk = DM / 64; WT = (bf16*)(wl + WL_D2); ldt = DFF | TILED_FLAG; }
    cvt_dispatch(W, ldw, nblk, scale, WT, ldt, kd0, mode, it, lane, scr);
}

struct CvtD { const float* W; const float* scale; bf16* WT; size_t ldt; int ldw, kd0, k0, c0, r0, ncv, nrv, tiled, sidx; };
template <class ArgsT> __device__ __forceinline__ void cvt_desc(const ArgsT& args, unsigned char* ws, int l, int item, CvtD& d) {
    unsigned char* wl = ws + WS_WL + (size_t)l * WL_STRIDE;
    const float* W; const float* scale = nullptr; bf16* WT; int ldw, nblk, it, kd0 = 0, mode = 0; size_t ldt;
    if (item < CI_U1)      { it = item;         W = args.in[I_F1G] + (size_t)l * DM * DFF; ldw = DFF; nblk = DFF / 64; scale = args.in[I_F1N] + l * DM; WT = (bf16*)(wl + WL_GU1); ldt = DM | TILED_FLAG; mode = 1; }
    else if (item < CI_D1) { it = item - CI_U1; W = args.in[I_F1U] + (size_t)l * DM * DFF; ldw = DFF; nblk = DFF / 64; scale = args.in[I_F1N] + l * DM; WT = (bf16*)(wl + WL_GU1); ldt = DM | TILED_FLAG; mode = 2; }
    else if (item < CI_IN) { it = item - CI_D1; W = args.in[I_F1D] + (size_t)l * DM * DFF; ldw = DM; nblk = DM / 64; WT = (bf16*)(wl + WL_D1); ldt = DFF | TILED_FLAG; }
    else if (item < CI_NG) { it = item - CI_IN; W = args.in[I_WIN] + (size_t)l * DM * IN_COLS; ldw = IN_COLS; nblk = PROJ_N / 64; scale = args.in[I_MIXN] + l * DM; WT = (bf16*)(wl + WL_IN); ldt = DM | TILED_FLAG; mode = 3; }
    else if (item < CI_C1) { it = item - CI_NG; W = args.in[I_WIN] + (size_t)l * DM * IN_COLS; ldw = IN_COLS; nblk = 1; scale = args.in[I_MIXN] + l * DM; WT = (bf16*)(wl + WL_NG); ldt = DM; mode = 4; }
    else if (item < CI_C2) { it = item - CI_C1; const int kv = it >> 7; it &= 127; W = args.in[I_CW1] + (size_t)(l * 2 + kv) * 4096 * 128; ldw = 128; nblk = 2; WT = (bf16*)(wl + WL_C1) + (size_t)kv * 128 * 4096; ldt = 4096 | FRAG_FLAG; }
    else if (item < CI_UD) { it = item - CI_C2; const int kv = it >> 2; it &= 3; W = args.in[I_CW2] + (size_t)(l * 2 + kv) * 128 * 128; ldw = 128; nblk = 2; WT = (bf16*)(wl + WL_C2) + (size_t)kv * 128 * 128; ldt = 128; }
    else if (item < CI_UN) { it = item - CI_UD; W = args.in[I_WUD] + (size_t)l * 1024 * DM; ldw = DM; nblk = 32; WT = (bf16*)(wl + WL_UP); ldt = 2560 | TILED_FLAG; }
    else if (item < CI_UM) { it = item - CI_UN; W = args.in[I_WUN] + (size_t)l * 1024 * DM; ldw = DM; nblk = 32; WT = (bf16*)(wl + WL_UP); ldt = 2560 | TILED_FLAG; kd0 = 1024; }
    else if (item < CI_O)  { it = item - CI_UM; W = args.in[I_WUM] + (size_t)l * 512 * DM; ldw = DM; nblk = 32; WT = (bf16*)(wl + WL_UP); ldt = 2560 | TILED_FLAG; kd0 = 2048; }
    else if (item < CI_G2) { it = item - CI_O;  W = args.in[I_WO] + (size_t)l * DM * DM; ldw = DM; nblk = 32; WT = (bf16*)(wl + WL_O); ldt = DM | TILED_FLAG; }
    else if (item < CI_U2) { it = item - CI_G2; W = args.in[I_F2G] + (size_t)l * DM * DFF; ldw = DFF; nblk = DFF / 64; scale = args.in[I_F2N] + l * DM; WT = (bf16*)(wl + WL_GU2); ldt = DM | TILED_FLAG; mode = 1; }
    else if (item < CI_D2) { it = item - CI_U2; W = args.in[I_F2U] + (size_t)l * DM * DFF; ldw = DFF; nblk = DFF / 64; scale = args.in[I_F2N] + l * DM; WT = (bf16*)(wl + WL_GU2); ldt = DM | TILED_FLAG; mode = 2; }
    else                   { it = item - CI_D2; W = args.in[I_F2D] + (size_t)l * DM * DFF; ldw = DM; nblk = DM / 64; WT = (bf16*)(wl + WL_D2); ldt = DFF | TILED_FLAG; }
    const int kb = it / nblk, nb = it % nblk, n0 = 64 * nb; int c0 = n0, r0 = n0, ncv = 64, nrv = 64;
    if (mode == 1) r0 = 256 * (n0 >> 7) + (n0 & 127);
    else if (mode == 2) r0 = 256 * (n0 >> 7) + 128 + (n0 & 127);
    else if (mode == 3) c0 = (n0 < NG_COL0) ? n0 : n0 + 24;
    else if (mode == 4) { c0 = NG_COL0; ncv = 24; nrv = 32; }
    d.sidx = (scale == nullptr) ? 0 : ((item < CI_D1) ? 1 : ((item < CI_C1) ? 2 : 3));
    d.W = W; d.scale = scale; d.WT = WT; d.ldt = ldt; d.ldw = ldw; d.kd0 = kd0; d.k0 = 64 * kb; d.c0 = c0; d.r0 = r0; d.ncv = ncv; d.nrv = nrv; d.tiled = ((ldt & TILED_FLAG) && mode != 4) ? 1 : 0;
}
__device__ __forceinline__ void cvt_ld(const CvtD& d, int lane, f32x4 (&v)[16]) {
    if (!d.tiled) return;
    const int n4 = (lane & 15) * 4, kr = lane >> 4; const GAS float* p = (const GAS float*)d.W + (size_t)(d.k0 + 16 * kr) * d.ldw + d.c0 + n4;
#pragma unroll
    for (int i = 0; i < 16; ++i) v[i] = __builtin_nontemporal_load((const GAS f32x4*)(p + (size_t)i * d.ldw));
}
__device__ __forceinline__ void cvt_fin(const CvtD& d, int lane, const f32x4 (&v)[16], LAS unsigned char* scr, const LAS float* gains  ) {
    if (!d.tiled) { cvt_item(d.W, (size_t)d.ldw, d.k0, d.c0, d.ncv, d.nrv, d.scale, d.WT, d.ldt, d.r0, d.kd0, lane); return; }
    const int n4 = (lane & 15) * 4, kr = lane >> 4; f32x4 sv[4];
    if (d.sidx) {
#pragma unroll
        for (int q = 0; q < 4; ++q) sv[q] = *(const LAS f32x4*)(gains + (d.sidx - 1) * 2048 + d.k0 + 16 * kr + 4 * q); }
    else {
#pragma unroll
        for (int q = 0; q < 4; ++q) sv[q] = (f32x4){1.f, 1.f, 1.f, 1.f}; }
#pragma unroll
    for (int e = 0; e < 4; ++e) { v4u o0, o1;
#define CP_(a) pg8::cvt_pk_bf16(v[a][e] * sv[(a) >> 2][(a) & 3], v[(a) + 1][e] * sv[((a) + 1) >> 2][((a) + 1) & 3])
        o0.x = CP_(0); o0.y = CP_(2); o0.z = CP_(4); o0.w = CP_(6); o1.x = CP_(8); o1.y = CP_(10); o1.z = CP_(12); o1.w = CP_(14);
#undef CP_
        LAS v4u* lp = (LAS v4u*)(scr + (n4 + e) * 144 + kr * 32); lp[0] = o0; lp[1] = o1; }
    asm volatile("s_waitcnt lgkmcnt(0)" ::: "memory");
    const int rr = lane >> 3, p = lane & 7; const size_t KT = (size_t)(d.ldt & ~TILED_FLAG) / 64;
    GAS v4u* dp = (GAS v4u*)(d.WT + (((size_t)(d.r0 >> 8) * KT + (size_t)((d.kd0 + d.k0) >> 6)) * 256 + (d.r0 & 255)) * 64) + lane;
    v4u t[8];
#pragma unroll
    for (int q = 0; q < 8; ++q) t[q] = *(const LAS v4u*)(scr + (8 * q + rr) * 144 + p * 16);
#pragma unroll
    for (int q = 0; q < 8; ++q) __builtin_nontemporal_store(t[q], dp + 64 * q);
    asm volatile("s_waitcnt lgkmcnt(0)" ::: "memory");
}
template <class ArgsT> __device__ __forceinline__ void cvt_pull(const ArgsT& args, unsigned char* ws, int L, gu32* ctr, int tid, LAS unsigned char* ring) {
    static_assert(CVT_ITEMS % 8 == 0, "cvt_pull takes eight items per pull");
    const int lane = tid & 63, wave = __builtin_amdgcn_readfirstlane(tid >> 6);
    LAS unsigned char* scr = ring + wave * 9216; LAS float* gains = (LAS float*)(ring + 8 * 9216);
    for (int i = tid; i < 3 * 2048; i += NTHREADS) { const int g = i >> 11, k = i & 2047; gains[i] = (g == 0 ? args.in[I_F1N] : (g == 1 ? args.in[I_MIXN] : args.in[I_F2N]))[L * DM + k]; }
    __syncthreads();
    for (;;) { unsigned b0 = 0u; if (lane == 0) b0 = __hip_atomic_fetch_add(ctr, 8u, __ATOMIC_RELAXED, __HIP_MEMORY_SCOPE_AGENT);
        const int base = (int)__builtin_amdgcn_readfirstlane((int)b0); if (base >= CVT_ITEMS) break;
        CvtD dA, dB; f32x4 vA[16], vB[16];
        cvt_desc(args, ws, L, base, dA); cvt_ld(dA, lane, vA);
#pragma unroll 1
        for (int jj = 0; jj < 4; ++jj) {
            cvt_desc(args, ws, L, base + 2 * jj + 1, dB); cvt_ld(dB, lane, vB);
            cvt_fin(dA, lane, vA, scr, gains);
            if (jj < 3) { cvt_desc(args, ws, L, base + 2 * jj + 2, dA); cvt_ld(dA, lane, vA); }
            cvt_fin(dB, lane, vB, scr, gains); } }
    __syncthreads();
}

namespace att {
typedef short bf16x8 __attribute__((ext_vector_type(8)));
typedef short s16x4 __attribute__((ext_vector_type(4)));
typedef float f32x16 __attribute__((ext_vector_type(16)));
typedef unsigned u32x4 __attribute__((ext_vector_type(4)));
#define KSWZ(row, colB) ((row) * 256 + ((colB) ^ (((row) & 7) << 4)))
#define SBAR() __builtin_amdgcn_sched_barrier(0)
constexpr int SHM_T = 16384;
constexpr int L_V = 0, L_K = 3 * SHM_T, L_WS = 6 * SHM_T, L_IMP = L_WS + 8 * 256, L_SEL = L_IMP + 64 * 65 * 4, L_MISC = L_SEL + 512, L_END = L_MISC + 64, L_STG = 65536  , L_TOP = L_STG + 4 * 8192;
static_assert(L_END <= 131072 && L_TOP <= L_WS, "attention LDS map");
constexpr float LOG2E = 1.4426950408889634f;
__device__ __forceinline__ int crow(int r, int hi) { return (r & 3) + 8 * (r >> 2) + 4 * hi; }
__device__ __forceinline__ unsigned cvtpk(float lo, float hi) { return pg8::cvt_pk_bf16(lo, hi); }
__device__ __forceinline__ int v_st(int k, int c) { const int kk = (k & ~0xC) | ((k & 4) << 1) | ((k & 8) >> 1); return ((kk >> 3) * 4 + (c >> 5)) * 512 + ((kk & 7) * 32 + (c & 31)) * 2; }
__device__ __forceinline__ int v_rd_base(int lane) { return ((lane & 3) << 3) | (((lane >> 2) & 3) << 6) | (((lane >> 4) & 1) << 5) | (((lane >> 5) & 1) << 8); }
constexpr int v_rd_off(int d0, int ks, int half) { return d0 * 512 + ks * 4096 + half * 2048; }
template <int OFF> __device__ __forceinline__ s16x4 tr_read(int vb) { s16x4 r; asm volatile("ds_read_b64_tr_b16 %0, %1 offset:%2" : "=&v"(r) : "v"(vb), "i"(OFF) : "memory"); return r; }
template <int D0> __device__ __forceinline__ void pv_one(f32x16& od, int vb, bf16x8 pa0, bf16x8 pa1, bf16x8 pa2, bf16x8 pa3) {
  const s16x4 l0 = tr_read<v_rd_off(D0, 0, 0)>(vb), h0 = tr_read<v_rd_off(D0, 0, 1)>(vb), l1 = tr_read<v_rd_off(D0, 1, 0)>(vb), h1 = tr_read<v_rd_off(D0, 1, 1)>(vb);
  const s16x4 l2 = tr_read<v_rd_off(D0, 2, 0)>(vb), h2 = tr_read<v_rd_off(D0, 2, 1)>(vb), l3 = tr_read<v_rd_off(D0, 3, 0)>(vb), h3 = tr_read<v_rd_off(D0, 3, 1)>(vb);
  asm volatile("s_waitcnt lgkmcnt(0)" ::: "memory"); SBAR();
#define PK(L, H) (bf16x8){L[0], L[1], L[2], L[3], H[0], H[1], H[2], H[3]}
  od = __builtin_amdgcn_mfma_f32_32x32x16_bf16(pa0, PK(l0, h0), od, 0, 0, 0);
  od = __builtin_amdgcn_mfma_f32_32x32x16_bf16(pa1, PK(l1, h1), od, 0, 0, 0);
  od = __builtin_amdgcn_mfma_f32_32x32x16_bf16(pa2, PK(l2, h2), od, 0, 0, 0);
  od = __builtin_amdgcn_mfma_f32_32x32x16_bf16(pa3, PK(l3, h3), od, 0, 0, 0);
#undef PK
}
__device__ __forceinline__ void pv_d0(f32x16 (&o)[4], int vb, bf16x8 pa0, bf16x8 pa1, bf16x8 pa2, bf16x8 pa3) {
  pv_one<0>(o[0], vb, pa0, pa1, pa2, pa3); pv_one<1>(o[1], vb, pa0, pa1, pa2, pa3); pv_one<2>(o[2], vb, pa0, pa1, pa2, pa3); pv_one<3>(o[3], vb, pa0, pa1, pa2, pa3);
}
typedef float f32x4_t __attribute__((ext_vector_type(4)));
typedef __attribute__((address_space(3))) const bf16x8* lds_frag_ptr;
typedef __attribute__((address_space(3))) float lds_f32;
typedef __attribute__((address_space(3))) unsigned short lds_u16;
typedef __attribute__((address_space(3))) unsigned long long lds_u64;
typedef __attribute__((address_space(3))) char lds_char;
__device__ __forceinline__ void k_addr(int (&ka)[4], int kbase  , int r32, int hi) {
#pragma unroll
  for (int j = 0; j < 4; ++j) ka[j] = kbase + r32 * 256 + ((j * 32 + hi * 16) ^ ((r32 & 7) << 4));
}
template <int ND0> __device__ __forceinline__ void qkt(f32x16& p0, f32x16& p1, const int (&ka)[4], const bf16x8 (&qr)[ND0]) {
#pragma unroll
  for (int h = 0; h < ND0; h += 4) { bf16x8 kb0[4], kb1[4];
#pragma unroll
    for (int j = 0; j < 4; ++j) { kb0[j] = *(lds_frag_ptr)(unsigned)(ka[(h + j) & 3] + ((h + j) >> 2) * 128); kb1[j] = *(lds_frag_ptr)(unsigned)(ka[(h + j) & 3] + ((h + j) >> 2) * 128 + 8192); }
    SBAR();
#pragma unroll
    for (int j = 0; j < 4; ++j) { p0 = __builtin_amdgcn_mfma_f32_32x32x16_bf16(kb0[j], qr[h + j], p0, 0, 0, 0); p1 = __builtin_amdgcn_mfma_f32_32x32x16_bf16(kb1[j], qr[h + j], p1, 0, 0, 0); }
  }
}
template <int ND0, bool BIAS, bool SELM>
__device__ __forceinline__ void run_tiles(char* lds, const bf16* Kg, const bf16* Vg, size_t ldk, size_t ldv, unsigned long long tmask, const bf16x8 (&qr)[ND0], int dbase,
                                          float slope2, int q, int klo, int khi, int klo_max, int khi_min, unsigned long long selq,
                                          f32x16 (&o)[4], float& m_reg, float& l_reg, int tid_in) {
  int tid = tid_in; asm volatile("" : "+v"(tid)); const int lane = tid & 63;
  const int r32 = lane & 31, hi = lane >> 5, wid = __builtin_amdgcn_readfirstlane(tid >> 6);
  const int vb0 = (int)(uintptr_t)(lds + L_V) + v_rd_base(lane);
  int kinv[4]; k_addr(kinv, (int)(uintptr_t)(lds + L_K) + (dbase >> 2) * 128, r32, hi);
  lds_f32* al_l = (lds_f32*)(lds + L_WS) + wid * 64;
  if (tmask == 0ull) return;
  const int wu = wid;
  unsigned koff[2], voff[2];
#pragma unroll
  for (int i = 0; i < 2; ++i) { const int pc = wu + 8 * i;
    const int krow = pc * 4 + (lane >> 4), kcol = ((lane & 15) ^ (krow & 7)) * 8; koff[i] = (unsigned)(krow * (int)ldk + kcol);
    const int sub = pc * 2 + (lane >> 5), kk = (sub >> 2) * 8 + ((lane & 31) >> 2), vk = (kk & ~0xC) | ((kk & 4) << 1) | ((kk & 8) >> 1), vc = (sub & 3) * 32 + (lane & 3) * 8; voff[i] = (unsigned)(vk * (int)ldv + vc); }
  typedef __attribute__((address_space(3))) unsigned lds_u32;
  lds_u32* ldsa = (lds_u32*)lds;
#define DMA_K(key0, b) do { _Pragma("unroll") for (int i_ = 0; i_ < 2; ++i_) \
    __builtin_amdgcn_global_load_lds((const unsigned*)(Kg + (size_t)(key0) * ldk + koff[i_]), (lds_u32*)((__attribute__((address_space(3))) char*)ldsa + L_K + (b) * SHM_T + (wu + 8 * i_) * 1024), 16, 0, 0); } while (0)
#define DMA_V(key0, b) do { _Pragma("unroll") for (int i_ = 0; i_ < 2; ++i_) \
    __builtin_amdgcn_global_load_lds((const unsigned*)(Vg + (size_t)(key0) * ldv + voff[i_]), (lds_u32*)((__attribute__((address_space(3))) char*)ldsa + L_V + (b) * SHM_T + (wu + 8 * i_) * 1024), 16, 0, 0); } while (0)
#define QK(P0, P1, tt, kb) do { const bool sq_ = SELM ? (((selq >> (tt)) & 1ull) != 0ull) : true;     \
    const float b0_ = sq_ ? (BIAS ? slope2 * (float)((tt) * 64 + 4 * hi - q) : 0.f) : -INFINITY; \
    _Pragma("unroll") for (int r = 0; r < 16; ++r) { const int cr = (r & 3) + 8 * (r >> 2); P0[r] = BIAS ? fmaf(slope2, (float)cr, b0_) : b0_; P1[r] = BIAS ? fmaf(slope2, (float)(cr + 32), b0_) : b0_; } \
    int ka_[4]; _Pragma("unroll") for (int j = 0; j < 4; ++j) ka_[j] = kinv[j] + (kb) * SHM_T; \
    qkt<ND0>(P0, P1, ka_, qr); } while (0)
#define SM_PV(P0, P1, tt, vbuf) do { const int tb = (tt) * 64; \
    bool selb = true; if (SELM) selb = ((selq >> (tt)) & 1ull) != 0ull; \
    if ((tb < klo_max) || (tb + 63 > khi_min)) { \
      const bool lv = selb && (khi >= klo); const unsigned span = lv ? (unsigned)(khi - klo) : 0u; const int lo_t = lv ? (klo - tb - 4 * hi) : 1000000; \
      _Pragma("unroll") for (int r = 0; r < 16; ++r) { const int cr = (r & 3) + 8 * (r >> 2); \
        P0[r] = ((unsigned)(cr - lo_t) <= span) ? P0[r] : -INFINITY; P1[r] = ((unsigned)(cr + 32 - lo_t) <= span) ? P1[r] : -INFINITY; } } \
    float pmax = fmaxf(P0[0], P1[0]); \
    _Pragma("unroll") for (int r = 1; r < 16; ++r) pmax = fmaxf(fmaxf(pmax, P0[r]), P1[r]); \
    { auto rr = __builtin_amdgcn_permlane32_swap(__float_as_uint(pmax), __float_as_uint(pmax), false, false); pmax = fmaxf(__uint_as_float(rr[0]), __uint_as_float(rr[1])); } \
    const float mn = (pmax > m_reg + 8.0f) ? pmax : m_reg, alpha = __builtin_amdgcn_exp2f(m_reg - mn); m_reg = mn;     \
    _Pragma("unroll") for (int r = 0; r < 16; ++r) { P0[r] = __builtin_amdgcn_exp2f(P0[r] - mn); P1[r] = __builtin_amdgcn_exp2f(P1[r] - mn); } \
    float ps; { typedef float f32x2_ __attribute__((ext_vector_type(2))); f32x2_ s2 = {0.f, 0.f}; \
      _Pragma("unroll") for (int r = 0; r < 16; r += 2) { s2 += (f32x2_){P0[r], P0[r + 1]}; s2 += (f32x2_){P1[r], P1[r + 1]}; } ps = s2.x + s2.y; } \
    { auto rr = __builtin_amdgcn_permlane32_swap(__float_as_uint(ps), __float_as_uint(ps), false, false); ps = __uint_as_float(rr[0]) + __uint_as_float(rr[1]); } \
    l_reg = l_reg * alpha + ps; \
    bf16x8 pa0, pa1, pa2, pa3; \
    PK4(P0, 0, pa0); PK4(P0, 8, pa1); PK4(P1, 0, pa2); PK4(P1, 8, pa3); \
    if (__any(alpha < 1.f)) { if (hi == 0) al_l[r32] = alpha; asm volatile("s_waitcnt lgkmcnt(0)" ::: "memory"); \
      _Pragma("unroll") for (int d = 0; d < 4; ++d) _Pragma("unroll") for (int r = 0; r < 16; ++r) o[d][r] *= al_l[crow(r, hi)]; } \
    pv_d0(o, vb0 + (vbuf) * SHM_T, pa0, pa1, pa2, pa3); } while (0)
#define PK4(P, BASE, OUT) do { unsigned a0 = cvtpk(P[BASE + 0], P[BASE + 1]), a1 = cvtpk(P[BASE + 2], P[BASE + 3]);   \
    unsigned b0_ = cvtpk(P[BASE + 4], P[BASE + 5]), b1_ = cvtpk(P[BASE + 6], P[BASE + 7]);                              \
    auto r0 = __builtin_amdgcn_permlane32_swap(a0, b0_, false, false); auto r1 = __builtin_amdgcn_permlane32_swap(a1, b1_, false, false); \
    u32x4 w = {r0[0], r1[0], r0[1], r1[1]}; OUT = *reinterpret_cast<bf16x8*>(&w); } while (0)
#define NEXT_TILE(var) do { var = -1; if (tmask != 0ull) { var = 63 - (int)__builtin_clzll(tmask); tmask &= ~(1ull << var); } } while (0)
#define WAIT_BAR() do { asm volatile("s_waitcnt vmcnt(0)" ::: "memory"); __syncthreads(); } while (0)
#define STEP_WAIT(nk, nv) do { if ((nk) && (nv)) asm volatile("s_waitcnt vmcnt(4)" ::: "memory"); else if ((nk) || (nv)) asm volatile("s_waitcnt vmcnt(2)" ::: "memory"); else asm volatile("s_waitcnt vmcnt(0)" ::: "memory"); \
    asm volatile("s_waitcnt lgkmcnt(0)" ::: "memory"); __builtin_amdgcn_s_barrier(); asm volatile("" ::: "memory"); } while (0)
  int t0, t1, t2, t3; NEXT_TILE(t0); NEXT_TILE(t1); NEXT_TILE(t2);
  DMA_K(t0 * 64, 0); DMA_V(t0 * 64, 0); if (t1 >= 0) { DMA_K(t1 * 64, 1); DMA_V(t1 * 64, 1); } if (t2 >= 0) DMA_K(t2 * 64, 2);
  if (t2 >= 0) asm volatile("s_waitcnt vmcnt(4)" ::: "memory"); else if (t1 >= 0) asm volatile("s_waitcnt vmcnt(2)" ::: "memory"); else asm volatile("s_waitcnt vmcnt(0)" ::: "memory");
  asm volatile("s_waitcnt lgkmcnt(0)" ::: "memory"); __builtin_amdgcn_s_barrier(); asm volatile("" ::: "memory");
  f32x16 pA0, pA1, pB0, pB1;
  QK(pA0, pA1, t0, 0);
  asm volatile("s_waitcnt lgkmcnt(0)" ::: "memory"); __builtin_amdgcn_s_barrier(); asm volatile("" ::: "memory");
  int s0 = 0, s1 = 1, s2 = 2;
  for (;;) {
    NEXT_TILE(t3);
    if (t3 >= 0) DMA_K(t3 * 64, s0);
    if (t2 >= 0) DMA_V(t2 * 64, s2);
    if (t1 >= 0) QK(pB0, pB1, t1, s1);
    SM_PV(pA0, pA1, t0, s0);
    STEP_WAIT(t3 >= 0, t2 >= 0);
    if (t1 < 0) break;
    t0 = t1; t1 = t2; t2 = t3; { const int r_ = s0; s0 = s1; s1 = s2; s2 = r_; }
    NEXT_TILE(t3);
    if (t3 >= 0) DMA_K(t3 * 64, s0);
    if (t2 >= 0) DMA_V(t2 * 64, s2);
    if (t1 >= 0) QK(pA0, pA1, t1, s1);
    SM_PV(pB0, pB1, t0, s0);
    STEP_WAIT(t3 >= 0, t2 >= 0);
    if (t1 < 0) break;
    t0 = t1; t1 = t2; t2 = t3; { const int r_ = s0; s0 = s1; s1 = s2; s2 = r_; }
  }
  asm volatile("s_waitcnt vmcnt(0) lgkmcnt(0)" ::: "memory"); __syncthreads();
#undef STEP_WAIT
#undef DMA_K
#undef DMA_V
#undef QK
#undef SM_PV
#undef PK4
#undef NEXT_TILE
#undef WAIT_BAR
}
__device__ __forceinline__ void row_bcast(lds_f32* wl, float sc, float (&out)[16], int r32_in, int hi_in) {
  int r32 = r32_in, hi = hi_in; asm volatile("" : "+v"(r32), "+v"(hi));
  asm volatile("s_waitcnt lgkmcnt(0)" ::: "memory");
  if (hi == 0) wl[r32] = sc; asm volatile("s_waitcnt lgkmcnt(0)" ::: "memory");
#pragma unroll
  for (int r = 0; r < 16; ++r) out[r] = wl[crow(r, hi)];
  asm volatile("s_waitcnt lgkmcnt(0)" ::: "memory");
}
template <int N> __device__ __forceinline__ void load_q(bf16x8 (&qr)[N], const bf16* qp  , int hi) {
#pragma unroll
  for (int d0 = 0; d0 < N; ++d0) qr[d0] = *reinterpret_cast<const bf16x8*>(qp + d0 * 16 + hi * 8);
}

__device__ __forceinline__ void store_rows(const f32x16 (&o)[4], const float (&sc)[16], char* stg, bf16* gp  , size_t pitch, int lane_in) {
  int lane = lane_in; asm volatile("" : "+v"(lane));
  const int r32 = lane & 31, hi = lane >> 5;
  lds_u16* sp = (lds_u16*)stg + hi * 4 * 128 + r32;
#pragma unroll
  for (int r = 0; r < 16; ++r)
#pragma unroll
    for (int d0 = 0; d0 < 4; ++d0) sp[((r & 3) + 8 * (r >> 2)) * 128 + d0 * 32] = (unsigned short)f2bf(o[d0][r] * sc[r]);
  asm volatile("s_waitcnt lgkmcnt(0)" ::: "memory");
  const int ch = lane & 15, rr = lane >> 4;
#pragma unroll
  for (int i = 0; i < 8; ++i) { const int row = i * 4 + rr; const u32x4 v = *(const __attribute__((address_space(3))) u32x4*)((lds_char*)stg + row * 256 + ch * 16); *(u32x4*)(gp + (size_t)row * pitch + ch * 8) = v; }
  asm volatile("s_waitcnt lgkmcnt(0)" ::: "memory");
}

__device__ __forceinline__ void mem_unit(char* lds, int b, int hm, int qb, const bf16* MQ, const bf16* MKV  , bf16* ACAT, int tid_in) {
  int tid = tid_in; asm volatile("" : "+v"(tid)); const int lane = tid & 63;
  const int r32 = lane & 31, hi = lane >> 5, wid = __builtin_amdgcn_readfirstlane(tid >> 6);
  const size_t row0 = (size_t)b * SEQ + qb * 256 + wid * 32;
  bf16x8 qr[8]; load_q<8>(qr, MQ + (row0 + r32) * 512 + hm * 128, hi);
  f32x16 o[4] = {}; float m_reg = -1e30f, l_reg = 0.f;
  const bf16* Kg = MKV + (size_t)(b * MEM_LEN) * 4096 + hm * 128;
  run_tiles<8, false, false>(lds, Kg, Kg + 512, 4096, 4096, 0xFull, qr, 0, 0.f, 0, 0, 1 << 30, 0, 1 << 30, 0ull, o, m_reg, l_reg, tid);
  int lane2 = tid_in; asm volatile("" : "+v"(lane2)); lane2 &= 63;
  float sc[16]; row_bcast((lds_f32*)(lds + L_WS) + wid * 64, 1.0f / fmaxf(l_reg, 1e-30f), sc, lane2 & 31, lane2 >> 5);
  store_rows(o, sc, lds + wid * 8192, ACAT + row0 * 2560 + 2048 + hm * 128, 2560, lane2);
  __syncthreads();
}

__device__ __forceinline__ void diff_unit(char* lds, int b, int h, int qb, const bf16* DQ, const bf16* DK, const bf16* DV, bf16* ACAT, const float* subln, float lam, float lam_init, unsigned* nrm, int tid_in) {
  int tid = tid_in; asm volatile("" : "+v"(tid)); const int lane = tid & 63;
  int r32 = lane & 31, hi = lane >> 5; const int wid = __builtin_amdgcn_readfirstlane(tid >> 6), mp = wid >> 2, qs = wid & 3;
  const int q0w = qb * 128 + qs * 32, q = q0w + r32; const size_t rowb = (size_t)b * SEQ;
  bf16x8 qr[4]; load_q<4>(qr, DQ + (rowb + q) * 1024 + h * 128 + mp * 64, hi);
  f32x16 o[4] = {}; float m_reg = -1e30f, l_reg = 0.f;
  const int nt = (qb * 128 + 128) / 64; unsigned long long tmask = (nt >= 64) ? ~0ull : ((1ull << nt) - 1ull);
  const float slope2 = exp2f(-(float)(h + 1)) * LOG2E;
  { const float q2a = __uint_as_float(__hip_atomic_load(nrm + (h * 2) * 16, __ATOMIC_RELAXED, __HIP_MEMORY_SCOPE_AGENT)), q2b = __uint_as_float(__hip_atomic_load(nrm + (h * 2 + 1) * 16, __ATOMIC_RELAXED, __HIP_MEMORY_SCOPE_AGENT));
    const float k2a = __uint_as_float(__hip_atomic_load(nrm + (16 + h * 2) * 16, __ATOMIC_RELAXED, __HIP_MEMORY_SCOPE_AGENT)), k2b = __uint_as_float(__hip_atomic_load(nrm + (16 + h * 2 + 1) * 16, __ATOMIC_RELAXED, __HIP_MEMORY_SCOPE_AGENT));
    const float bqk = sqrtf(fmaxf(q2a * k2a, q2b * k2b)), dcut = (2.05f * bqk + 153.0f) / slope2;
    int ns = (dcut < 8192.f) ? (qb * 128 - (int)dcut - 1) / 64 : 0; ns = __builtin_amdgcn_readfirstlane(ns);
    if (ns > 0) tmask &= ~((1ull << ns) - 1ull); }
  run_tiles<4, true, false>(lds, DK + rowb * 1024 + h * 128, DV + rowb * 1024 + h * 128, 1024, 1024, tmask, qr, mp * 4, slope2, q, 0, q, 0, q0w, 0ull, o, m_reg, l_reg, tid);
  int lane2 = tid_in; asm volatile("" : "+v"(lane2)); lane2 &= 63; r32 = lane2 & 31; hi = lane2 >> 5;
  float sc[16]; row_bcast((lds_f32*)(lds + L_WS) + wid * 64, 1.0f / fmaxf(l_reg, 1e-30f), sc, r32, hi);
  lds_f32* X = (lds_f32*)lds + qs * 4096;
  if (mp == 1) {
#pragma unroll
    for (int r = 0; r < 16; ++r)
#pragma unroll
      for (int d0 = 0; d0 < 4; ++d0) X[crow(r, hi) * 128 + d0 * 32 + r32] = o[d0][r] * sc[r]; }
  __syncthreads();
  if (mp == 0) {
    const float kk = 1.0f - lam_init; float g4[4];
#pragma unroll
    for (int d0 = 0; d0 < 4; ++d0) g4[d0] = subln[d0 * 32 + r32] * kk;
#pragma unroll
    for (int r = 0; r < 16; ++r) { float ss = 0.f;
#pragma unroll
      for (int d0 = 0; d0 < 4; ++d0) { const float v = o[d0][r] * sc[r] - lam * X[crow(r, hi) * 128 + d0 * 32 + r32]; o[d0][r] = v * g4[d0]; ss += v * v; }
      ss += __shfl_xor(ss, 1); ss += __shfl_xor(ss, 2); ss += __shfl_xor(ss, 4); ss += __shfl_xor(ss, 8); ss += __shfl_xor(ss, 16);
      sc[r] = 1.0f / sqrtf(ss * (1.0f / 128.0f) + NORM_EPS); }
    store_rows(o, sc, lds + L_STG + qs * 8192, ACAT + (rowb + q0w) * 2560 + h * 128, 2560, lane2);
  }
  __syncthreads();
}

template <int MODE> __device__ __forceinline__ void acc_rows(f32x16 (&o)[4], const float (&sc)[16], float* ap  , int lane_in) {
  int lane = lane_in; asm volatile("" : "+v"(lane));
  GAS f32x4_t* p = (GAS f32x4_t*)ap + lane;
  if (MODE != 0) { f32x4_t t[16];
#pragma unroll
    for (int i = 0; i < 16; ++i) t[i] = p[i * 64];
#pragma unroll
    for (int i = 0; i < 16; ++i)
#pragma unroll
      for (int e = 0; e < 4; ++e) o[i >> 2][4 * (i & 3) + e] = o[i >> 2][4 * (i & 3) + e] * sc[4 * (i & 3) + e] + t[i][e];
    asm volatile("" ::: "memory");
    if (MODE == 1) {
#pragma unroll
      for (int i = 0; i < 16; ++i) p[i * 64] = (f32x4_t){o[i >> 2][4 * (i & 3)], o[i >> 2][4 * (i & 3) + 1], o[i >> 2][4 * (i & 3) + 2], o[i >> 2][4 * (i & 3) + 3]}; }
  } else {
#pragma unroll
    for (int i = 0; i < 16; ++i) p[i * 64] = (f32x4_t){o[i >> 2][4 * (i & 3)] * sc[4 * (i & 3)], o[i >> 2][4 * (i & 3) + 1] * sc[4 * (i & 3) + 1], o[i >> 2][4 * (i & 3) + 2] * sc[4 * (i & 3) + 2], o[i >> 2][4 * (i & 3) + 3] * sc[4 * (i & 3) + 3]}; }
}
__device__ __forceinline__ void imp_pass(char* lds, const bf16* Kc, int ntc, const bf16x8 (&qr)[8], int cmax, float m_reg, float il, float (&impa)[32], int tid, int lane) {
  const int r32 = lane & 31, hi = lane >> 5, sr = tid >> 4, sc = (tid & 15) * 8;
  for (int t = 0; t < ntc; ++t) { const bf16x8 k0 = *(const bf16x8*)(Kc + (size_t)(t * 64 + sr) * 128 + sc), k1 = *(const bf16x8*)(Kc + (size_t)(t * 64 + 32 + sr) * 128 + sc);
    *(bf16x8*)(lds + t * SHM_T + KSWZ(sr, sc * 2)) = k0; *(bf16x8*)(lds + t * SHM_T + KSWZ(32 + sr, sc * 2)) = k1; }
  __syncthreads();
  float carry = 0.f;
#pragma unroll
  for (int t = 0; t < 4; ++t) {
    if (t < ntc) {
      f32x16 p0 = f32x16{}, p1 = f32x16{}; { int ka[4]; k_addr(ka, (int)(uintptr_t)lds + t * SHM_T, r32, hi); qkt<8>(p0, p1, ka, qr); }
      const int kb = t * 64 + 4 * hi;
#pragma unroll
      for (int r = 0; r < 16; ++r) { const int cr = (r & 3) + 8 * (r >> 2);
        p0[r] = (kb + cr <= cmax) ? __builtin_amdgcn_exp2f(p0[r] - m_reg) * il : 0.f; p1[r] = (kb + cr + 32 <= cmax) ? __builtin_amdgcn_exp2f(p1[r] - m_reg) * il : 0.f; }
      float xp0[4], xp1[4], c0[4], c1[4];
#pragma unroll
      for (int a = 0; a < 4; ++a) { xp0[a] = __shfl_xor(p0[4 * a + 3], 32); xp1[a] = __shfl_xor(p1[4 * a + 3], 32);
        c0[a] = (p0[4 * a] + p0[4 * a + 1]) + (p0[4 * a + 2] + p0[4 * a + 3]); c1[a] = (p1[4 * a] + p1[4 * a + 1]) + (p1[4 * a + 2] + p1[4 * a + 3]); }
#pragma unroll
      for (int a = 0; a < 4; ++a) { const float e0 = hi ? xp0[a] : (a ? xp0[a > 0 ? a - 1 : 0] : carry), e1 = hi ? xp1[a] : (a ? xp1[a > 0 ? a - 1 : 0] : xp0[3]);
        impa[t * 8 + a] = c0[a] + e0; impa[t * 8 + 4 + a] = c1[a] + e1; }
      carry = xp1[3];
    } else {
#pragma unroll
      for (int i = 0; i < 8; ++i) impa[t * 8 + i] = 0.f; }
  }
  __syncthreads();
}
__device__ __forceinline__ void nsa_unit(char* lds, int b, int g, int cur, const bf16* NQ, const bf16* NKV, const bf16* KCMP, const float* NG, float* ACC, bf16* ACAT, int tid_in) {
  int tid = tid_in; asm volatile("" : "+v"(tid)); const int lane = tid & 63;
  const int r32 = lane & 31, hi = lane >> 5, wid = __builtin_amdgcn_readfirstlane(tid >> 6), hh = wid & 3, qh = wid >> 2, head = g * 4 + hh;
  const int q0w = cur * 64 + qh * 32, q = q0w + r32; const size_t rowb = (size_t)b * SEQ;
  bf16x8 qr[8]; load_q<8>(qr, NQ + (rowb + q) * 1024 + head * 128, hi);
  const float slope2 = exp2f(-(float)(head + 1)) * LOG2E;
  lds_f32* wl = (lds_f32*)(lds + L_WS) + wid * 64; lds_f32* imp_sh = (lds_f32*)(lds + L_IMP); lds_u64* sel_sh = (lds_u64*)(lds + L_SEL); lds_u64* misc = (lds_u64*)(lds + L_MISC);
  float* accp = ACC + ((size_t)(((b * 2 + g) * 64 + cur) * 8 + wid)) * 4096;
  const float* ngp = NG + (rowb + q) * 24 + head * 3;
  f32x16 o[4] = {}; float m_reg = -1e30f, l_reg = 0.f; float sc[16];
  { const int cmax = (q >= 31) ? ((q - 31) >> 4) : -1, cmin_w = (q0w >= 31) ? ((q0w - 31) >> 4) : -1;
    const int ntc = ((4 * cur + 2) >> 6) + 1; const unsigned long long tmc = (1ull << ntc) - 1ull;
    const bf16* Kc = KCMP + ((size_t)((0 * BATCH + b) * 2 + g) * 256) * 128; const bf16* Vc = KCMP + ((size_t)((1 * BATCH + b) * 2 + g) * 256) * 128;
    run_tiles<8, false, false>(lds, Kc, Vc, 128, 128, tmc, qr, 0, 0.f, q, 0, cmax, 0, cmin_w, 0ull, o, m_reg, l_reg, tid);
    const float il = 1.0f / fmaxf(l_reg, 1e-30f);
    row_bcast(wl, ngp[0] * il, sc, r32, hi); acc_rows<0>(o, sc, accp, lane);
    float impa[32]; imp_pass(lds, Kc, ntc, qr, cmax, m_reg, il, impa, tid, lane);
    for (int h4 = 0; h4 < 4; ++h4) {
      if (hh == h4) { lds_f32* ir = imp_sh + (qh * 32 + r32) * 65 + hi;
#pragma unroll
        for (int t = 0; t < 4; ++t)
#pragma unroll
          for (int a = 0; a < 4; ++a) { const float v0 = impa[t * 8 + a], v1 = impa[t * 8 + 4 + a];
            if (h4 == 0) { ir[16 * t + 2 * a] = v0; ir[16 * t + 8 + 2 * a] = v1; } else { ir[16 * t + 2 * a] += v0; ir[16 * t + 8 + 2 * a] += v1; } } }
      __syncthreads(); }
  }
  { const int ql = tid >> 3, sub = tid & 7; const lds_f32* ir = imp_sh + ql * 65;
    float myv[8]; int rank[8];
#pragma unroll
    for (int i = 0; i < 8; ++i) { const int j = sub * 8 + i; myv[i] = (j == 0 || j == cur || j == cur - 1) ? 1e9f : (j > cur ? -1e9f : ir[j]); rank[i] = 0; }
    for (int j2 = 0; j2 < 64; ++j2) { const float v2 = (j2 == 0 || j2 == cur || j2 == cur - 1) ? 1e9f : (j2 > cur ? -1e9f : ir[j2]);
#pragma unroll
      for (int i = 0; i < 8; ++i) rank[i] += ((v2 > myv[i]) || (v2 == myv[i] && j2 < sub * 8 + i)) ? 1 : 0; }
    unsigned bits = 0u;
#pragma unroll
    for (int i = 0; i < 8; ++i) bits |= (rank[i] < 8 ? 1u : 0u) << i;
    unsigned slo = (sub < 4) ? (bits << (8 * sub)) : 0u, shi = (sub >= 4) ? (bits << (8 * (sub - 4))) : 0u;
    slo |= __shfl_xor(slo, 1); slo |= __shfl_xor(slo, 2); slo |= __shfl_xor(slo, 4); shi |= __shfl_xor(shi, 1); shi |= __shfl_xor(shi, 2); shi |= __shfl_xor(shi, 4);
    if (sub == 0) sel_sh[ql] = ((unsigned long long)shi << 32) | slo;
    __syncthreads();
    if (wid == 0) { const unsigned long long v = sel_sh[lane]; unsigned a = (unsigned)v, c = (unsigned)(v >> 32);
#pragma unroll
      for (int s = 1; s < 64; s <<= 1) { a |= __shfl_xor(a, s); c |= __shfl_xor(c, s); }
      if (lane == 0) misc[0] = ((unsigned long long)c << 32) | a; }
    __syncthreads();
  }
  const unsigned long long selq = sel_sh[qh * 32 + r32];
  unsigned long long usel; { const unsigned long long v = misc[0]; usel = ((unsigned long long)(unsigned)__builtin_amdgcn_readfirstlane((int)(unsigned)(v >> 32)) << 32) | (unsigned)__builtin_amdgcn_readfirstlane((int)(unsigned)v); }
  { const unsigned long long upto = (cur >= 63) ? ~0ull : ((2ull << cur) - 1ull);
    const bf16* Ks = NKV + ((size_t)(1 * 4 + 0 * 2 + g) * MROWS + rowb) * 128; const bf16* Vs = NKV + ((size_t)(1 * 4 + 1 * 2 + g) * MROWS + rowb) * 128;
#pragma unroll
    for (int d = 0; d < 4; ++d) o[d] = f32x16{};
    m_reg = -1e30f; l_reg = 0.f;
    run_tiles<8, true, true>(lds, Ks, Vs, 128, 128, usel & upto, qr, 0, slope2, q, 0, q, 0, q0w, selq, o, m_reg, l_reg, tid);
    row_bcast(wl, ngp[1] / fmaxf(l_reg, 1e-30f), sc, r32, hi); acc_rows<1>(o, sc, accp, lane);
  }
  { const int tlo = cur >= 8 ? cur - 8 : 0; const unsigned long long upto = (cur >= 63) ? ~0ull : ((2ull << cur) - 1ull); const unsigned long long tmw = upto & ~((1ull << tlo) - 1ull);
    const bf16* Kw = NKV + ((size_t)(2 * 4 + 0 * 2 + g) * MROWS + rowb) * 128; const bf16* Vw = NKV + ((size_t)(2 * 4 + 1 * 2 + g) * MROWS + rowb) * 128;
#pragma unroll
    for (int d = 0; d < 4; ++d) o[d] = f32x16{};
    m_reg = -1e30f; l_reg = 0.f;
    run_tiles<8, true, false>(lds, Kw, Vw, 128, 128, tmw, qr, 0, slope2, q, q - 511, q, q0w + 31 - 511, q0w, 0ull, o, m_reg, l_reg, tid);
    int lane2 = tid_in; asm volatile("" : "+v"(lane2)); lane2 &= 63;
    row_bcast(wl, ngp[2] / fmaxf(l_reg, 1e-30f), sc, lane2 & 31, lane2 >> 5); acc_rows<2>(o, sc, accp, lane2);
#pragma unroll
    for (int r = 0; r < 16; ++r) sc[r] = 1.0f;
    store_rows(o, sc, lds + wid * 8192, ACAT + (rowb + q0w) * 2560 + 1024 + head * 128, 2560, lane2);
  }
  __syncthreads();
}
#undef KSWZ
#undef SBAR
}

namespace cmpx {
typedef short bf16x8 __attribute__((ext_vector_type(8)));
typedef float f32x4 __attribute__((ext_vector_type(4)));
typedef __attribute__((address_space(3))) float lds_f32;
typedef __attribute__((address_space(3))) unsigned short lds_u16;
__device__ __forceinline__ void cmp_unit(char* lds, int u, const bf16* NKV, const bf16* W1t  , const bf16* W2t  , const float* bias1  , bf16* KCMP, int tid_in) {
  int tid = tid_in; asm volatile("" : "+v"(tid)); const int lane = tid & 63, wid = __builtin_amdgcn_readfirstlane(tid >> 6), li = lane & 15, kq = lane >> 4;
  const int ct = u & 15, g = (u >> 4) & 1, b = (u >> 5) & 1, kv = u >> 6, c0 = ct * 16;
  const bf16* A = NKV + ((size_t)(0 * 4 + kv * 2 + g) * MROWS + (size_t)b * SEQ + 16 * (c0 + li)) * 128 + wid * 512 + 8 * kq;
  const bf16* B = W1t + (size_t)kv * 128 * 4096 + (size_t)wid * 16 * 8 * 512 + lane * 8;
  bf16x8 w2[4]; { const bf16* B2p = W2t + ((size_t)kv * 128 + wid * 16 + li) * 128 + 8 * kq;
#pragma unroll
    for (int ks = 0; ks < 4; ++ks) w2[ks] = *(const bf16x8*)(B2p + ks * 32); }
  f32x4 acc[8];
#pragma unroll
  for (int n = 0; n < 8; ++n) acc[n] = (f32x4){0.f, 0.f, 0.f, 0.f};
#pragma unroll 4
  for (int ks = 0; ks < 16; ++ks) { const bf16x8 a = *(const bf16x8*)(A + ks * 32);
#pragma unroll
    for (int n = 0; n < 8; ++n) { const bf16x8 w = *(const bf16x8*)(B + (size_t)(ks * 8 + n) * 512); acc[n] = __builtin_amdgcn_mfma_f32_16x16x32_bf16(a, w, acc[n], 0, 0, 0); } }
  lds_f32* P = (lds_f32*)lds; lds_u16* Hs = (lds_u16*)(lds + 65536);
#pragma unroll
  for (int n = 0; n < 8; ++n)
#pragma unroll
    for (int r = 0; r < 4; ++r) P[wid * 2048 + (4 * kq + r) * 128 + 16 * n + li] = acc[n][r];
  __syncthreads();
  { const int c = tid >> 5, n4 = (tid & 31) * 4; float v[4];
#pragma unroll
    for (int e = 0; e < 4; ++e) { float sacc = bias1[kv * 128 + n4 + e];
#pragma unroll
      for (int w = 0; w < 8; ++w) sacc += P[w * 2048 + c * 128 + n4 + e];
      v[e] = gelu_tanh(sacc); }
#pragma unroll
    for (int e = 0; e < 4; ++e) Hs[c * 128 + n4 + e] = (unsigned short)f2bf(v[e]); }
  __syncthreads();
  { f32x4 o2 = (f32x4){0.f, 0.f, 0.f, 0.f};
#pragma unroll
    for (int ks = 0; ks < 4; ++ks) { const bf16x8 a = *(const __attribute__((address_space(3))) bf16x8*)(Hs + li * 128 + ks * 32 + 8 * kq);
      o2 = __builtin_amdgcn_mfma_f32_16x16x32_bf16(a, w2[ks], o2, 0, 0, 0); }
    bf16* op = KCMP + ((size_t)((kv * BATCH + b) * 2 + g) * 256 + c0) * 128 + wid * 16 + li;
#pragma unroll
    for (int r = 0; r < 4; ++r) { const int c = 4 * kq + r; op[(size_t)c * 128] = (c0 + c < NCMP) ? (bf16)f2bf(o2[r]) : (bf16)0; } }
  __syncthreads();
}
__device__ __forceinline__ void ng_unit(char* lds, int u, const bf16* XB, const bf16* WNG, const float* ssq, float* NG, int tid_in) {
  int tid = tid_in; asm volatile("" : "+v"(tid)); const int lane = tid & 63, wid = __builtin_amdgcn_readfirstlane(tid >> 6), li = lane & 15, kq = lane >> 4;
  const bf16* A = XB + ((size_t)u * 32 + li) * DM + wid * 256 + 8 * kq; const bf16* B = WNG + (size_t)li * DM + wid * 256 + 8 * kq;
  f32x4 acc[2][2];
#pragma unroll
  for (int i = 0; i < 2; ++i)
#pragma unroll
    for (int j = 0; j < 2; ++j) acc[i][j] = (f32x4){0.f, 0.f, 0.f, 0.f};
#pragma unroll
  for (int ks = 0; ks < 8; ++ks) { bf16x8 a[2], w[2];
#pragma unroll
    for (int i = 0; i < 2; ++i) { a[i] = *(const bf16x8*)(A + (size_t)i * 16 * DM + ks * 32); w[i] = *(const bf16x8*)(B + (size_t)i * 16 * DM + ks * 32); }
#pragma unroll
    for (int i = 0; i < 2; ++i)
#pragma unroll
      for (int j = 0; j < 2; ++j) acc[i][j] = __builtin_amdgcn_mfma_f32_16x16x32_bf16(a[i], w[j], acc[i][j], 0, 0, 0); }
  lds_f32* P = (lds_f32*)lds;
#pragma unroll
  for (int i = 0; i < 2; ++i)
#pragma unroll
    for (int j = 0; j < 2; ++j)
#pragma unroll
      for (int r = 0; r < 4; ++r) P[wid * 1024 + (16 * i + 4 * kq + r) * 32 + 16 * j + li] = acc[i][j][r];
  __syncthreads();
  { const int row = tid >> 4, j0 = (tid & 15) * 2; const float rs = pg8::row_rstd(ssq, u * 32 + row);
#pragma unroll
    for (int e = 0; e < 2; ++e) { const int j = j0 + e; float sacc = 0.f;
#pragma unroll
      for (int w = 0; w < 8; ++w) sacc += P[w * 1024 + row * 32 + j];
      if (j < 24) NG[(size_t)(u * 32 + row) * 24 + j] = 1.0f / (1.0f + __expf(-sacc * rs)); } }
  __syncthreads();
}

__device__ __forceinline__ void qk_norm_max(char* lds, const bf16* DQ, const bf16* DK, unsigned* nrm  , int wg, int nwg, int tid_in) {
  int tid = tid_in; asm volatile("" : "+v"(tid)); const int lane = tid & 63, wid = __builtin_amdgcn_readfirstlane(tid >> 6);
  float qm = 0.f, km = 0.f;
  for (int r = wg * 8 + wid; r < MROWS; r += nwg * 8) {
    const v4u a0 = *(const __attribute__((address_space(1))) v4u*)(DQ + (size_t)r * 1024 + lane * 16), a1 = *(const __attribute__((address_space(1))) v4u*)(DQ + (size_t)r * 1024 + lane * 16 + 8);
    const v4u b0 = *(const __attribute__((address_space(1))) v4u*)(DK + (size_t)r * 1024 + lane * 16), b1 = *(const __attribute__((address_space(1))) v4u*)(DK + (size_t)r * 1024 + lane * 16 + 8);
    float sq = 0.f, sk = 0.f;
#pragma unroll
    for (int e = 0; e < 4; ++e) { const float q0 = blo(a0[e]), q1 = bhi(a0[e]), q2 = blo(a1[e]), q3 = bhi(a1[e]); sq += (q0 * q0 + q1 * q1) + (q2 * q2 + q3 * q3);
      const float k0 = blo(b0[e]), k1 = bhi(b0[e]), k2 = blo(b1[e]), k3 = bhi(b1[e]); sk += (k0 * k0 + k1 * k1) + (k2 * k2 + k3 * k3); }
    sq += __shfl_xor(sq, 1); sq += __shfl_xor(sq, 2); sk += __shfl_xor(sk, 1); sk += __shfl_xor(sk, 2);
    qm = fmaxf(qm, sq); km = fmaxf(km, sk); }
  lds_f32* red = (lds_f32*)lds;
  __syncthreads();
  if ((lane & 3) == 0) { red[wid * 32 + (lane >> 2)] = qm; red[wid * 32 + 16 + (lane >> 2)] = km; }
  __syncthreads();
  if (tid < 32) { float m = red[tid];
#pragma unroll
    for (int w = 1; w < 8; ++w) m = fmaxf(m, red[w * 32 + tid]);
    (void)__hip_atomic_fetch_max(nrm + tid * 16, __float_as_uint(m), __ATOMIC_RELAXED, __HIP_MEMORY_SCOPE_AGENT); }
  __syncthreads();
}
}


#ifndef SITE_MASK
#define SITE_MASK 0xffffffffu
#endif
#define SITE(k) ((SITE_MASK >> (k)) & 1u)
struct Args { const float* in[N_IN]; float* out; unsigned char* ws; int step_lo, step_hi; };
constexpr int N_STEPS = 1 + DEPTH * 9 + 1;

__global__ void __launch_bounds__(NTHREADS, 2) trunk_fwd(Args args_unused) {
#define SITE_ARGS const __attribute__((address_space(4))) Args* argp_ = (const __attribute__((address_space(4))) Args*)__builtin_amdgcn_kernarg_segment_ptr(); asm volatile("" : "+s"(argp_)); const __attribute__((address_space(4))) Args& args = *argp_;
    unsigned char* ws; int lo, hi; { SITE_ARGS ws = args.ws; lo = args.step_lo; hi = args.step_hi; }
    extern __shared__ __attribute__((aligned(16))) unsigned char lds_raw[];
    LAS unsigned char* lds = (LAS unsigned char*)lds_raw;
    volatile LAS unsigned* MISC = (volatile LAS unsigned*)(lds + MISC_OFF);
    const int G = gridDim.x, NT = G * NTHREADS, NGW = G * NWAVES;
    const int wave_u = __builtin_amdgcn_readfirstlane((int)(threadIdx.x >> 6));
#define MYTID (wave_u * 64 + lane_id_fresh())
#define SITE_IDS int tid = MYTID; asm volatile("" : "+v"(tid)); const int lane = tid & 63, wave = __builtin_amdgcn_readfirstlane(tid >> 6), gtid = blockIdx.x * NTHREADS + tid, gw = blockIdx.x * NWAVES + wave; (void)lane; (void)gtid; (void)gw;
    gu32* ctl = (gu32*)(ws + WS_CTL);
    for (int u = threadIdx.x; u < (LDS_BYTES - LDSCTL_OFF) / 4; u += NTHREADS) ((LAS unsigned*)(lds + LDSCTL_OFF))[u] = 0u;
    __syncthreads();
    if (hi - lo > 1) (void)xcd_barrier_post((unsigned*)(ctl + CW_BAR), MISC + 8);
#define RUN(s) ((s) >= lo && (s) < hi)
#define SEAM(s) do { if ((s) + 1 < hi) { XcdBarrier bar_; bar_.bar = (unsigned*)((gu32*)(ws + WS_CTL) + CW_BAR); bar_.x = xb_xcc_id(); bar_.st = (volatile LAS unsigned*)(lds + MISC_OFF) + 8; xcd_barrier(bar_); } } while (0)
    bf16* XB = (bf16*)(ws + WS_XB); float* SSQ = (float*)(ws + WS_SSQ);
    bf16* Hb = (bf16*)(ws + WS_H);
    float* BIAS1 = (float*)(ws + WS_MISC); float* LAMV = (float*)(ws + WS_MISC + 4096);
    LAS float* epi_scr = (LAS float*)(lds + EPI_OFF);

    if (SITE(0) && RUN(0)) {
        SITE_IDS SITE_ARGS
        LAS float* scr = (LAS float*)(lds + RING_OFF + wave * 16384);
        const bool halfsplit = (G & 15) == 0; const int Gs = halfsplit ? G / 2 : G, sidx = halfsplit ? (int)(((blockIdx.x >> 4) << 3) | (blockIdx.x & 7u)) : (int)blockIdx.x;
        if (!halfsplit || ((blockIdx.x >> 3) & 1u) == 0u) {
        const int gws = sidx * NWAVES + wave, NGWs = Gs * NWAVES;
        for (int l = 0; l < DEPTH; ++l) cvt_job(args.in[I_WMKV] + (size_t)l * DM * 1024, DM, 1024, 16, args.in[I_MEMN] + l * DM, (bf16*)(ws + WS_WMKV) + (size_t)l * 1024 * DM, DM | TILED_FLAG, 0, 0, scr, gws, NGWs, lane);
        for (int m = gws; m < MROWS + MEMROWS; m += NGWs) {
            const bool isx = m < MROWS; const int r = isx ? m : m - MROWS;
            const float* src = isx ? args.in[I_X] + (size_t)r * DM : args.in[I_MEM] + (size_t)r * DM;
            bf16* db = isx ? XB + (size_t)r * DM : (bf16*)(ws + WS_MEMB) + (size_t)r * DM;
            float* dq = isx ? SSQ + (size_t)r * 8 : (float*)(ws + WS_MEMSSQ) + (size_t)r * 8;
            float s = 0.f; f32x4 v[8];
#pragma unroll
            for (int j = 0; j < 8; ++j) v[j] = *((const GAS f32x4*)src + lane + 64 * j);
#pragma unroll
            for (int j = 0; j < 8; ++j) { s += (v[j][0] * v[j][0] + v[j][1] * v[j][1]) + (v[j][2] * v[j][2] + v[j][3] * v[j][3]);
                *((GAS unsigned long long*)db + lane + 64 * j) = (unsigned long long)pk2(v[j][0], v[j][1]) | ((unsigned long long)pk2(v[j][2], v[j][3]) << 32); }
            s = wave_sum(s);
            if (lane < 8) dq[lane] = (lane == 0) ? s : 0.f;
        }
        for (int o4 = sidx; o4 < DEPTH * 2 * 32; o4 += Gs) { const int n4 = (o4 & 31) * 4, lk = o4 >> 5;
            const float* pos = args.in[I_CPOS] + (size_t)lk * 4096; const float* w = args.in[I_CW1] + (size_t)lk * 4096 * 128 + n4; f32x4 s4 = {0.f, 0.f, 0.f, 0.f};
#pragma unroll
            for (int i = 0; i < 8; ++i) { const int k = wave * 512 + i * 64 + lane; s4 += *(const GAS f32x4*)(w + (size_t)k * 128) * pos[k]; }
            const float s0 = wave_sum(s4[0]), s1 = wave_sum(s4[1]), s2 = wave_sum(s4[2]), s3 = wave_sum(s4[3]);
            LAS float* red = (LAS float*)(lds + EPI_OFF);
            __syncthreads();
            if (lane == 0) { red[wave * 4 + 0] = s0; red[wave * 4 + 1] = s1; red[wave * 4 + 2] = s2; red[wave * 4 + 3] = s3; }
            __syncthreads();
            if (tid < 4) { float t = red[tid];
#pragma unroll
                for (int w8 = 1; w8 < 8; ++w8) t += red[w8 * 4 + tid];
                BIAS1[lk * 128 + n4 + tid] = t; } }
        if (blockIdx.x == 0 && wave >= 1 && wave <= DEPTH) { const int ll = wave - 1; const float* lp = args.in[I_LAM] + ll * 256;
            const float a = wave_sum(lp[lane] * lp[64 + lane]), b2 = wave_sum(lp[128 + lane] * lp[192 + lane]);
            if (lane == 0) LAMV[ll] = expf(a) - expf(b2) + (0.8f - 0.6f * expf(-0.3f * (float)ll)); }
        __syncthreads();
        }
        cvt_pull(args, ws, 0, (gu32*)(ws + WS_CTL) + CW_CVT + 3 * 128, tid, lds + RING_OFF);
        SEAM(0);
    }

    for (int it = 0; it < 3 * DEPTH; ++it) {
        const int l = it / 3, r3 = it - 3 * l; const int sb = 1 + 9 * l + (r3 == 0 ? 0 : (r3 == 1 ? 2 : 7));
        unsigned char* wl = ws + WS_WL + (size_t)l * WL_STRIDE;
        if (r3 != 1) {
            if (SITE(1) && RUN(sb)) {
                pg8::Gemm g{XB, (const bf16*)(wl + (r3 == 0 ? WL_GU1 : WL_GU2)), MROWS, 2 * DFF, DM}; pg8::StaticOrder S; S.init(MROWS, 2 * DFF, G, (int)blockIdx.x);
                pg8::EpiSwiGLU E{Hb, SSQ, DFF, (const LAS float*)(lds + SSQI_OFF)}; pg8::NoHook nh;
                pg8::gemm_phase<pg8::EpiSwiGLU, pg8::StaticOrder, pg8::NoHook, true, true>(lds + RING_OFF, g, S, E, nh, MYTID);
                if (SITE(2) && it == 0) {
                    pg8::Gemm g2{(const bf16*)(ws + WS_MEMB), (const bf16*)(ws + WS_WMKV), MEMROWS, DEPTH * 1024, DM}; pg8::StaticOrder S2; S2.init(MEMROWS, DEPTH * 1024, G, (int)((blockIdx.x + G / 2) % G));
                    pg8::EpiScaleBf16 E2{(bf16*)(ws + WS_MEMKV), DEPTH * 1024, (const float*)(ws + WS_MEMSSQ), (const LAS float*)(lds + SSQI_OFF)};
                    pg8::gemm_phase<pg8::EpiScaleBf16, pg8::StaticOrder, pg8::NoHook, true, true>(lds + RING_OFF, g2, S2, E2, nh, MYTID);
                }
                SEAM(sb);
            }
            if (SITE(3) && RUN(sb + 1)) {
                pg8::Gemm g{Hb, (const bf16*)(wl + (r3 == 0 ? WL_D1 : WL_D2)), MROWS, DM, DFF}; pg8::StaticOrder S; S.init(MROWS, DM, G, (int)blockIdx.x);
                pg8::EpiResid E{XB, SSQ, 0.5f, epi_scr}; pg8::NoHook nh;
                pg8::gemm_phase<pg8::EpiResid, pg8::StaticOrder, pg8::NoHook, true, true>(lds + RING_OFF, g, S, E, nh, MYTID);
                SEAM(sb + 1);
            }
        } else {
            bf16* DQ = (bf16*)(ws + WS_DQ); bf16* DK = (bf16*)(ws + WS_DK); bf16* DV = (bf16*)(ws + WS_DV); bf16* NQ = (bf16*)(ws + WS_NQ);
            bf16* NKV = (bf16*)(ws + WS_NKV); bf16* MQ = (bf16*)(ws + WS_MQ); bf16* MG = (bf16*)(ws + WS_MG); float* NG = (float*)(ws + WS_NG);
            bf16* KCMP = (bf16*)(ws + WS_KCMP); float* HC = (float*)(ws + WS_HC); bf16* ACAT = (bf16*)(ws + WS_ACAT); bf16* MERGED = (bf16*)(ws + WS_MERGED);
            if (SITE(4) && RUN(sb)) {
                pg8::Gemm g{XB, (const bf16*)(wl + WL_IN), MROWS, PROJ_N, DM}; pg8::StaticOrder S; S.init(MROWS, PROJ_N, G, (int)blockIdx.x);
                pg8::EpiProj E{(const LAS float*)(lds + SSQI_OFF), SSQ, DQ, DK, DV, NQ, NKV, MQ, MG, MROWS}; pg8::NoHook nh;
                pg8::gemm_phase<pg8::EpiProj, pg8::StaticOrder, pg8::NoHook, true, true>(lds + RING_OFF, g, S, E, nh, MYTID);
                SEAM(sb);
            }
            if (SITE(5) && RUN(sb + 1)) {
                SITE_IDS SITE_ARGS
                char* alds = (char*)lds_raw + RING_OFF;
                if (G >= 256 && (int)blockIdx.x >= G - 128) { cmpx::cmp_unit(alds, G - 1 - (int)blockIdx.x, NKV, (const bf16*)(wl + WL_C1), (const bf16*)(wl + WL_C2), BIAS1 + l * 256, KCMP, tid); }
                else if (G >= 256) { for (int u = (int)blockIdx.x; u < MROWS / 32; u += G - 128) cmpx::ng_unit(alds, u, XB, (const bf16*)(wl + WL_NG), SSQ, NG, tid);
                                     cmpx::qk_norm_max(alds, DQ, DK, (unsigned*)((gu32*)(ws + WS_CTL) + CW_NRM + l * 512), (int)blockIdx.x, G - 128, tid); }
                else { cmpx::qk_norm_max(alds, DQ, DK, (unsigned*)((gu32*)(ws + WS_CTL) + CW_NRM + l * 512), (int)blockIdx.x, G, tid);
                       for (int u = (int)blockIdx.x; u < MROWS / 32; u += G) cmpx::ng_unit(alds, u, XB, (const bf16*)(wl + WL_NG), SSQ, NG, tid);
                       for (int u = (int)blockIdx.x; u < 128; u += G) cmpx::cmp_unit(alds, u, NKV, (const bf16*)(wl + WL_C1), (const bf16*)(wl + WL_C2), BIAS1 + l * 256, KCMP, tid); }
                SEAM(sb + 1);
            }
#define CVT_PULL() do { SITE_IDS SITE_ARGS cvt_pull(args, ws, l + 1, (gu32*)(ws + WS_CTL) + CW_CVT + l * 128, tid, lds + RING_OFF); } while (0)
            if (SITE(7) && RUN(sb + 2) && l + 1 < DEPTH && (int)(blockIdx.x >> 3) >= (G >> 3) - 5) CVT_PULL();
            if (SITE(7) && RUN(sb + 2)) {
                SITE_IDS SITE_ARGS
                const float lam_init = 0.8f - 0.6f * expf(-0.3f * (float)l);
                { char* alds = (char*)lds_raw + RING_OFF; volatile LAS unsigned* qslot = (volatile LAS unsigned*)(lds + MISC_OFF) + 16; const float lam = LAMV[l]; const float* subln = args.in[I_SUBLN] + l * 128;
                  gu32* qh = (gu32*)(ws + WS_CTL) + CW_Q + (l * 4) * 64;
                  for (;;) {
                      if (tid == 0) qslot[0] = __hip_atomic_fetch_add(qh, 1u, __ATOMIC_RELAXED, __HIP_MEMORY_SCOPE_AGENT);
                      __syncthreads(); const int u = (int)qslot[0]; __syncthreads();
                      if (u >= BATCH * 2 * 64) break;
                      att::nsa_unit(alds, (u >> 1) & 1, u & 1, 63 - (u >> 2), NQ, NKV, KCMP, NG, (float*)(ws + WS_ACC), ACAT, tid); }
                  for (;;) {
                      if (tid == 0) qslot[0] = __hip_atomic_fetch_add(qh + 64, 1u, __ATOMIC_RELAXED, __HIP_MEMORY_SCOPE_AGENT);
                      __syncthreads(); const int u = (int)qslot[0]; __syncthreads();
                      if (u >= BATCH * 8 * 32) break;
                      att::diff_unit(alds, (u >> 3) & 1, u & 7, 31 - (u >> 4), DQ, DK, DV, ACAT, subln, lam, lam_init, (unsigned*)((gu32*)(ws + WS_CTL) + CW_NRM + l * 512), tid); }
                  for (;;) {
                      if (tid == 0) qslot[0] = __hip_atomic_fetch_add(qh + 128, 1u, __ATOMIC_RELAXED, __HIP_MEMORY_SCOPE_AGENT);
                      __syncthreads(); const int u = (int)qslot[0]; __syncthreads();
                      if (u >= BATCH * 4 * 16) break;
                      att::mem_unit(alds, (u >> 2) & 1, u & 3, u >> 3, MQ, (const bf16*)(ws + WS_MEMKV) + (size_t)l * 1024, ACAT, tid); } }
            }
            if (SITE(7) && RUN(sb + 2)) {
                if (l + 1 < DEPTH) CVT_PULL();
                SEAM(sb + 2);
            }
#undef CVT_PULL
            if (SITE(8) && RUN(sb + 3)) {
                pg8::Gemm g{ACAT, (const bf16*)(wl + WL_UP), MROWS, DM, 2560}; pg8::StaticOrder S; S.init(MROWS, DM, G, (int)blockIdx.x);
                pg8::MergeGate mgk{MG}; pg8::EpiMerge E{MERGED, mgk};
                pg8::gemm_phase<pg8::EpiMerge, pg8::StaticOrder, pg8::MergeGate, false, true>(lds + RING_OFF, g, S, E, mgk, MYTID);
                SEAM(sb + 3);
            }
            if (SITE(9) && RUN(sb + 4)) {
                pg8::Gemm g{MERGED, (const bf16*)(wl + WL_O), MROWS, DM, DM}; pg8::StaticOrder S; S.init(MROWS, DM, G, (int)blockIdx.x);
                pg8::EpiResid E{XB, SSQ, 1.0f, epi_scr}; pg8::NoHook nh;
                pg8::gemm_phase<pg8::EpiResid, pg8::StaticOrder, pg8::NoHook, true, true>(lds + RING_OFF, g, S, E, nh, MYTID);
                SEAM(sb + 4);
            }
        }
    }
    if (RUN(N_STEPS - 1)) {
        SITE_IDS SITE_ARGS
        const float* gn = args.in[I_FINN];
        for (int m = gw; m < MROWS; m += NGW) { const GAS unsigned long long* xr = (const GAS unsigned long long*)(XB + (size_t)m * DM) + lane; f32x4 v[8]; float s = 0.f;
#pragma unroll
            for (int j = 0; j < 8; ++j) { const unsigned long long w = xr[64 * j]; const unsigned w0 = (unsigned)w, w1 = (unsigned)(w >> 32); v[j] = (f32x4){blo(w0), bhi(w0), blo(w1), bhi(w1)};
                s += (v[j][0] * v[j][0] + v[j][1] * v[j][1]) + (v[j][2] * v[j][2] + v[j][3] * v[j][3]); }
            const float rs = 1.0f / sqrtf(wave_sum(s) * (1.0f / DM) + NORM_EPS);
#pragma unroll
            for (int j = 0; j < 8; ++j) { const f32x4 gv = *((const f32x4*)gn + lane + 64 * j); *((f32x4*)(args.out + (size_t)m * DM) + lane + 64 * j) = v[j] * rs * gv; } }
    }
#undef RUN
#undef SEAM
#undef SITE_IDS
#undef SITE_ARGS
#undef MYTID
}

#ifndef MK_PER_STEP
#define MK_PER_STEP 0
#endif
extern "C" void kernel_launch(void* const* d_in, const int* in_sizes, int n_in, void* d_out, int out_size, void* d_ws, size_t ws_size, hipStream_t stream) {
    static int grid = 0;
    if (grid == 0) {
        if (n_in != N_IN || in_sizes[0] != MROWS * DM || out_size != MROWS * DM || ws_size < WS_END) {
            fprintf(stderr, "kernel_launch: shape/workspace mismatch: n_in %d in0 %d out %d ws %zu (need %zu)\n", n_in, n_in > 0 ? in_sizes[0] : -1, out_size, ws_size, (size_t)WS_END); grid = -1; return; }
        int dev = 0, cus = 0, per_cu = 0;
        if (hipGetDevice(&dev) != hipSuccess || hipDeviceGetAttribute(&cus, hipDeviceAttributeMultiprocessorCount, dev) != hipSuccess) { grid = -1; return; }
        if (hipFuncSetAttribute((const void*)trunk_fwd, hipFuncAttributeMaxDynamicSharedMemorySize, LDS_BYTES) != hipSuccess) { fprintf(stderr, "kernel_launch: hipFuncSetAttribute failed\n"); grid = -1; return; }
        if (hipOccupancyMaxActiveBlocksPerMultiprocessor(&per_cu, (const void*)trunk_fwd, NTHREADS, LDS_BYTES) != hipSuccess || per_cu < 1)
            fprintf(stderr, "kernel_launch: note: occupancy query reports %d workgroups per CU\n", per_cu);
        (void)hipGetLastError();
        grid = cus;
    }
    if (grid < 0) return;
    if (hipMemsetAsync((char*)d_ws + WS_CTL, 0, CTL_ZERO_BYTES, stream) != hipSuccess) return;
    Args a{};
    for (int i = 0; i < N_IN; ++i) a.in[i] = (const float*)d_in[i];
    a.out = (float*)d_out; a.ws = (unsigned char*)d_ws;
#if MK_PER_STEP
    for (int s = 0; s < N_STEPS; ++s) { a.step_lo = s; a.step_hi = s + 1; hipLaunchKernelGGL(trunk_fwd, dim3(grid), dim3(NTHREADS), LDS_BYTES, stream, a); }
#else
    a.step_lo = 0; a.step_hi = N_STEPS; hipLaunchKernelGGL(trunk_fwd, dim3(grid), dim3(NTHREADS), LDS_BYTES, stream, a);
#endif
    const hipError_t le = hipPeekAtLastError();
    if (le != hipSuccess) fprintf(stderr, "kernel_launch: launch failed: %s\n", hipGetErrorName(le));
}
```

```cpp
#include <hip/hip_runtime.h>
#include <cstdio>
#include <cstdint>

__device__ __forceinline__ int lane_id_fresh() { int l; asm volatile("v_mbcnt_lo_u32_b32 %0, -1, 0\n\tv_mbcnt_hi_u32_b32 %0, -1, %0" : "=v"(l)); return l; }
namespace pg8 {
#define PG8_LAS __attribute__((address_space(3)))
#ifndef GAS
#define GAS __attribute__((address_space(1)))
#endif
typedef unsigned short bf16_t;
typedef short bf16x8 __attribute__((ext_vector_type(8)));
typedef float f32x4 __attribute__((ext_vector_type(4)));
typedef unsigned u32x4 __attribute__((ext_vector_type(4)));
typedef unsigned u32x2 __attribute__((ext_vector_type(2)));
constexpr int BM = 256, BK = 64, HALF = 128, HTB = HALF * BK * 2  , STAGE_BYTES = 8 * HTB, NXCD = 8, WGM = 4;

__host__ __device__ __forceinline__ int lds_byte(int r, int c) { const int st = (r >> 4) * 2 + (c >> 5), rr = r & 15, cc = c & 31, ob = rr * 64 + cc * 2; return st * 1024 + (ob ^ (((ob >> 9) & 1) << 5)); }
__host__ __device__ __forceinline__ void stage_rc(int b, int& R, int& C) { const int st = b / 1024, sb = b % 1024, swz = sb ^ (((sb >> 9) & 1) << 5); R = (st >> 1) * 16 + swz / 64; C = (st & 1) * 32 + (swz % 64) / 2; }
__host__ __device__ __forceinline__ int perm32(int rho) { const int n = rho >> 4, i = rho & 15; return 8 * (i >> 2) + 4 * n + (i & 3); }

struct Unit { int pm, pn; };
struct Gemm { const bf16_t* A; const bf16_t* Bt; int M, N, K; };

struct StaticOrder {
    int nM, nN, nwg, G, c;
    __host__ __device__ void init(int M, int N, int G_, int c_) { nM = M / BM; nN = N / BM; nwg = nM * nN; G = G_; c = c_; }
    __host__ __device__ bool next(int i, Unit& u) const {
        const long L = (long)i * G + c; if (L >= nwg) return false;
        int wgid = (int)L; { const int q = nwg / NXCD, r = nwg % NXCD, xcd = wgid % NXCD, off = wgid / NXCD; wgid = (xcd < r ? xcd * (q + 1) : r * (q + 1) + (xcd - r) * q) + off; }
        const int nig = WGM * nN, gid = wgid / nig, fm = gid * WGM, gsz = (nM - fm) < WGM ? (nM - fm) : WGM;
        u.pm = fm + ((wgid % nig) % gsz); u.pn = (wgid % nig) / gsz; return true;
    }
    __device__ __forceinline__ void a_ready(const Unit&) const {}
    __device__ __forceinline__ void done(const Unit&) const {}
};

typedef float f32x2_cv __attribute__((ext_vector_type(2))); typedef __bf16 bf16x2_cv __attribute__((ext_vector_type(2)));
__device__ __forceinline__ unsigned cvt_pk_bf16(float lo, float hi) { const f32x2_cv v = {lo, hi}; const bf16x2_cv b = __builtin_convertvector(v, bf16x2_cv); return __builtin_bit_cast(unsigned, b); }
__device__ __forceinline__ float bflo(unsigned w) { return __uint_as_float(w << 16); }
__device__ __forceinline__ float bfhi(unsigned w) { return __uint_as_float(w & 0xffff0000u); }
struct NoHook { static constexpr bool ON = false; static constexpr int T1 = -1, T2 = -1;
    __device__ __forceinline__ void apply(f32x4 (&)[2][2][4][2], const Unit&, int, int, int, int, int) const {} };

__device__ __forceinline__ float row_rstd(const float* ssq, int row) {
    const f32x4 a = *(const f32x4*)(ssq + (size_t)row * 8), b = *(const f32x4*)(ssq + (size_t)row * 8 + 4);
    const float s = ((a[0] + a[1]) + (a[2] + a[3])) + ((b[0] + b[1]) + (b[2] + b[3]));
    return __builtin_amdgcn_rsqf(s * (1.0f / 2048.0f) + 1e-6f);
}
__device__ __forceinline__ float row_rstd_lds(const PG8_LAS float* img, int rl) {
    const f32x4 a = *(const PG8_LAS f32x4*)(img + rl * 8), b = *(const PG8_LAS f32x4*)(img + rl * 8 + 4);
    const float s = ((a[0] + a[1]) + (a[2] + a[3])) + ((b[0] + b[1]) + (b[2] + b[3]));
    return __builtin_amdgcn_rsqf(s * (1.0f / 2048.0f) + 1e-6f);
}
__device__ __forceinline__ float fast_sigmoid(float v) { return __builtin_amdgcn_rcpf(1.0f + __builtin_amdgcn_exp2f(-1.4426950408889634f * v)); }

struct EpiSwiGLU { static constexpr bool PERM = true, AFTER_DRAIN = false, NEED_SSQ = true;
    bf16_t* H; const float* ssq; int ldh; const PG8_LAS float* img;
    __device__ __forceinline__ void operator()(const f32x4 (&acc)[2][2][4][2], const Unit& u, int wr, int wc, int fr, int fq, int, int) const {
        const int row0 = u.pm * BM + wr * 64 + fr, col0 = u.pn * 128 + wc * 32 + 8 * fq;
#pragma unroll
        for (int ai = 0; ai < 2; ++ai)
#pragma unroll
            for (int m = 0; m < 4; ++m) { const int row = row0 + ai * HALF + m * 16; const float rs = row_rstd_lds(img, wr * 64 + fr + ai * HALF + m * 16);
                const float kk = rs * -1.4426950408889634f, rs2 = rs * rs;
                float hv[8];
#pragma unroll
                for (int n = 0; n < 2; ++n)
#pragma unroll
                    for (int e = 0; e < 4; ++e) { const float G_ = acc[ai][0][m][n][e], U_ = acc[ai][1][m][n][e]; const float t_ = G_ * kk, gu_ = G_ * U_;
                        const float r_ = __builtin_amdgcn_rcpf(1.0f + __builtin_amdgcn_exp2f(t_)); hv[n * 4 + e] = gu_ * (r_ * rs2); }
                u32x4 w; w.x = cvt_pk_bf16(hv[0], hv[1]); w.y = cvt_pk_bf16(hv[2], hv[3]); w.z = cvt_pk_bf16(hv[4], hv[5]); w.w = cvt_pk_bf16(hv[6], hv[7]);
                *(u32x4*)(H + (size_t)row * ldh + col0) = w; }
    }
};
struct EpiResid { static constexpr bool PERM = true, AFTER_DRAIN = false, NEED_SSQ = false;
    bf16_t* XB; float* ssq; float scale; PG8_LAS float* scr;
    __device__ __forceinline__ void operator()(const f32x4 (&acc)[2][2][4][2], const Unit& u, int wr, int wc, int fr_in, int fq_in, int wid, int lane_in) const {
        const int lane = lane_id_fresh(), fr = lane & 15, fq = lane >> 4; (void)fr_in; (void)fq_in; (void)lane_in;
        const int col0 = u.pn * BM + wc * 32 + 8 * fq;
#pragma unroll
        for (int ai = 0; ai < 2; ++ai) {
            size_t off0 = (size_t)(u.pm * BM + ai * HALF + wr * 64 + fr) * 2048 + col0; asm volatile("" : "+v"(off0));
            GAS bf16_t* bp = (GAS bf16_t*)XB + off0;
            u32x4 xo[4][2];
#pragma unroll
            for (int m = 0; m < 4; ++m)
#pragma unroll
                for (int bj = 0; bj < 2; ++bj) xo[m][bj] = *(const GAS u32x4*)(bp + (size_t)(m * 16) * 2048 + bj * HALF);
            asm volatile("" ::: "memory");
#pragma unroll
            for (int m = 0; m < 4; ++m) { float q = 0.f;
#pragma unroll
                for (int bj = 0; bj < 2; ++bj) { const u32x4 xi = xo[m][bj];
                    const f32x4 i0 = {bflo(xi.x), bfhi(xi.x), bflo(xi.y), bfhi(xi.y)}, i1 = {bflo(xi.z), bfhi(xi.z), bflo(xi.w), bfhi(xi.w)};
                    const f32x4 x0 = i0 + acc[ai][bj][m][0] * scale, x1 = i1 + acc[ai][bj][m][1] * scale;
                    u32x4 w; w.x = cvt_pk_bf16(x0[0], x0[1]); w.y = cvt_pk_bf16(x0[2], x0[3]); w.z = cvt_pk_bf16(x1[0], x1[1]); w.w = cvt_pk_bf16(x1[2], x1[3]); *(GAS u32x4*)(bp + (size_t)(m * 16) * 2048 + bj * HALF) = w;
                    q += ((x0[0] * x0[0] + x0[1] * x0[1]) + (x0[2] * x0[2] + x0[3] * x0[3])) + ((x1[0] * x1[0] + x1[1] * x1[1]) + (x1[2] * x1[2] + x1[3] * x1[3])); }
                q += __shfl_xor(q, 16); q += __shfl_xor(q, 32);
                if (fq == 0) scr[(ai * HALF + wr * 64 + m * 16 + fr) * 4 + wc] = q; }
            asm volatile("" ::: "memory"); }
        asm volatile("s_waitcnt lgkmcnt(0)\n\ts_barrier" ::: "memory");
        const int tid = wid * 64 + lane;
        if (tid < 256) { const float s = (scr[tid * 4 + 0] + scr[tid * 4 + 1]) + (scr[tid * 4 + 2] + scr[tid * 4 + 3]); ssq[(size_t)(u.pm * BM + tid) * 8 + u.pn] = s; }
        asm volatile("s_waitcnt lgkmcnt(0)" ::: "memory");
    }
};
struct EpiScaleBf16 { static constexpr bool PERM = true, AFTER_DRAIN = false, NEED_SSQ = true;
    bf16_t* O; int ldc; const float* ssq; const PG8_LAS float* img;
    __device__ __forceinline__ void operator()(const f32x4 (&acc)[2][2][4][2], const Unit& u, int wr, int wc, int fr, int fq, int, int) const {
        const int row0 = u.pm * BM + wr * 64 + fr, col0 = u.pn * BM + wc * 32 + 8 * fq;
#pragma unroll
        for (int ai = 0; ai < 2; ++ai)
#pragma unroll
            for (int m = 0; m < 4; ++m) { const int row = row0 + ai * HALF + m * 16; const float rs = row_rstd_lds(img, wr * 64 + fr + ai * HALF + m * 16);
#pragma unroll
                for (int bj = 0; bj < 2; ++bj) { const f32x4 v0 = acc[ai][bj][m][0] * rs, v1 = acc[ai][bj][m][1] * rs;
                    u32x4 w; w.x = cvt_pk_bf16(v0[0], v0[1]); w.y = cvt_pk_bf16(v0[2], v0[3]); w.z = cvt_pk_bf16(v1[0], v1[1]); w.w = cvt_pk_bf16(v1[2], v1[3]);
                    *(u32x4*)(O + (size_t)row * ldc + col0 + bj * HALF) = w; } }
    }
};
__device__ __forceinline__ size_t mg_off(int s_, int pm, int pn, int wid, int ai) { return ((((size_t)(s_ * 32 + pm) * 8 + pn) * 8 + wid) * 2 + ai) * 4096; }
constexpr size_t MG_SET = (size_t)8192 * 2048;
struct EpiProj { static constexpr bool PERM = true, AFTER_DRAIN = false, NEED_SSQ = true;
    const PG8_LAS float* img; const float* ssq; bf16_t *DQ, *DK, *DV, *NQ, *NKV, *MQ, *MG; int Mrows;
    __device__ __forceinline__ void operator()(const f32x4 (&acc)[2][2][4][2], const Unit& u, int wr, int wc, int fr, int fq, int, int) const {
        const int pn = u.pn; bf16_t* base; int ldc, c0; size_t bjs = HALF;
        float qs = 1.0f;
        if (pn < 4) { base = DQ; ldc = 1024; c0 = 256 * pn; qs = 0.125f * 1.4426950408889634f; }
        else if (pn < 8) { base = DK; ldc = 1024; c0 = 256 * (pn - 4); }
        else if (pn < 12) { base = DV; ldc = 1024; c0 = 256 * (pn - 8); }
        else if (pn < 16) { base = NQ; ldc = 1024; c0 = 256 * (pn - 12); qs = 0.08838834764831845f * 1.4426950408889634f; }
        else if (pn < 22) { base = NKV + (size_t)(2 * (pn - 16)) * Mrows * 128; ldc = 128; c0 = 0; bjs = (size_t)Mrows * 128; }
        else if (pn < 24) { base = MQ; ldc = 512; c0 = 256 * (pn - 22); qs = 0.08838834764831845f * 1.4426950408889634f; }
        else { base = MG; ldc = 6144; c0 = 256 * (pn - 24); }
        const bool gate_tile = pn >= 24;
        const int row0 = u.pm * BM + wr * 64 + fr, col0 = c0 + wc * 32 + 8 * fq;
        if (gate_tile) {
#pragma unroll
            for (int ai = 0; ai < 2; ++ai)
#pragma unroll
                for (int m = 0; m < 4; ++m) { const int row = row0 + ai * HALF + m * 16; const float rs = row_rstd_lds(img, wr * 64 + fr + ai * HALF + m * 16) * -1.4426950408889634f;
#pragma unroll
                    for (int bj = 0; bj < 2; ++bj) { f32x4 v0 = acc[ai][bj][m][0] * rs, v1 = acc[ai][bj][m][1] * rs;
#pragma unroll
                        for (int e = 0; e < 4; ++e) { v0[e] = 1.0f + __builtin_amdgcn_exp2f(fminf(v0[e], 43.28085123f)); v1[e] = 1.0f + __builtin_amdgcn_exp2f(fminf(v1[e], 43.28085123f)); }
                        u32x4 w; w.x = cvt_pk_bf16(v0[0], v0[1]); w.y = cvt_pk_bf16(v0[2], v0[3]); w.z = cvt_pk_bf16(v1[0], v1[1]); w.w = cvt_pk_bf16(v1[2], v1[3]);
                        *(u32x4*)(MG + mg_off((pn - 24) >> 3, u.pm, (pn - 24) & 7, wr * 4 + wc, ai) + (m * 2 + bj) * 512 + (fr + 16 * fq) * 8) = w; } }
        } else {
#pragma unroll
            for (int ai = 0; ai < 2; ++ai)
#pragma unroll
                for (int m = 0; m < 4; ++m) { const int row = row0 + ai * HALF + m * 16; const float rs = row_rstd_lds(img, wr * 64 + fr + ai * HALF + m * 16) * qs;
#pragma unroll
                    for (int bj = 0; bj < 2; ++bj) { const f32x4 v0 = acc[ai][bj][m][0] * rs, v1 = acc[ai][bj][m][1] * rs;
                        u32x4 w; w.x = cvt_pk_bf16(v0[0], v0[1]); w.y = cvt_pk_bf16(v0[2], v0[3]); w.z = cvt_pk_bf16(v1[0], v1[1]); w.w = cvt_pk_bf16(v1[2], v1[3]);
                        *(u32x4*)(base + bj * bjs + (size_t)row * ldc + col0) = w; } }
        }
    }
};
struct MergeGate { static constexpr bool ON = true; static constexpr int T1 = 16, T2 = 32;
    const bf16_t* MG;
    __device__ __forceinline__ void apply(f32x4 (&acc)[2][2][4][2], const Unit& u, int wr, int wc, int fr_in, int fq_in, int which) const {
        const int lane = lane_id_fresh(), fr = lane & 15, fq = lane >> 4; (void)fr_in; (void)fq_in;
        const GAS bf16_t* gbase = (const GAS bf16_t*)MG + mg_off(which, u.pm, u.pn, wr * 4 + wc, 0) + lane * 8;
#pragma unroll
        for (int ai = 0; ai < 2; ++ai) { u32x4 wa[4][2], wb[4][2];
            const GAS bf16_t* gp = gbase + (size_t)ai * 4096; asm volatile("" : "+v"(gp));
#pragma unroll
            for (int m = 0; m < 4; ++m)
#pragma unroll
                for (int bj = 0; bj < 2; ++bj) { wa[m][bj] = *(const GAS u32x4*)(gp + (m * 2 + bj) * 512);
                    if (which < 2) wb[m][bj] = *(const GAS u32x4*)(gp + MG_SET + (m * 2 + bj) * 512); }
#pragma unroll
            for (int m = 0; m < 4; ++m)
#pragma unroll
                for (int bj = 0; bj < 2; ++bj) { float f[8];
#pragma unroll
                    for (int e = 0; e < 4; ++e) { f[2 * e] = __builtin_amdgcn_rcpf(bflo(wa[m][bj][e])); f[2 * e + 1] = __builtin_amdgcn_rcpf(bfhi(wa[m][bj][e])); }
                    if (which < 2) {
#pragma unroll
                        for (int e = 0; e < 4; ++e) { f[2 * e] *= bflo(wb[m][bj][e]); f[2 * e + 1] *= bfhi(wb[m][bj][e]); } }
#pragma unroll
                    for (int e = 0; e < 4; ++e) { acc[ai][bj][m][0][e] *= f[e]; acc[ai][bj][m][1][e] *= f[4 + e]; } }
            asm volatile("" ::: "memory"); }
    }
};
struct EpiMerge { static constexpr bool PERM = true, AFTER_DRAIN = false, NEED_SSQ = false;
    bf16_t* O; MergeGate G;
    __device__ __forceinline__ void operator()(const f32x4 (&acc_in)[2][2][4][2], const Unit& u, int wr, int wc, int fr_in, int fq_in, int, int) const {
        const int lane = lane_id_fresh(), fr = lane & 15, fq = lane >> 4; (void)fr_in; (void)fq_in;
        const int row0 = u.pm * BM + wr * 64 + fr, col0 = u.pn * BM + wc * 32 + 8 * fq;
#pragma unroll
        for (int ai = 0; ai < 2; ++ai) { u32x4 wa[4][2];
            const GAS bf16_t* gp = (const GAS bf16_t*)G.MG + mg_off(2, u.pm, u.pn, wr * 4 + wc, ai) + lane * 8; asm volatile("" : "+v"(gp));
#pragma unroll
            for (int m = 0; m < 4; ++m)
#pragma unroll
                for (int bj = 0; bj < 2; ++bj) wa[m][bj] = *(const GAS u32x4*)(gp + (m * 2 + bj) * 512);
#pragma unroll
            for (int m = 0; m < 4; ++m) { const int row = row0 + ai * HALF + m * 16;
#pragma unroll
                for (int bj = 0; bj < 2; ++bj) { float g[8];
#pragma unroll
                    for (int e = 0; e < 4; ++e) { g[2 * e] = __builtin_amdgcn_rcpf(bflo(wa[m][bj][e])); g[2 * e + 1] = __builtin_amdgcn_rcpf(bfhi(wa[m][bj][e])); }
                    const f32x4 a0 = acc_in[ai][bj][m][0], a1 = acc_in[ai][bj][m][1];
                    u32x4 w; w.x = cvt_pk_bf16(a0[0] * g[0], a0[1] * g[1]); w.y = cvt_pk_bf16(a0[2] * g[2], a0[3] * g[3]); w.z = cvt_pk_bf16(a1[0] * g[4], a1[1] * g[5]); w.w = cvt_pk_bf16(a1[2] * g[6], a1[3] * g[7]);
                    *(GAS u32x4*)((GAS bf16_t*)O + (size_t)row * 2048 + col0 + bj * HALF) = w; } }
            asm volatile("" ::: "memory"); }
    }
};

template <class Epi, class Sched, class Hook, bool ALIGN_EPI = false, bool SP2 = false>
__device__ __forceinline__ void gemm_phase(PG8_LAS unsigned char* lds, const Gemm g, const Sched& S, const Epi& E, const Hook& Hk, int tid_in) {
    int tid_ = tid_in; asm volatile("" : "+v"(tid_));
    const int tid = tid_, wid = __builtin_amdgcn_readfirstlane(tid >> 6), lane = tid & 63, wr = wid >> 2, wc = wid & 3, fr = lane & 15, fq = lane >> 4;
    const int K = g.K, nt = K / BK;
    unsigned voffA[2], voffB[2];
#pragma unroll
    for (int i = 0; i < 2; ++i) { int R, C; stage_rc(tid * 16 + i * 8192, R, C); const int Rb = Epi::PERM ? ((R & ~31) + perm32(R & 31)) : R;
        voffA[i] = (unsigned)(R * K + C) * 2u; voffB[i] = (unsigned)(Rb * BK + C) * 2u; }
    const size_t kstep = (size_t)(BK * 2), kstepB = (size_t)BM * BK * 2;
    const size_t hstep = (size_t)HALF * K * 2, hstepB = (size_t)HALF * BK * 2;
    const size_t tstep = 2 * hstep, tstepB = (size_t)BM * K * 2;
    const unsigned ldsw = (unsigned)wid * 1024u;
    const int aoff = lds_byte(wr * 64 + fr, fq * 8), boff = lds_byte(wc * 32 + fr, fq * 8);
#define PG8_SA(b, h) (((b) * 2 + (h)) * HTB)
#define PG8_SB(b, h) ((4 + (b) * 2 + (h)) * HTB)
#define PG8_STAGE(bufoff, gbase, voff) do { _Pragma("unroll") for (int _i = 0; _i < 2; ++_i) \
        __builtin_amdgcn_global_load_lds((const unsigned*)((const char*)(gbase) + (voff)[_i]), (PG8_LAS unsigned*)(lds + (bufoff) + ldsw + _i * 8192), 16, 0, 0); } while (0)
#define PG8_LDA(dst, b, h) do { _Pragma("unroll") for (int m = 0; m < 4; ++m) _Pragma("unroll") for (int k = 0; k < 2; ++k) dst[m][k] = *(const PG8_LAS bf16x8*)(lds + PG8_SA(b, h) + aoff + m * 2048 + k * 1024); } while (0)
#define PG8_LDB(dst, b, h) do { _Pragma("unroll") for (int n = 0; n < 2; ++n) _Pragma("unroll") for (int k = 0; k < 2; ++k) dst[n][k] = *(const PG8_LAS bf16x8*)(lds + PG8_SB(b, h) + boff + n * 2048 + k * 1024); } while (0)
#define PG8_MMA(ai, bj, At, Bt) do { __builtin_amdgcn_s_setprio(1); _Pragma("unroll") for (int m = 0; m < 4; ++m) _Pragma("unroll") for (int n = 0; n < 2; ++n) _Pragma("unroll") for (int k = 0; k < 2; ++k) \
        acc[ai][bj][m][n] = __builtin_amdgcn_mfma_f32_16x16x32_bf16(Bt[n][k], At[m][k], acc[ai][bj][m][n], 0, 0, 0); __builtin_amdgcn_s_setprio(0); } while (0)
#define PG8_WAIT_V(n) asm volatile("s_waitcnt vmcnt(" #n ")" ::: "memory")
#define PG8_WAIT_L(n) asm volatile("s_waitcnt lgkmcnt(" #n ")" ::: "memory")
#define PG8_BAR __builtin_amdgcn_s_barrier()
#define PG8_SCHED __builtin_amdgcn_sched_barrier(0)
    Unit cur, nxt; int ui = 0;
    if (!S.next(0, cur)) return;
    f32x4 acc[2][2][4][2];
#pragma unroll
    for (int a = 0; a < 2; ++a)
#pragma unroll
        for (int b = 0; b < 2; ++b)
#pragma unroll
            for (int m = 0; m < 4; ++m)
#pragma unroll
                for (int n = 0; n < 2; ++n) acc[a][b][m][n] = (f32x4){0.f, 0.f, 0.f, 0.f};
    bf16x8 At[4][2], B0[2][2], B1[2][2];
    const char* cA = (const char*)g.A + (size_t)cur.pm * tstep; const char* cB = (const char*)g.Bt + (size_t)cur.pn * tstepB;
    S.a_ready(cur);
    if constexpr (SP2) {
        PG8_STAGE(PG8_SB(0, 0), cB, voffB); PG8_STAGE(PG8_SB(0, 1), cB + hstepB, voffB); PG8_STAGE(PG8_SA(0, 0), cA, voffA); PG8_STAGE(PG8_SA(0, 1), cA + hstep, voffA);
        if (wr == 1) PG8_BAR;
        PG8_WAIT_V(2); PG8_BAR;
        PG8_STAGE(PG8_SB(1, 0), cB + kstepB, voffB); PG8_STAGE(PG8_SA(1, 0), cA + kstep, voffA); PG8_STAGE(PG8_SB(1, 1), cB + hstepB + kstepB, voffB);
        PG8_WAIT_V(6); PG8_BAR;
    } else {
        PG8_STAGE(PG8_SB(0, 0), cB, voffB); PG8_STAGE(PG8_SA(0, 0), cA, voffA); PG8_STAGE(PG8_SB(0, 1), cB + hstepB, voffB); PG8_STAGE(PG8_SA(0, 1), cA + hstep, voffA);
        if (wr == 1) PG8_BAR;
        PG8_WAIT_V(4); PG8_BAR;
        PG8_STAGE(PG8_SB(1, 0), cB + kstepB, voffB); PG8_STAGE(PG8_SA(1, 0), cA + kstep, voffA); PG8_STAGE(PG8_SB(1, 1), cB + hstepB + kstepB, voffB);
        PG8_WAIT_V(6); PG8_BAR;
    }
    for (;;) {
        const bool has_next = S.next(ui + 1, nxt);
        const char* nA = has_next ? (const char*)g.A + (size_t)nxt.pm * tstep : cA; const char* nB = has_next ? (const char*)g.Bt + (size_t)nxt.pn * tstepB : cB;
#pragma unroll
        for (int seg = 0; seg < (Hook::ON ? 3 : 1); ++seg) {
        const int tb = Hook::ON ? (seg == 0 ? 0 : (seg == 1 ? Hook::T1 : Hook::T2)) : 0, te = Hook::ON ? (seg == 0 ? Hook::T1 : (seg == 1 ? Hook::T2 : nt)) : nt;
        if constexpr (Hook::ON) { if (seg > 0) Hk.apply(acc, cur, wr, wc, fr, fq, seg - 1); }
        for (int t = tb; t < te; t += 2) {
            const bool last = (t == nt - 2);
            const char* a1 = cA + (size_t)(t + 1) * kstep;
            const char* a2 = last ? nA : cA + (size_t)(t + 2) * kstep; const char* b2 = last ? nB : cB + (size_t)(t + 2) * kstepB;
            const char* a3 = a2 + kstep; const char* b3 = b2 + kstepB;
            if (last && has_next) S.a_ready(nxt);
            if constexpr (Epi::NEED_SSQ) { if (last) {
                __builtin_amdgcn_global_load_lds((const unsigned*)(E.ssq + ((size_t)cur.pm * BM + wid * 32 + (lane >> 1)) * 8 + (lane & 1) * 4), (PG8_LAS unsigned*)((PG8_LAS unsigned char*)E.img + wid * 1024), 16, 0, 0); } }
            if constexpr (SP2) {
            PG8_LDB(B0, 0, 0); PG8_LDB(B1, 0, 1); PG8_SCHED; PG8_LDA(At, 0, 0); PG8_STAGE(PG8_SA(1, 1), a1 + hstep, voffA);
            PG8_WAIT_V(8); PG8_WAIT_L(0); PG8_BAR; PG8_MMA(0, 0, At, B0); PG8_MMA(0, 1, At, B1); PG8_BAR; PG8_SCHED;
            PG8_LDA(At, 0, 1); PG8_STAGE(PG8_SB(0, 0), b2, voffB); PG8_STAGE(PG8_SB(0, 1), b2 + hstepB, voffB); PG8_STAGE(PG8_SA(0, 0), a2, voffA);
            PG8_WAIT_V(8); PG8_WAIT_L(0); PG8_BAR; PG8_MMA(1, 0, At, B0); PG8_MMA(1, 1, At, B1); PG8_BAR; PG8_SCHED;
            PG8_LDB(B0, 1, 0); PG8_LDB(B1, 1, 1); PG8_SCHED; PG8_LDA(At, 1, 0); PG8_STAGE(PG8_SA(0, 1), a2 + hstep, voffA);
            PG8_WAIT_V(8); PG8_WAIT_L(0); PG8_BAR; PG8_MMA(0, 0, At, B0); PG8_MMA(0, 1, At, B1); PG8_BAR; PG8_SCHED;
            PG8_LDA(At, 1, 1); PG8_STAGE(PG8_SB(1, 0), b3, voffB); PG8_STAGE(PG8_SB(1, 1), b3 + hstepB, voffB); PG8_STAGE(PG8_SA(1, 0), a3, voffA);
            PG8_WAIT_V(8); PG8_WAIT_L(0); PG8_BAR; PG8_MMA(1, 0, At, B0); PG8_MMA(1, 1, At, B1); PG8_BAR; PG8_SCHED;
            } else {
            PG8_LDB(B0, 0, 0); PG8_SCHED; PG8_LDA(At, 0, 0); PG8_STAGE(PG8_SA(1, 1), a1 + hstep, voffA);
            PG8_WAIT_L(8); PG8_BAR; PG8_WAIT_L(0); PG8_MMA(0, 0, At, B0); PG8_BAR; PG8_SCHED;
            PG8_LDB(B1, 0, 1); PG8_STAGE(PG8_SB(0, 0), b2, voffB);
            PG8_BAR; PG8_WAIT_L(0); PG8_MMA(0, 1, At, B1); PG8_BAR;
            PG8_LDA(At, 0, 1); PG8_STAGE(PG8_SA(0, 0), a2, voffA);
            PG8_BAR; PG8_WAIT_L(0); PG8_MMA(1, 0, At, B0); PG8_BAR; PG8_SCHED;
            PG8_STAGE(PG8_SB(0, 1), b2 + hstepB, voffB);
            PG8_WAIT_V(6); PG8_BAR; PG8_MMA(1, 1, At, B1); PG8_BAR;
            PG8_LDB(B0, 1, 0); PG8_SCHED; PG8_LDA(At, 1, 0); PG8_STAGE(PG8_SA(0, 1), a2 + hstep, voffA);
            PG8_WAIT_L(8); PG8_BAR; PG8_WAIT_L(0); PG8_MMA(0, 0, At, B0); PG8_BAR; PG8_SCHED;
            PG8_LDB(B1, 1, 1); PG8_STAGE(PG8_SB(1, 0), b3, voffB);
            PG8_BAR; PG8_WAIT_L(0); PG8_MMA(0, 1, At, B1); PG8_BAR;
            PG8_LDA(At, 1, 1); PG8_STAGE(PG8_SA(1, 0), a3, voffA);
            PG8_BAR; PG8_WAIT_L(0); PG8_MMA(1, 0, At, B0); PG8_BAR; PG8_SCHED;
            PG8_STAGE(PG8_SB(1, 1), b3 + hstepB, voffB);
            PG8_WAIT_V(6); PG8_BAR; PG8_MMA(1, 1, At, B1); PG8_BAR;
            }
        }
        }
        if constexpr (ALIGN_EPI) { if (wr == 0) PG8_BAR; }
        if constexpr (!Epi::AFTER_DRAIN) { E(acc, cur, wr, wc, fr, fq, wid, lane); S.done(cur); }
        if (!has_next) break;
#pragma unroll
        for (int a = 0; a < 2; ++a)
#pragma unroll
            for (int b = 0; b < 2; ++b)
#pragma unroll
                for (int m = 0; m < 4; ++m)
#pragma unroll
                    for (int n = 0; n < 2; ++n) acc[a][b][m][n] = (f32x4){0.f, 0.f, 0.f, 0.f};
        cur = nxt; cA = nA; cB = nB; ++ui;
        if constexpr (ALIGN_EPI) { if (wr == 1) PG8_BAR; }
    }
    PG8_WAIT_V(0);
    if constexpr (!ALIGN_EPI) { if (wr == 0) PG8_BAR; }
    PG8_BAR;
    if constexpr (Epi::AFTER_DRAIN) { E.fused(acc, cur, wr, wc, fr, fq, lds, wid, lane); S.done(cur); }
#undef PG8_SA
#undef PG8_SB
#undef PG8_STAGE
#undef PG8_LDA
#undef PG8_LDB
#undef PG8_MMA
#undef PG8_WAIT_V
#undef PG8_WAIT_L
#undef PG8_BAR
#undef PG8_SCHED
}
}

constexpr int NWAVES = 8, NTHREADS = 512;
constexpr int BATCH = 2, SEQ = 4096, DM = 2048, DFF = 5632, DEPTH = 4, MROWS = BATCH * SEQ;
constexpr int MEM_LEN = 256, MEMROWS = BATCH * MEM_LEN;
constexpr int IN_COLS = 12312, PROJ_N = 12288, NG_COL0 = 5632;
constexpr int NCMP = 255;
constexpr float NORM_EPS = 1e-6f;
enum { I_X = 0, I_MEM, I_F1N, I_F1G, I_F1U, I_F1D, I_MIXN, I_WIN, I_LAM, I_SUBLN, I_CPOS, I_CW1, I_CW2, I_MEMN, I_WMKV, I_WUD, I_WUN, I_WUM, I_WO, I_F2N, I_F2G, I_F2U, I_F2D, I_FINN, N_IN };

constexpr size_t MiB = 1u << 20;
constexpr size_t WS_CTL = 0, CTL_ZERO_BYTES = 64 * 1024;
constexpr size_t WS_WL = 2 * MiB, WL_STRIDE = 202 * MiB;
constexpr size_t WL_GU1 = 0, WL_D1 = 44 * MiB, WL_IN = 66 * MiB, WL_NG = 114 * MiB, WL_C1 = 115 * MiB, WL_C2 = 117 * MiB, WL_UP = 118 * MiB, WL_O = 128 * MiB, WL_GU2 = 136 * MiB, WL_D2 = 180 * MiB;
constexpr size_t WS_WMKV = WS_WL + DEPTH * WL_STRIDE;
constexpr size_t WS_X = WS_WMKV + 16 * MiB;
constexpr size_t WS_XB = WS_X + 64 * MiB;
constexpr size_t WS_SSQ = WS_XB + 32 * MiB;
constexpr size_t WS_H = WS_SSQ + 1 * MiB;
constexpr size_t WS_DQ = WS_H + 88 * MiB, WS_DK = WS_DQ + 16 * MiB, WS_DV = WS_DK + 16 * MiB, WS_NQ = WS_DV + 16 * MiB;
constexpr size_t WS_NKV = WS_NQ + 16 * MiB;
constexpr size_t WS_MQ = WS_NKV + 24 * MiB;
constexpr size_t WS_MG = WS_MQ + 8 * MiB;
constexpr size_t WS_NG = WS_MG + 96 * MiB;
constexpr size_t WS_KCMP = WS_NG + 1 * MiB;
constexpr size_t WS_HC = WS_KCMP + 1 * MiB;
constexpr size_t WS_MEMB = WS_HC + 1 * MiB;
constexpr size_t WS_MEMSSQ = WS_MEMB + 2 * MiB;
constexpr size_t WS_MEMKV = WS_MEMSSQ + 1 * MiB;
constexpr size_t WS_ACAT = WS_MEMKV + 4 * MiB;
constexpr size_t WS_MERGED = WS_ACAT + 40 * MiB;
constexpr size_t WS_MISC = WS_MERGED + 32 * MiB;
constexpr size_t WS_ACC = WS_MISC + 1 * MiB;
constexpr size_t WS_END = WS_ACC + 32 * MiB;
constexpr int CW_BAR = 4096;
constexpr int CW_CVT = 12288;
constexpr int CW_NRM = 13312;
constexpr int CW_Q = 8192;

constexpr int RING_OFF = 0, RING_BYTES = 131072;
constexpr int EPI_OFF = RING_BYTES, EPI_BYTES = 4096;
constexpr int SSQI_OFF = EPI_OFF + EPI_BYTES, SSQI_BYTES = 8192;
constexpr int LDSCTL_OFF = SSQI_OFF + SSQI_BYTES, MISC_OFF = LDSCTL_OFF + 320;
constexpr int LDS_BYTES = 147456;

#define GAS __attribute__((address_space(1)))
#define LAS __attribute__((address_space(3)))
typedef unsigned short bf16;
typedef unsigned v4u __attribute__((ext_vector_type(4)));
typedef float f32x4 __attribute__((ext_vector_type(4)));
typedef short bf16x8 __attribute__((ext_vector_type(8)));
typedef GAS unsigned gu32;
typedef GAS unsigned long long gu64;
#define RLX_AGENT __ATOMIC_RELAXED, __HIP_MEMORY_SCOPE_AGENT
#define LDS_WAIT() asm volatile("s_waitcnt lgkmcnt(0)" ::: "memory")
#define VM_WAIT() asm volatile("s_waitcnt vmcnt(0)" ::: "memory")
__device__ __forceinline__ unsigned long long rt() { return __builtin_amdgcn_s_memrealtime(); }
__device__ __forceinline__ unsigned f2bf(float f) { unsigned u = __builtin_bit_cast(unsigned, f); return (u + 0x7fffu + ((u >> 16) & 1u)) >> 16; }
__device__ __forceinline__ unsigned pk2(float lo, float hi) { return f2bf(lo) | (f2bf(hi) << 16); }

#define XB_TMO      128
#define XB_XCNT(j)  (256  + 64 * (j))
#define XB_XSUB(j)  (1280 + 64 * (j))
#define XB_XGEN(j)  (2304 + 64 * (j))
#define XB_TOP      3328
#define XB_TOPGEN   3392
#define XCD_BAR_WORDS 3456
#define XB_SPIN_CAP (1u << 18)

__device__ __forceinline__ unsigned xb_ld(unsigned* p)              { return __hip_atomic_load(p, __ATOMIC_RELAXED, __HIP_MEMORY_SCOPE_AGENT); }
__device__ __forceinline__ unsigned xb_add(unsigned* p, unsigned v) { return __hip_atomic_fetch_add(p, v, __ATOMIC_RELAXED, __HIP_MEMORY_SCOPE_AGENT); }
__device__ __forceinline__ unsigned xb_xcc_id() { return (unsigned)__builtin_amdgcn_s_getreg((3 << 11) | 20) & 0xFu; }
#define XB_SPIN(cond, bar) do { unsigned _sp = 0; while (cond) { __builtin_amdgcn_s_sleep(1); \
    if ((++_sp & 255u) == 0u) { if (xb_ld(&(bar)[XB_TMO])) break; if (_sp > XB_SPIN_CAP) { atomicAdd(&(bar)[XB_TMO], 1u); break; } } } } while (0)

struct XcdBarrier {
    unsigned* bar; unsigned x;
    volatile LAS unsigned* st;
};

__device__ __forceinline__ XcdBarrier xcd_barrier_post(unsigned* bar, volatile LAS unsigned* st) {
    XcdBarrier b; b.bar = bar; b.x = xb_xcc_id(); b.st = st;
    if (threadIdx.x == 0) (void)xb_add(&bar[XB_XCNT(b.x)], 1u);
    return b;
}
__device__ __forceinline__ void xcd_barrier_complete(unsigned* bar, unsigned x, unsigned& nloc, unsigned& nx) {
    const unsigned G = gridDim.x * gridDim.y * gridDim.z;
    unsigned sum, cnt, mine, sp = 0u;
    for (;;) {
        sum = 0u; cnt = 0u; mine = 0u;
#pragma unroll
        for (unsigned j = 0; j < 16; ++j) { const unsigned c = xb_ld(&bar[XB_XCNT(j)]); sum += c; cnt += (c > 0u) ? 1u : 0u; mine = (j == x) ? c : mine; }
        if (sum == G) break;
        __builtin_amdgcn_s_sleep(1);
        if ((++sp & 255u) == 0u) { if (xb_ld(&bar[XB_TMO])) break; if (sp > XB_SPIN_CAP) { atomicAdd(&bar[XB_TMO], 1u); break; } }
    }
    nloc = mine > 0u ? mine : 1u; nx = cnt > 0u ? cnt : 1u;
}

__device__ __forceinline__ void xcd_barrier(const XcdBarrier& b) {
    asm volatile("s_waitcnt vmcnt(0)" ::: "memory");
    __syncthreads();
    if (threadIdx.x == 0) {
        unsigned* bar = b.bar;
        __builtin_amdgcn_s_waitcnt(0);
        unsigned nloc = b.st[0], nx = b.st[1];
        if (nloc == 0u) { xcd_barrier_complete(bar, b.x, nloc, nx); b.st[0] = nloc; b.st[1] = nx; }
        const unsigned old = xb_add(&bar[XB_XSUB(b.x)], 1u);
        const unsigned gen = old / nloc;
        if (old + 1u == (gen + 1u) * nloc) {
            __builtin_amdgcn_fence(__ATOMIC_RELEASE, "agent");
            asm volatile("s_waitcnt vmcnt(0)" ::: "memory");
            const unsigned og = xb_add(&bar[XB_TOP], 1u);
            const unsigned tg = og / nx;
            if (og + 1u == (tg + 1u) * nx) xb_add(&bar[XB_TOPGEN], 1u);
            else XB_SPIN(xb_ld(&bar[XB_TOPGEN]) == tg, bar);
            __builtin_amdgcn_fence(__ATOMIC_ACQUIRE, "agent");
            xb_add(&bar[XB_XGEN(b.x)], 1u);
            asm volatile("s_waitcnt vmcnt(0)" ::: "memory");
        } else {
            XB_SPIN(xb_ld(&bar[XB_XGEN(b.x)]) == gen, bar);
            __builtin_amdgcn_fence(__ATOMIC_ACQUIRE, "agent");
            asm volatile("s_waitcnt vmcnt(0)" ::: "memory");
        }
    }
    __syncthreads();
}

__device__ __forceinline__ float wave_sum(float v) {
#pragma unroll
    for (int o = 1; o < 64; o <<= 1) v += __shfl_xor(v, o);
    return v;
}
__device__ __forceinline__ float bf2f(unsigned short u) { return __uint_as_float(((unsigned)u) << 16); }
__device__ __forceinline__ float blo(unsigned w) { return __uint_as_float(w << 16); }
__device__ __forceinline__ float bhi(unsigned w) { return __uint_as_float(w & 0xffff0000u); }
__device__ __forceinline__ float gelu_tanh(float v) { const float u = 0.7978845608028654f * (v + 0.044715f * v * v * v); return 0.5f * v * (1.0f + tanhf(u)); }

constexpr size_t FRAG_FLAG = (size_t)1 << 41;
constexpr size_t TILED_FLAG = (size_t)1 << 40;
__device__ __forceinline__ void cvt_item(const float* W, size_t ldw, int k0, int c0, int ncv, int nrv, const float* scale, bf16* WT, size_t ldt, int r0, int kd0, int lane) {
    const int n4 = (lane & 15) * 4, kr = lane >> 4; f32x4 v[16];
#pragma unroll
    for (int i = 0; i < 16; ++i) { const int k = k0 + 16 * kr + i; v[i] = (n4 < ncv) ? *(const GAS f32x4*)(W + (size_t)k * ldw + c0 + n4) : (f32x4){0.f, 0.f, 0.f, 0.f}; }
    if (scale) {
#pragma unroll
        for (int i = 0; i < 16; ++i) v[i] = v[i] * scale[k0 + 16 * kr + i]; }
    if (n4 < nrv) {
#pragma unroll
        for (int e = 0; e < 4; ++e) { v4u o0, o1; o0.x = pk2(v[0][e], v[1][e]); o0.y = pk2(v[2][e], v[3][e]); o0.z = pk2(v[4][e], v[5][e]); o0.w = pk2(v[6][e], v[7][e]);
            o1.x = pk2(v[8][e], v[9][e]); o1.y = pk2(v[10][e], v[11][e]); o1.z = pk2(v[12][e], v[13][e]); o1.w = pk2(v[14][e], v[15][e]);
            const int n = r0 + n4 + e; GAS v4u* dp;
            if (ldt & TILED_FLAG) { const size_t KT = (size_t)(ldt & ~TILED_FLAG) / 64;
                dp = (GAS v4u*)(WT + ((((size_t)(n >> 8) * KT + (size_t)((kd0 + k0) >> 6)) * 256 + (n & 255)) * 64 + 16 * kr)); }
            else if (ldt & FRAG_FLAG) { const int k = k0 + 16 * kr;
                GAS bf16* fp = (GAS bf16*)WT + ((((size_t)((k >> 9) * 16 + ((k >> 5) & 15)) * 8 + (size_t)(n >> 4)) * 64 + (size_t)((n & 15) + 16 * ((k >> 3) & 3))) * 8);
                *(GAS v4u*)fp = o0; *(GAS v4u*)(fp + 128) = o1; continue; }
            else dp = (GAS v4u*)(WT + (size_t)n * ldt + kd0 + k0 + 16 * kr);
            dp[0] = o0; dp[1] = o1; } }
}
__device__ __forceinline__ void cvt_item_t(const float* W, size_t ldw, int k0, int c0, const float* scale, bf16* WT, size_t KT, int r0, int kd0, int lane, LAS unsigned char* scr) {
    const int n4 = (lane & 15) * 4, kr = lane >> 4; f32x4 v[16];
#pragma unroll
    for (int i = 0; i < 16; ++i) { const int k = k0 + 16 * kr + i; v[i] = *(const GAS f32x4*)(W + (size_t)k * ldw + c0 + n4); }
    if (scale) {
#pragma unroll
        for (int i = 0; i < 16; ++i) v[i] = v[i] * scale[k0 + 16 * kr + i]; }
#pragma unroll
    for (int e = 0; e < 4; ++e) { v4u o0, o1; o0.x = pk2(v[0][e], v[1][e]); o0.y = pk2(v[2][e], v[3][e]); o0.z = pk2(v[4][e], v[5][e]); o0.w = pk2(v[6][e], v[7][e]);
        o1.x = pk2(v[8][e], v[9][e]); o1.y = pk2(v[10][e], v[11][e]); o1.z = pk2(v[12][e], v[13][e]); o1.w = pk2(v[14][e], v[15][e]);
        LAS v4u* lp = (LAS v4u*)(scr + (n4 + e) * 144 + kr * 32); lp[0] = o0; lp[1] = o1; }
    asm volatile("s_waitcnt lgkmcnt(0)" ::: "memory");
    const int rr = lane >> 3, p = lane & 7;
    GAS v4u* dp = (GAS v4u*)(WT + (((size_t)(r0 >> 8) * KT + (size_t)((kd0 + k0) >> 6)) * 256 + (r0 & 255)) * 64) + lane;
    v4u t[8];
#pragma unroll
    for (int j = 0; j < 8; ++j) t[j] = *(const LAS v4u*)(scr + (8 * j + rr) * 144 + p * 16);
#pragma unroll
    for (int j = 0; j < 8; ++j) dp[64 * j] = t[j];
    asm volatile("s_waitcnt lgkmcnt(0)" ::: "memory");
}
__device__ __forceinline__ void cvt_dispatch(const float* W, int ldw, int nblk, const float* scale, bf16* WT, size_t ldt, int kd0, int mode, int it, int lane, LAS unsigned char* scr) {
    const int kb = it / nblk, nb = it % nblk, n0 = 64 * nb; int c0 = n0, r0 = n0, ncv = 64, nrv = 64;
    if (mode == 1) r0 = 256 * (n0 >> 7) + (n0 & 127);
    else if (mode == 2) r0 = 256 * (n0 >> 7) + 128 + (n0 & 127);
    else if (mode == 3) c0 = (n0 < NG_COL0) ? n0 : n0 + 24;
    else if (mode == 4) { c0 = NG_COL0; ncv = 24; nrv = 32; }
    if ((ldt & TILED_FLAG) && mode != 4) cvt_item_t(W, (size_t)ldw, 64 * kb, c0, scale, WT, (size_t)(ldt & ~TILED_FLAG) / 64, r0, kd0, lane, scr);
    else cvt_item(W, (size_t)ldw, 64 * kb, c0, ncv, nrv, scale, WT, ldt, r0, kd0, lane);
}
__device__ __forceinline__ void cvt_job(const float* W, int K, int ldw, int nblk, const float* scale, bf16* WT, size_t ldt, int kd0, int mode, LAS float* scr, int gw, int NGW, int lane) {
    const int nit = (K / 64) * nblk;
    for (int it = gw; it < nit; it += NGW) cvt_dispatch(W, ldw, nblk, scale, WT, ldt, kd0, mode, it, lane, (LAS unsigned char*)scr);
}

constexpr int CI_U1 = 2816, CI_D1 = 5632, CI_IN = 8448, CI_NG = 14592, CI_C1 = 14624, CI_C2 = 14880, CI_UD = 14888, CI_UN = 15400, CI_UM = 15912, CI_O = 16168, CI_G2 = 17192, CI_U2 = 20008, CI_D2 = 22824, CVT_ITEMS = 25640;
template <class ArgsT> __device__ __forceinline__ void cvt_layer_item(const ArgsT& args, unsigned char* ws, int l, int item, int lane, LAS unsigned char* scr) {
    unsigned char* wl = ws + WS_WL + (size_t)l * WL_STRIDE;
    const float* W; const float* scale = nullptr; bf16* WT; int ldw, nblk, it, kd0 = 0, mode = 0; size_t ldt;
    if (item < CI_U1)      { it = item;         W = args.in[I_F1G] + (size_t)l * DM * DFF; ldw = DFF; nblk = DFF / 64; scale = args.in[I_F1N] + l * DM; WT = (bf16*)(wl + WL_GU1); ldt = DM | TILED_FLAG; mode = 1; }
    else if (item < CI_D1) { it = item - CI_U1; W = args.in[I_F1U] + (size_t)l * DM * DFF; ldw = DFF; nblk = DFF / 64; scale = args.in[I_F1N] + l * DM; WT = (bf16*)(wl + WL_GU1); ldt = DM | TILED_FLAG; mode = 2; }
    else if (item < CI_IN) { it = item - CI_D1; W = args.in[I_F1D] + (size_t)l * DM * DFF; ldw = DM; nblk = DM / 64; WT = (bf16*)(wl + WL_D1); ldt = DFF | TILED_FLAG; }
    else if (item < CI_NG) { it = item - CI_IN; W = args.in[I_WIN] + (size_t)l * DM * IN_COLS; ldw = IN_COLS; nblk = PROJ_N / 64; scale = args.in[I_MIXN] + l * DM; WT = (bf16*)(wl + WL_IN); ldt = DM | TILED_FLAG; mode = 3; }
    else if (item < CI_C1) { it = item - CI_NG; W = args.in[I_WIN] + (size_t)l * DM * IN_COLS; ldw = IN_COLS; nblk = 1; scale = args.in[I_MIXN] + l * DM; WT = (bf16*)(wl + WL_NG); ldt = DM; mode = 4; }
    else if (item < CI_C2) { it = item - CI_C1; const int kv = it >> 7; it &= 127; W = args.in[I_CW1] + (size_t)(l * 2 + kv) * 4096 * 128; ldw = 128; nblk = 2; WT = (bf16*)(wl + WL_C1) + (size_t)kv * 128 * 4096; ldt = 4096 | FRAG_FLAG; }
    else if (item < CI_UD) { it = item - CI_C2; const int kv = it >> 2; it &= 3; W = args.in[I_CW2] + (size_t)(l * 2 + kv) * 128 * 128; ldw = 128; nblk = 2; WT = (bf16*)(wl + WL_C2) + (size_t)kv * 128 * 128; ldt = 128; }
    else if (item < CI_UN) { it = item - CI_UD; W = args.in[I_WUD] + (size_t)l * 1024 * DM; ldw = DM; nblk = 32; WT = (bf16*)(wl + WL_UP); ldt = 2560 | TILED_FLAG; }
    else if (item < CI_UM) { it = item - CI_UN; W = args.in[I_WUN] + (size_t)l * 1024 * DM; ldw = DM; nblk = 32; WT = (bf16*)(wl + WL_UP); ldt = 2560 | TILED_FLAG; kd0 = 1024; }
    else if (item < CI_O)  { it = item - CI_UM; W = args.in[I_WUM] + (size_t)l * 512 * DM; ldw = DM; nblk = 32; WT = (bf16*)(wl + WL_UP); ldt = 2560 | TILED_FLAG; kd0 = 2048; }
    else if (item < CI_G2) { it = item - CI_O;  W = args.in[I_WO] + (size_t)l * DM * DM; ldw = DM; nblk = 32; WT = (bf16*)(wl + WL_O); ldt = DM | TILED_FLAG; }
    else if (item < CI_U2) { it = item - CI_G2; W = args.in[I_F2G] + (size_t)l * DM * DFF; ldw = DFF; nblk = DFF / 64; scale = args.in[I_F2N] + l * DM; WT = (bf16*)(wl + WL_GU2); ldt = DM | TILED_FLAG; mode = 1; }
    else if (item < CI_D2) { it = item - CI_U2; W = args.in[I_F2U] + (size_t)l * DM * DFF; ldw = DFF; nblk = DFF / 64; scale = args.in[I_F2N] + l * DM; WT = (bf16*)(wl + WL_GU2); ldt = DM | TILED_FLAG; mode = 2; }
    else                   { it = item - CI_D2; W = args.in[I_F2D] + (size_t)l * DM * DFF; ldw = DM; nblk = DM / 64; WT = (bf16*)(wl + WL_D2); ldt = DFF | TILED_FLAG; }
    cvt_dispatch(W, ldw, nblk, scale, WT, ldt, kd0, mode, it, lane, scr);
}

struct CvtD { const float* W; const float* scale; bf16* WT; size_t ldt; int ldw, kd0, k0, c0, r0, ncv, nrv, tiled, sidx; };
template <class ArgsT> __device__ __forceinline__ void cvt_desc(const ArgsT& args, unsigned char* ws, int l, int item, CvtD& d) {
    unsigned char* wl = ws + WS_WL + (size_t)l * WL_STRIDE;
    const float* W; const float* scale = nullptr; bf16* WT; int ldw, nblk, it, kd0 = 0, mode = 0; size_t ldt;
    if (item < CI_U1)      { it = item;         W = args.in[I_F1G] + (size_t)l * DM * DFF; ldw = DFF; nblk = DFF / 64; scale = args.in[I_F1N] + l * DM; WT = (bf16*)(wl + WL_GU1); ldt = DM | TILED_FLAG; mode = 1; }
    else if (item < CI_D1) { it = item - CI_U1; W = args.in[I_F1U] + (size_t)l * DM * DFF; ldw = DFF; nblk = DFF / 64; scale = args.in[I_F1N] + l * DM; WT = (bf16*)(wl + WL_GU1); ldt = DM | TILED_FLAG; mode = 2; }
    else if (item < CI_IN) { it = item - CI_D1; W = args.in[I_F1D] + (size_t)l * DM * DFF; ldw = DM; nblk = DM / 64; WT = (bf16*)(wl + WL_D1); ldt = DFF | TILED_FLAG; }
    else if (item < CI_NG) { it = item - CI_IN; W = args.in[I_WIN] + (size_t)l * DM * IN_COLS; ldw = IN_COLS; nblk = PROJ_N / 64; scale = args.in[I_MIXN] + l * DM; WT = (bf16*)(wl + WL_IN); ldt = DM | TILED_FLAG; mode = 3; }
    else if (item < CI_C1) { it = item - CI_NG; W = args.in[I_WIN] + (size_t)l * DM * IN_COLS; ldw = IN_COLS; nblk = 1; scale = args.in[I_MIXN] + l * DM; WT = (bf16*)(wl + WL_NG); ldt = DM; mode = 4; }
    else if (item < CI_C2) { it = item - CI_C1; const int kv = it >> 7; it &= 127; W = args.in[I_CW1] + (size_t)(l * 2 + kv) * 4096 * 128; ldw = 128; nblk = 2; WT = (bf16*)(wl + WL_C1) + (size_t)kv * 128 * 4096; ldt = 4096 | FRAG_FLAG; }
    else if (item < CI_UD) { it = item - CI_C2; const int kv = it >> 2; it &= 3; W = args.in[I_CW2] + (size_t)(l * 2 + kv) * 128 * 128; ldw = 128; nblk = 2; WT = (bf16*)(wl + WL_C2) + (size_t)kv * 128 * 128; ldt = 128; }
    else if (item < CI_UN) { it = item - CI_UD; W = args.in[I_WUD] + (size_t)l * 1024 * DM; ldw = DM; nblk = 32; WT = (bf16*)(wl + WL_UP); ldt = 2560 | TILED_FLAG; }
    else if (item < CI_UM) { it = item - CI_UN; W = args.in[I_WUN] + (size_t)l * 1024 * DM; ldw = DM; nblk = 32; WT = (bf16*)(wl + WL_UP); ldt = 2560 | TILED_FLAG; kd0 = 1024; }
    else if (item < CI_O)  { it = item - CI_UM; W = args.in[I_WUM] + (size_t)l * 512 * DM; ldw = DM; nblk = 32; WT = (bf16*)(wl + WL_UP); ldt = 2560 | TILED_FLAG; kd0 = 2048; }
    else if (item < CI_G2) { it = item - CI_O;  W = args.in[I_WO] + (size_t)l * DM * DM; ldw = DM; nblk = 32; WT = (bf16*)(wl + WL_O); ldt = DM | TILED_FLAG; }
    else if (item < CI_U2) { it = item - CI_G2; W = args.in[I_F2G] + (size_t)l * DM * DFF; ldw = DFF; nblk = DFF / 64; scale = args.in[I_F2N] + l * DM; WT = (bf16*)(wl + WL_GU2); ldt = DM | TILED_FLAG; mode = 1; }
    else if (item < CI_D2) { it = item - CI_U2; W = args.in[I_F2U] + (size_t)l * DM * DFF; ldw = DFF; nblk = DFF / 64; scale = args.in[I_F2N] + l * DM; WT = (bf16*)(wl + WL_GU2); ldt = DM | TILED_FLAG; mode = 2; }
    else                   { it = item - CI_D2; W = args.in[I_F2D] + (size_t)l * DM * DFF; ldw = DM; nblk = DM / 64; WT = (bf16*)(wl + WL_D2); ldt = DFF | TILED_FLAG; }
    const int kb = it / nblk, nb = it % nblk, n0 = 64 * nb; int c0 = n0, r0 = n0, ncv = 64, nrv = 64;
    if (mode == 1) r0 = 256 * (n0 >> 7) + (n0 & 127);
    else if (mode == 2) r0 = 256 * (n0 >> 7) + 128 + (n0 & 127);
    else if (mode == 3) c0 = (n0 < NG_COL0) ? n0 : n0 + 24;
    else if (mode == 4) { c0 = NG_COL0; ncv = 24; nrv = 32; }
    d.sidx = (scale == nullptr) ? 0 : ((item < CI_D1) ? 1 : ((item < CI_C1) ? 2 : 3));
    d.W = W; d.scale = scale; d.WT = WT; d.ldt = ldt; d.ldw = ldw; d.kd0 = kd0; d.k0 = 64 * kb; d.c0 = c0; d.r0 = r0; d.ncv = ncv; d.nrv = nrv; d.tiled = ((ldt & TILED_FLAG) && mode != 4) ? 1 : 0;
}
__device__ __forceinline__ void cvt_ld(const CvtD& d, int lane, f32x4 (&v)[16]) {
    if (!d.tiled) return;
    const int n4 = (lane & 15) * 4, kr = lane >> 4; const GAS float* p = (const GAS float*)d.W + (size_t)(d.k0 + 16 * kr) * d.ldw + d.c0 + n4;
#pragma unroll
    for (int i = 0; i < 16; ++i) v[i] = __builtin_nontemporal_load((const GAS f32x4*)(p + (size_t)i * d.ldw));
}
__device__ __forceinline__ void cvt_fin(const CvtD& d, int lane, const f32x4 (&v)[16], LAS unsigned char* scr, const LAS float* gains  ) {
    if (!d.tiled) { cvt_item(d.W, (size_t)d.ldw, d.k0, d.c0, d.ncv, d.nrv, d.scale, d.WT, d.ldt, d.r0, d.kd0, lane); return; }
    const int n4 = (lane & 15) * 4, kr = lane >> 4; f32x4 sv[4];
    if (d.sidx) {
#pragma unroll
        for (int q = 0; q < 4; ++q) sv[q] = *(const LAS f32x4*)(gains + (d.sidx - 1) * 2048 + d.k0 + 16 * kr + 4 * q); }
    else {
#pragma unroll
        for (int q = 0; q < 4; ++q) sv[q] = (f32x4){1.f, 1.f, 1.f, 1.f}; }
#pragma unroll
    for (int e = 0; e < 4; ++e) { v4u o0, o1;
#define CP_(a) pg8::cvt_pk_bf16(v[a][e] * sv[(a) >> 2][(a) & 3], v[(a) + 1][e] * sv[((a) + 1) >> 2][((a) + 1) & 3])
        o0.x = CP_(0); o0.y = CP_(2); o0.z = CP_(4); o0.w = CP_(6); o1.x = CP_(8); o1.y = CP_(10); o1.z = CP_(12); o1.w = CP_(14);
#undef CP_
        LAS v4u* lp = (LAS v4u*)(scr + (n4 + e) * 144 + kr * 32); lp[0] = o0; lp[1] = o1; }
    asm volatile("s_waitcnt lgkmcnt(0)" ::: "memory");
    const int rr = lane >> 3, p = lane & 7; const size_t KT = (size_t)(d.ldt & ~TILED_FLAG) / 64;
    GAS v4u* dp = (GAS v4u*)(d.WT + (((size_t)(d.r0 >> 8) * KT + (size_t)((d.kd0 + d.k0) >> 6)) * 256 + (d.r0 & 255)) * 64) + lane;
    v4u t[8];
#pragma unroll
    for (int q = 0; q < 8; ++q) t[q] = *(const LAS v4u*)(scr + (8 * q + rr) * 144 + p * 16);
#pragma unroll
    for (int q = 0; q < 8; ++q) __builtin_nontemporal_store(t[q], dp + 64 * q);
    asm volatile("s_waitcnt lgkmcnt(0)" ::: "memory");
}
template <class ArgsT> __device__ __forceinline__ void cvt_pull(const ArgsT& args, unsigned char* ws, int L, gu32* ctr, int tid, LAS unsigned char* ring) {
    static_assert(CVT_ITEMS % 8 == 0, "cvt_pull takes eight items per pull");
    const int lane = tid & 63, wave = __builtin_amdgcn_readfirstlane(tid >> 6);
    LAS unsigned char* scr = ring + wave * 9216; LAS float* gains = (LAS float*)(ring + 8 * 9216);
    for (int i = tid; i < 3 * 2048; i += NTHREADS) { const int g = i >> 11, k = i & 2047; gains[i] = (g == 0 ? args.in[I_F1N] : (g == 1 ? args.in[I_MIXN] : args.in[I_F2N]))[L * DM + k]; }
    __syncthreads();
    for (;;) { unsigned b0 = 0u; if (lane == 0) b0 = __hip_atomic_fetch_add(ctr, 8u, __ATOMIC_RELAXED, __HIP_MEMORY_SCOPE_AGENT);
        const int base = (int)__builtin_amdgcn_readfirstlane((int)b0); if (base >= CVT_ITEMS) break;
        CvtD dA, dB; f32x4 vA[16], vB[16];
        cvt_desc(args, ws, L, base, dA); cvt_ld(dA, lane, vA);
#pragma unroll 1
        for (int jj = 0; jj < 4; ++jj) {
            cvt_desc(args, ws, L, base + 2 * jj + 1, dB); cvt_ld(dB, lane, vB);
            cvt_fin(dA, lane, vA, scr, gains);
            if (jj < 3) { cvt_desc(args, ws, L, base + 2 * jj + 2, dA); cvt_ld(dA, lane, vA); }
            cvt_fin(dB, lane, vB, scr, gains); } }
    __syncthreads();
}

namespace att {
typedef short bf16x8 __attribute__((ext_vector_type(8)));
typedef short s16x4 __attribute__((ext_vector_type(4)));
typedef float f32x16 __attribute__((ext_vector_type(16)));
typedef unsigned u32x4 __attribute__((ext_vector_type(4)));
#define KSWZ(row, colB) ((row) * 256 + ((colB) ^ (((row) & 7) << 4)))
#define SBAR() __builtin_amdgcn_sched_barrier(0)
constexpr int SHM_T = 16384;
constexpr int L_V = 0, L_K = 3 * SHM_T, L_WS = 6 * SHM_T, L_IMP = L_WS + 8 * 256, L_SEL = L_IMP + 64 * 65 * 4, L_MISC = L_SEL + 512, L_END = L_MISC + 64, L_STG = 65536  , L_TOP = L_STG + 4 * 8192;
static_assert(L_END <= 131072 && L_TOP <= L_WS, "attention LDS map");
constexpr float LOG2E = 1.4426950408889634f;
__device__ __forceinline__ int crow(int r, int hi) { return (r & 3) + 8 * (r >> 2) + 4 * hi; }
__device__ __forceinline__ unsigned cvtpk(float lo, float hi) { return pg8::cvt_pk_bf16(lo, hi); }
__device__ __forceinline__ int v_st(int k, int c) { const int kk = (k & ~0xC) | ((k & 4) << 1) | ((k & 8) >> 1); return ((kk >> 3) * 4 + (c >> 5)) * 512 + ((kk & 7) * 32 + (c & 31)) * 2; }
__device__ __forceinline__ int v_rd_base(int lane) { return ((lane & 3) << 3) | (((lane >> 2) & 3) << 6) | (((lane >> 4) & 1) << 5) | (((lane >> 5) & 1) << 8); }
constexpr int v_rd_off(int d0, int ks, int half) { return d0 * 512 + ks * 4096 + half * 2048; }
template <int OFF> __device__ __forceinline__ s16x4 tr_read(int vb) { s16x4 r; asm volatile("ds_read_b64_tr_b16 %0, %1 offset:%2" : "=&v"(r) : "v"(vb), "i"(OFF) : "memory"); return r; }
template <int D0> __device__ __forceinline__ void pv_one(f32x16& od, int vb, bf16x8 pa0, bf16x8 pa1, bf16x8 pa2, bf16x8 pa3) {
  const s16x4 l0 = tr_read<v_rd_off(D0, 0, 0)>(vb), h0 = tr_read<v_rd_off(D0, 0, 1)>(vb), l1 = tr_read<v_rd_off(D0, 1, 0)>(vb), h1 = tr_read<v_rd_off(D0, 1, 1)>(vb);
  const s16x4 l2 = tr_read<v_rd_off(D0, 2, 0)>(vb), h2 = tr_read<v_rd_off(D0, 2, 1)>(vb), l3 = tr_read<v_rd_off(D0, 3, 0)>(vb), h3 = tr_read<v_rd_off(D0, 3, 1)>(vb);
  asm volatile("s_waitcnt lgkmcnt(0)" ::: "memory"); SBAR();
#define PK(L, H) (bf16x8){L[0], L[1], L[2], L[3], H[0], H[1], H[2], H[3]}
  od = __builtin_amdgcn_mfma_f32_32x32x16_bf16(pa0, PK(l0, h0), od, 0, 0, 0);
  od = __builtin_amdgcn_mfma_f32_32x32x16_bf16(pa1, PK(l1, h1), od, 0, 0, 0);
  od = __builtin_amdgcn_mfma_f32_32x32x16_bf16(pa2, PK(l2, h2), od, 0, 0, 0);
  od = __builtin_amdgcn_mfma_f32_32x32x16_bf16(pa3, PK(l3, h3), od, 0, 0, 0);
#undef PK
}
__device__ __forceinline__ void pv_d0(f32x16 (&o)[4], int vb, bf16x8 pa0, bf16x8 pa1, bf16x8 pa2, bf16x8 pa3) {
  pv_one<0>(o[0], vb, pa0, pa1, pa2, pa3); pv_one<1>(o[1], vb, pa0, pa1, pa2, pa3); pv_one<2>(o[2], vb, pa0, pa1, pa2, pa3); pv_one<3>(o[3], vb, pa0, pa1, pa2, pa3);
}
__device__ __forceinline__ void pv_pre(s16x4 (&f)[4], int vb) { f[0] = tr_read<v_rd_off(0, 0, 0)>(vb); f[1] = tr_read<v_rd_off(0, 0, 1)>(vb); f[2] = tr_read<v_rd_off(0, 1, 0)>(vb); f[3] = tr_read<v_rd_off(0, 1, 1)>(vb); }
__device__ __forceinline__ void pv_d0p(f32x16 (&o)[4], int vb, bf16x8 pa0, bf16x8 pa1, bf16x8 pa2, bf16x8 pa3, const s16x4 (&f)[4]) {
  const s16x4 l2 = tr_read<v_rd_off(0, 2, 0)>(vb), h2 = tr_read<v_rd_off(0, 2, 1)>(vb), l3 = tr_read<v_rd_off(0, 3, 0)>(vb), h3 = tr_read<v_rd_off(0, 3, 1)>(vb);
  asm volatile("s_waitcnt lgkmcnt(0)" ::: "memory"); SBAR();
#define PK(L, H) (bf16x8){L[0], L[1], L[2], L[3], H[0], H[1], H[2], H[3]}
  o[0] = __builtin_amdgcn_mfma_f32_32x32x16_bf16(pa0, PK(f[0], f[1]), o[0], 0, 0, 0);
  o[0] = __builtin_amdgcn_mfma_f32_32x32x16_bf16(pa1, PK(f[2], f[3]), o[0], 0, 0, 0);
  o[0] = __builtin_amdgcn_mfma_f32_32x32x16_bf16(pa2, PK(l2, h2), o[0], 0, 0, 0);
  o[0] = __builtin_amdgcn_mfma_f32_32x32x16_bf16(pa3, PK(l3, h3), o[0], 0, 0, 0);
#undef PK
  pv_one<1>(o[1], vb, pa0, pa1, pa2, pa3); pv_one<2>(o[2], vb, pa0, pa1, pa2, pa3); pv_one<3>(o[3], vb, pa0, pa1, pa2, pa3);
}
typedef float f32x4_t __attribute__((ext_vector_type(4)));
typedef __attribute__((address_space(3))) const bf16x8* lds_frag_ptr;
typedef __attribute__((address_space(3))) float lds_f32;
typedef __attribute__((address_space(3))) unsigned short lds_u16;
typedef __attribute__((address_space(3))) unsigned long long lds_u64;
typedef __attribute__((address_space(3))) char lds_char;
__device__ __forceinline__ void k_addr(int (&ka)[4], int kbase  , int r32, int hi) {
#pragma unroll
  for (int j = 0; j < 4; ++j) ka[j] = kbase + r32 * 256 + ((j * 32 + hi * 16) ^ ((r32 & 7) << 4));
}
template <int ND0> __device__ __forceinline__ void qkt(f32x16& p0, f32x16& p1, const int (&ka)[4], const bf16x8 (&qr)[ND0]) {
#pragma unroll
  for (int h = 0; h < ND0; h += 4) { bf16x8 kb0[4], kb1[4];
#pragma unroll
    for (int j = 0; j < 4; ++j) { kb0[j] = *(lds_frag_ptr)(unsigned)(ka[(h + j) & 3] + ((h + j) >> 2) * 128); kb1[j] = *(lds_frag_ptr)(unsigned)(ka[(h + j) & 3] + ((h + j) >> 2) * 128 + 8192); }
    SBAR();
#pragma unroll
    for (int j = 0; j < 4; ++j) { p0 = __builtin_amdgcn_mfma_f32_32x32x16_bf16(kb0[j], qr[h + j], p0, 0, 0, 0); p1 = __builtin_amdgcn_mfma_f32_32x32x16_bf16(kb1[j], qr[h + j], p1, 0, 0, 0); }
  }
}
template <int ND0, bool BIAS, bool SELM>
__device__ __forceinline__ void run_tiles(char* lds, const bf16* Kg, const bf16* Vg, size_t ldk, size_t ldv, unsigned long long tmask, const bf16x8 (&qr)[ND0], int dbase,
                                          float slope2, int q, int klo, int khi, int klo_max, int khi_min, unsigned long long selq,
                                          f32x16 (&o)[4], float& m_reg, float& l_reg, int tid_in) {
  int tid = tid_in; asm volatile("" : "+v"(tid)); const int lane = tid & 63;
  const int r32 = lane & 31, hi = lane >> 5, wid = __builtin_amdgcn_readfirstlane(tid >> 6);
  const int vb0 = (int)(uintptr_t)(lds + L_V) + v_rd_base(lane);
  int kinv[4]; k_addr(kinv, (int)(uintptr_t)(lds + L_K) + (dbase >> 2) * 128, r32, hi);
  lds_f32* al_l = (lds_f32*)(lds + L_WS) + wid * 64;
  if (tmask == 0ull) return;
  const int wu = wid;
  unsigned koff[2], voff[2];
#pragma unroll
  for (int i = 0; i < 2; ++i) { const int pc = wu + 8 * i;
    const int krow = pc * 4 + (lane >> 4), kcol = ((lane & 15) ^ (krow & 7)) * 8; koff[i] = (unsigned)(krow * (int)ldk + kcol);
    const int sub = pc * 2 + (lane >> 5), kk = (sub >> 2) * 8 + ((lane & 31) >> 2), vk = (kk & ~0xC) | ((kk & 4) << 1) | ((kk & 8) >> 1), vc = (sub & 3) * 32 + (lane & 3) * 8; voff[i] = (unsigned)(vk * (int)ldv + vc); }
  typedef __attribute__((address_space(3))) unsigned lds_u32;
  lds_u32* ldsa = (lds_u32*)lds;
#define DMA_K(key0, b) do { _Pragma("unroll") for (int i_ = 0; i_ < 2; ++i_) \
    __builtin_amdgcn_global_load_lds((const unsigned*)(Kg + (size_t)(key0) * ldk + koff[i_]), (lds_u32*)((__attribute__((address_space(3))) char*)ldsa + L_K + (b) * SHM_T + (wu + 8 * i_) * 1024), 16, 0, 0); } while (0)
#define DMA_V(key0, b) do { _Pragma("unroll") for (int i_ = 0; i_ < 2; ++i_) \
    __builtin_amdgcn_global_load_lds((const unsigned*)(Vg + (size_t)(key0) * ldv + voff[i_]), (lds_u32*)((__attribute__((address_space(3))) char*)ldsa + L_V + (b) * SHM_T + (wu + 8 * i_) * 1024), 16, 0, 0); } while (0)
#define QK(P0, P1, tt, kb) do { const float b0_ = BIAS ? slope2 * (float)((tt) * 64 + 4 * hi - q) : 0.f; \
    _Pragma("unroll") for (int r = 0; r < 16; ++r) { const int cr = (r & 3) + 8 * (r >> 2); P0[r] = BIAS ? fmaf(slope2, (float)cr, b0_) : 0.f; P1[r] = BIAS ? fmaf(slope2, (float)(cr + 32), b0_) : 0.f; } \
    int ka_[4]; _Pragma("unroll") for (int j = 0; j < 4; ++j) ka_[j] = kinv[j] + (kb) * SHM_T; \
    qkt<ND0>(P0, P1, ka_, qr); } while (0)
#define SM_PV(P0, P1, tt, vbuf) do { const int tb = (tt) * 64; s16x4 vpre_[4]; pv_pre(vpre_, vb0 + (vbuf) * SHM_T); \
    bool selb = true; if (SELM) selb = ((selq >> (tt)) & 1ull) != 0ull; \
    if ((tb < klo_max) || (tb + 63 > khi_min)) { \
      const bool lv = selb && (khi >= klo); const unsigned span = lv ? (unsigned)(khi - klo) : 0u; const int lo_t = lv ? (klo - tb - 4 * hi) : 1000000; \
      _Pragma("unroll") for (int r = 0; r < 16; ++r) { const int cr = (r & 3) + 8 * (r >> 2); \
        P0[r] = ((unsigned)(cr - lo_t) <= span) ? P0[r] : -INFINITY; P1[r] = ((unsigned)(cr + 32 - lo_t) <= span) ? P1[r] : -INFINITY; } } \
    else if (SELM && !__all(selb)) {   \
      _Pragma("unroll") for (int r = 0; r < 16; ++r) { P0[r] = selb ? P0[r] : -INFINITY; P1[r] = selb ? P1[r] : -INFINITY; } } \
    float pmax = fmaxf(P0[0], P1[0]); \
    _Pragma("unroll") for (int r = 1; r < 16; ++r) pmax = fmaxf(fmaxf(pmax, P0[r]), P1[r]); \
    { auto rr = __builtin_amdgcn_permlane32_swap(__float_as_uint(pmax), __float_as_uint(pmax), false, false); pmax = fmaxf(__uint_as_float(rr[0]), __uint_as_float(rr[1])); } \
    const float mn = (pmax > m_reg + 8.0f) ? pmax : m_reg, alpha = __builtin_amdgcn_exp2f(m_reg - mn); m_reg = mn;     \
    _Pragma("unroll") for (int r = 0; r < 16; ++r) { P0[r] = __builtin_amdgcn_exp2f(P0[r] - mn); P1[r] = __builtin_amdgcn_exp2f(P1[r] - mn); } \
    float ps; { typedef float f32x2_ __attribute__((ext_vector_type(2))); f32x2_ s2 = {0.f, 0.f}; \
      _Pragma("unroll") for (int r = 0; r < 16; r += 2) { s2 += (f32x2_){P0[r], P0[r + 1]}; s2 += (f32x2_){P1[r], P1[r + 1]}; } ps = s2.x + s2.y; } \
    { auto rr = __builtin_amdgcn_permlane32_swap(__float_as_uint(ps), __float_as_uint(ps), false, false); ps = __uint_as_float(rr[0]) + __uint_as_float(rr[1]); } \
    l_reg = l_reg * alpha + ps; \
    bf16x8 pa0, pa1, pa2, pa3; \
    PK4(P0, 0, pa0); PK4(P0, 8, pa1); PK4(P1, 0, pa2); PK4(P1, 8, pa3); \
    if (__any(alpha < 1.f)) { if (hi == 0) al_l[r32] = alpha; asm volatile("s_waitcnt lgkmcnt(0)" ::: "memory"); \
      _Pragma("unroll") for (int d = 0; d < 4; ++d) _Pragma("unroll") for (int r = 0; r < 16; ++r) o[d][r] *= al_l[crow(r, hi)]; } \
    pv_d0p(o, vb0 + (vbuf) * SHM_T, pa0, pa1, pa2, pa3, vpre_); } while (0)
#define PK4(P, BASE, OUT) do { unsigned a0 = cvtpk(P[BASE + 0], P[BASE + 1]), a1 = cvtpk(P[BASE + 2], P[BASE + 3]);   \
    unsigned b0_ = cvtpk(P[BASE + 4], P[BASE + 5]), b1_ = cvtpk(P[BASE + 6], P[BASE + 7]);                              \
    auto r0 = __builtin_amdgcn_permlane32_swap(a0, b0_, false, false); auto r1 = __builtin_amdgcn_permlane32_swap(a1, b1_, false, false); \
    u32x4 w = {r0[0], r1[0], r0[1], r1[1]}; OUT = *reinterpret_cast<bf16x8*>(&w); } while (0)
#define NEXT_TILE(var) do { var = -1; if (tmask != 0ull) { var = 63 - (int)__builtin_clzll(tmask); tmask &= ~(1ull << var); } } while (0)
#define WAIT_BAR() do { asm volatile("s_waitcnt vmcnt(0)" ::: "memory"); __syncthreads(); } while (0)
#define STEP_WAIT(nk, nv) do { if ((nk) && (nv)) asm volatile("s_waitcnt vmcnt(4)" ::: "memory"); else if ((nk) || (nv)) asm volatile("s_waitcnt vmcnt(2)" ::: "memory"); else asm volatile("s_waitcnt vmcnt(0)" ::: "memory"); \
    asm volatile("s_waitcnt lgkmcnt(0)" ::: "memory"); __builtin_amdgcn_s_barrier(); asm volatile("" ::: "memory"); } while (0)
  int t0, t1, t2, t3; NEXT_TILE(t0); NEXT_TILE(t1); NEXT_TILE(t2);
  DMA_K(t0 * 64, 0); DMA_V(t0 * 64, 0); if (t1 >= 0) { DMA_K(t1 * 64, 1); DMA_V(t1 * 64, 1); } if (t2 >= 0) DMA_K(t2 * 64, 2);
  if (t2 >= 0) asm volatile("s_waitcnt vmcnt(4)" ::: "memory"); else if (t1 >= 0) asm volatile("s_waitcnt vmcnt(2)" ::: "memory"); else asm volatile("s_waitcnt vmcnt(0)" ::: "memory");
  asm volatile("s_waitcnt lgkmcnt(0)" ::: "memory"); __builtin_amdgcn_s_barrier(); asm volatile("" ::: "memory");
  f32x16 pA0, pA1, pB0, pB1;
  QK(pA0, pA1, t0, 0);
  asm volatile("s_waitcnt lgkmcnt(0)" ::: "memory"); __builtin_amdgcn_s_barrier(); asm volatile("" ::: "memory");
  int s0 = 0, s1 = 1, s2 = 2;
  for (;;) {
    NEXT_TILE(t3);
    if (t3 >= 0) DMA_K(t3 * 64, s0);
    if (t2 >= 0) DMA_V(t2 * 64, s2);
    if (t1 >= 0) QK(pB0, pB1, t1, s1);
    SM_PV(pA0, pA1, t0, s0);
    STEP_WAIT(t3 >= 0, t2 >= 0);
    if (t1 < 0) break;
    t0 = t1; t1 = t2; t2 = t3; { const int r_ = s0; s0 = s1; s1 = s2; s2 = r_; }
    NEXT_TILE(t3);
    if (t3 >= 0) DMA_K(t3 * 64, s0);
    if (t2 >= 0) DMA_V(t2 * 64, s2);
    if (t1 >= 0) QK(pA0, pA1, t1, s1);
    SM_PV(pB0, pB1, t0, s0);
    STEP_WAIT(t3 >= 0, t2 >= 0);
    if (t1 < 0) break;
    t0 = t1; t1 = t2; t2 = t3; { const int r_ = s0; s0 = s1; s1 = s2; s2 = r_; }
  }
  asm volatile("s_waitcnt vmcnt(0) lgkmcnt(0)" ::: "memory"); __syncthreads();
#undef STEP_WAIT
#undef DMA_K
#undef DMA_V
#undef QK
#undef SM_PV
#undef PK4
#undef NEXT_TILE
#undef WAIT_BAR
}
__device__ __forceinline__ void row_bcast(lds_f32* wl, float sc, float (&out)[16], int r32_in, int hi_in) {
  int r32 = r32_in, hi = hi_in; asm volatile("" : "+v"(r32), "+v"(hi));
  asm volatile("s_waitcnt lgkmcnt(0)" ::: "memory");
  if (hi == 0) wl[r32] = sc; asm volatile("s_waitcnt lgkmcnt(0)" ::: "memory");
#pragma unroll
  for (int r = 0; r < 16; ++r) out[r] = wl[crow(r, hi)];
  asm volatile("s_waitcnt lgkmcnt(0)" ::: "memory");
}
template <int N> __device__ __forceinline__ void load_q(bf16x8 (&qr)[N], const bf16* qp  , int hi) {
#pragma unroll
  for (int d0 = 0; d0 < N; ++d0) qr[d0] = *reinterpret_cast<const bf16x8*>(qp + d0 * 16 + hi * 8);
}

__device__ __forceinline__ void store_rows(const f32x16 (&o)[4], const float (&sc)[16], char* stg, bf16* gp  , size_t pitch, int lane_in) {
  int lane = lane_in; asm volatile("" : "+v"(lane));
  const int r32 = lane & 31, hi = lane >> 5;
  lds_u16* sp = (lds_u16*)stg + hi * 4 * 128 + r32;
#pragma unroll
  for (int r = 0; r < 16; ++r)
#pragma unroll
    for (int d0 = 0; d0 < 4; ++d0) sp[((r & 3) + 8 * (r >> 2)) * 128 + d0 * 32] = (unsigned short)f2bf(o[d0][r] * sc[r]);
  asm volatile("s_waitcnt lgkmcnt(0)" ::: "memory");
  const int ch = lane & 15, rr = lane >> 4;
#pragma unroll
  for (int i = 0; i < 8; ++i) { const int row = i * 4 + rr; const u32x4 v = *(const __attribute__((address_space(3))) u32x4*)((lds_char*)stg + row * 256 + ch * 16); *(u32x4*)(gp + (size_t)row * pitch + ch * 8) = v; }
  asm volatile("s_waitcnt lgkmcnt(0)" ::: "memory");
}

__device__ __forceinline__ void mem_unit(char* lds, int b, int hm, int qb, const bf16* MQ, const bf16* MKV  , bf16* ACAT, int tid_in) {
  int tid = tid_in; asm volatile("" : "+v"(tid)); const int lane = tid & 63;
  const int r32 = lane & 31, hi = lane >> 5, wid = __builtin_amdgcn_readfirstlane(tid >> 6);
  const size_t row0 = (size_t)b * SEQ + qb * 256 + wid * 32;
  bf16x8 qr[8]; load_q<8>(qr, MQ + (row0 + r32) * 512 + hm * 128, hi);
  f32x16 o[4] = {}; float m_reg = -1e30f, l_reg = 0.f;
  const bf16* Kg = MKV + (size_t)(b * MEM_LEN) * 4096 + hm * 128;
  run_tiles<8, false, false>(lds, Kg, Kg + 512, 4096, 4096, 0xFull, qr, 0, 0.f, 0, 0, 1 << 30, 0, 1 << 30, 0ull, o, m_reg, l_reg, tid);
  int lane2 = tid_in; asm volatile("" : "+v"(lane2)); lane2 &= 63;
  float sc[16]; row_bcast((lds_f32*)(lds + L_WS) + wid * 64, 1.0f / fmaxf(l_reg, 1e-30f), sc, lane2 & 31, lane2 >> 5);
  store_rows(o, sc, lds + wid * 8192, ACAT + row0 * 2560 + 2048 + hm * 128, 2560, lane2);
  __syncthreads();
}

__device__ __forceinline__ void diff_unit(char* lds, int b, int h, int qb, const bf16* DQ, const bf16* DK, const bf16* DV, bf16* ACAT, const float* subln, float lam, float lam_init, unsigned* nrm, int tid_in) {
  int tid = tid_in; asm volatile("" : "+v"(tid)); const int lane = tid & 63;
  int r32 = lane & 31, hi = lane >> 5; const int wid = __builtin_amdgcn_readfirstlane(tid >> 6), mp = wid >> 2, qs = wid & 3;
  const int q0w = qb * 128 + qs * 32, q = q0w + r32; const size_t rowb = (size_t)b * SEQ;
  bf16x8 qr[4]; load_q<4>(qr, DQ + (rowb + q) * 1024 + h * 128 + mp * 64, hi);
  f32x16 o[4] = {}; float m_reg = -1e30f, l_reg = 0.f;
  const int nt = (qb * 128 + 128) / 64; unsigned long long tmask = (nt >= 64) ? ~0ull : ((1ull << nt) - 1ull);
  const float slope2 = exp2f(-(float)(h + 1)) * LOG2E;
  { const float q2a = __uint_as_float(__hip_atomic_load(nrm + (h * 2) * 16, __ATOMIC_RELAXED, __HIP_MEMORY_SCOPE_AGENT)), q2b = __uint_as_float(__hip_atomic_load(nrm + (h * 2 + 1) * 16, __ATOMIC_RELAXED, __HIP_MEMORY_SCOPE_AGENT));
    const float k2a = __uint_as_float(__hip_atomic_load(nrm + (16 + h * 2) * 16, __ATOMIC_RELAXED, __HIP_MEMORY_SCOPE_AGENT)), k2b = __uint_as_float(__hip_atomic_load(nrm + (16 + h * 2 + 1) * 16, __ATOMIC_RELAXED, __HIP_MEMORY_SCOPE_AGENT));
    const float bqk = sqrtf(fmaxf(q2a * k2a, q2b * k2b)), dcut = (2.05f * bqk + 153.0f) / slope2;
    int ns = (dcut < 8192.f) ? (qb * 128 - (int)dcut - 1) / 64 : 0; ns = __builtin_amdgcn_readfirstlane(ns);
    if (ns > 0) tmask &= ~((1ull << ns) - 1ull); }
  run_tiles<4, true, false>(lds, DK + rowb * 1024 + h * 128, DV + rowb * 1024 + h * 128, 1024, 1024, tmask, qr, mp * 4, slope2, q, 0, q, 0, q0w, 0ull, o, m_reg, l_reg, tid);
  int lane2 = tid_in; asm volatile("" : "+v"(lane2)); lane2 &= 63; r32 = lane2 & 31; hi = lane2 >> 5;
  float sc[16]; row_bcast((lds_f32*)(lds + L_WS) + wid * 64, 1.0f / fmaxf(l_reg, 1e-30f), sc, r32, hi);
  lds_f32* X = (lds_f32*)lds + qs * 4096;
  if (mp == 1) {
#pragma unroll
    for (int r = 0; r < 16; ++r)
#pragma unroll
      for (int d0 = 0; d0 < 4; ++d0) X[crow(r, hi) * 128 + d0 * 32 + r32] = o[d0][r] * sc[r]; }
  __syncthreads();
  if (mp == 0) {
    const float kk = 1.0f - lam_init; float g4[4];
#pragma unroll
    for (int d0 = 0; d0 < 4; ++d0) g4[d0] = subln[d0 * 32 + r32] * kk;
#pragma unroll
    for (int r = 0; r < 16; ++r) { float ss = 0.f;
#pragma unroll
      for (int d0 = 0; d0 < 4; ++d0) { const float v = o[d0][r] * sc[r] - lam * X[crow(r, hi) * 128 + d0 * 32 + r32]; o[d0][r] = v * g4[d0]; ss += v * v; }
      ss += __shfl_xor(ss, 1); ss += __shfl_xor(ss, 2); ss += __shfl_xor(ss, 4); ss += __shfl_xor(ss, 8); ss += __shfl_xor(ss, 16);
      sc[r] = 1.0f / sqrtf(ss * (1.0f / 128.0f) + NORM_EPS); }
    store_rows(o, sc, lds + L_STG + qs * 8192, ACAT + (rowb + q0w) * 2560 + h * 128, 2560, lane2);
  }
  __syncthreads();
}

template <int MODE> __device__ __forceinline__ void acc_rows(f32x16 (&o)[4], const float (&sc)[16], float* ap  , int lane_in) {
  int lane = lane_in; asm volatile("" : "+v"(lane));
  GAS f32x4_t* p = (GAS f32x4_t*)ap + lane;
  if (MODE != 0) { f32x4_t t[16];
#pragma unroll
    for (int i = 0; i < 16; ++i) t[i] = p[i * 64];
#pragma unroll
    for (int i = 0; i < 16; ++i)
#pragma unroll
      for (int e = 0; e < 4; ++e) o[i >> 2][4 * (i & 3) + e] = o[i >> 2][4 * (i & 3) + e] * sc[4 * (i & 3) + e] + t[i][e];
    asm volatile("" ::: "memory");
    if (MODE == 1) {
#pragma unroll
      for (int i = 0; i < 16; ++i) p[i * 64] = (f32x4_t){o[i >> 2][4 * (i & 3)], o[i >> 2][4 * (i & 3) + 1], o[i >> 2][4 * (i & 3) + 2], o[i >> 2][4 * (i & 3) + 3]}; }
  } else {
#pragma unroll
    for (int i = 0; i < 16; ++i) p[i * 64] = (f32x4_t){o[i >> 2][4 * (i & 3)] * sc[4 * (i & 3)], o[i >> 2][4 * (i & 3) + 1] * sc[4 * (i & 3) + 1], o[i >> 2][4 * (i & 3) + 2] * sc[4 * (i & 3) + 2], o[i >> 2][4 * (i & 3) + 3] * sc[4 * (i & 3) + 3]}; }
}
__device__ __forceinline__ void imp_pass(char* lds, const bf16* Kc, int ntc, const bf16x8 (&qr)[8], int cmax, float m_reg, float il, float (&impa)[32], int tid, int lane) {
  const int r32 = lane & 31, hi = lane >> 5, sr = tid >> 4, sc = (tid & 15) * 8;
  for (int t = 0; t < ntc; ++t) { const bf16x8 k0 = *(const bf16x8*)(Kc + (size_t)(t * 64 + sr) * 128 + sc), k1 = *(const bf16x8*)(Kc + (size_t)(t * 64 + 32 + sr) * 128 + sc);
    *(bf16x8*)(lds + t * SHM_T + KSWZ(sr, sc * 2)) = k0; *(bf16x8*)(lds + t * SHM_T + KSWZ(32 + sr, sc * 2)) = k1; }
  __syncthreads();
  float carry = 0.f;
#pragma unroll
  for (int t = 0; t < 4; ++t) {
    if (t < ntc) {
      f32x16 p0 = f32x16{}, p1 = f32x16{}; { int ka[4]; k_addr(ka, (int)(uintptr_t)lds + t * SHM_T, r32, hi); qkt<8>(p0, p1, ka, qr); }
      const int kb = t * 64 + 4 * hi;
#pragma unroll
      for (int r = 0; r < 16; ++r) { const int cr = (r & 3) + 8 * (r >> 2);
        p0[r] = (kb + cr <= cmax) ? __builtin_amdgcn_exp2f(p0[r] - m_reg) * il : 0.f; p1[r] = (kb + cr + 32 <= cmax) ? __builtin_amdgcn_exp2f(p1[r] - m_reg) * il : 0.f; }
      float xp0[4], xp1[4], c0[4], c1[4];
#pragma unroll
      for (int a = 0; a < 4; ++a) { xp0[a] = __shfl_xor(p0[4 * a + 3], 32); xp1[a] = __shfl_xor(p1[4 * a + 3], 32);
        c0[a] = (p0[4 * a] + p0[4 * a + 1]) + (p0[4 * a + 2] + p0[4 * a + 3]); c1[a] = (p1[4 * a] + p1[4 * a + 1]) + (p1[4 * a + 2] + p1[4 * a + 3]); }
#pragma unroll
      for (int a = 0; a < 4; ++a) { const float e0 = hi ? xp0[a] : (a ? xp0[a > 0 ? a - 1 : 0] : carry), e1 = hi ? xp1[a] : (a ? xp1[a > 0 ? a - 1 : 0] : xp0[3]);
        impa[t * 8 + a] = c0[a] + e0; impa[t * 8 + 4 + a] = c1[a] + e1; }
      carry = xp1[3];
    } else {
#pragma unroll
      for (int i = 0; i < 8; ++i) impa[t * 8 + i] = 0.f; }
  }
  __syncthreads();
}
__device__ __forceinline__ void nsa_unit(char* lds, int b, int g, int cur, const bf16* NQ, const bf16* NKV, const bf16* KCMP, const float* NG, float* ACC, bf16* ACAT, int tid_in) {
  int tid = tid_in; asm volatile("" : "+v"(tid)); const int lane = tid & 63;
  const int r32 = lane & 31, hi = lane >> 5, wid = __builtin_amdgcn_readfirstlane(tid >> 6), hh = wid & 3, qh = wid >> 2, head = g * 4 + hh;
  const int q0w = cur * 64 + qh * 32, q = q0w + r32; const size_t rowb = (size_t)b * SEQ;
  bf16x8 qr[8]; load_q<8>(qr, NQ + (rowb + q) * 1024 + head * 128, hi);
  const float slope2 = exp2f(-(float)(head + 1)) * LOG2E;
  lds_f32* wl = (lds_f32*)(lds + L_WS) + wid * 64; lds_f32* imp_sh = (lds_f32*)(lds + L_IMP); lds_u64* sel_sh = (lds_u64*)(lds + L_SEL); lds_u64* misc = (lds_u64*)(lds + L_MISC);
  float* accp = ACC + ((size_t)(((b * 2 + g) * 64 + cur) * 8 + wid)) * 4096;
  const float* ngp = NG + (rowb + q) * 24 + head * 3;
  f32x16 o[4] = {}; float m_reg = -1e30f, l_reg = 0.f; float sc[16];
  { const int cmax = (q >= 31) ? ((q - 31) >> 4) : -1, cmin_w = (q0w >= 31) ? ((q0w - 31) >> 4) : -1;
    const int ntc = ((4 * cur + 2) >> 6) + 1; const unsigned long long tmc = (1ull << ntc) - 1ull;
    const bf16* Kc = KCMP + ((size_t)((0 * BATCH + b) * 2 + g) * 256) * 128; const bf16* Vc = KCMP + ((size_t)((1 * BATCH + b) * 2 + g) * 256) * 128;
    run_tiles<8, false, false>(lds, Kc, Vc, 128, 128, tmc, qr, 0, 0.f, q, 0, cmax, 0, cmin_w, 0ull, o, m_reg, l_reg, tid);
    const float il = 1.0f / fmaxf(l_reg, 1e-30f);
    row_bcast(wl, ngp[0] * il, sc, r32, hi); acc_rows<0>(o, sc, accp, lane);
    float impa[32]; imp_pass(lds, Kc, ntc, qr, cmax, m_reg, il, impa, tid, lane);
    for (int h4 = 0; h4 < 4; ++h4) {
      if (hh == h4) { lds_f32* ir = imp_sh + (qh * 32 + r32) * 65 + hi;
#pragma unroll
        for (int t = 0; t < 4; ++t)
#pragma unroll
          for (int a = 0; a < 4; ++a) { const float v0 = impa[t * 8 + a], v1 = impa[t * 8 + 4 + a];
            if (h4 == 0) { ir[16 * t + 2 * a] = v0; ir[16 * t + 8 + 2 * a] = v1; } else { ir[16 * t + 2 * a] += v0; ir[16 * t + 8 + 2 * a] += v1; } } }
      __syncthreads(); }
  }
  { const int ql = tid >> 3, sub = tid & 7; const lds_f32* ir = imp_sh + ql * 65;
    float myv[8]; int rank[8];
#pragma unroll
    for (int i = 0; i < 8; ++i) { const int j = sub * 8 + i; myv[i] = (j == 0 || j == cur || j == cur - 1) ? 1e9f : (j > cur ? -1e9f : ir[j]); rank[i] = 0; }
    for (int j2 = 0; j2 < 64; ++j2) { const float v2 = (j2 == 0 || j2 == cur || j2 == cur - 1) ? 1e9f : (j2 > cur ? -1e9f : ir[j2]);
#pragma unroll
      for (int i = 0; i < 8; ++i) rank[i] += ((v2 > myv[i]) || (v2 == myv[i] && j2 < sub * 8 + i)) ? 1 : 0; }
    unsigned bits = 0u;
#pragma unroll
    for (int i = 0; i < 8; ++i) bits |= (rank[i] < 8 ? 1u : 0u) << i;
    unsigned slo = (sub < 4) ? (bits << (8 * sub)) : 0u, shi = (sub >= 4) ? (bits << (8 * (sub - 4))) : 0u;
    slo |= __shfl_xor(slo, 1); slo |= __shfl_xor(slo, 2); slo |= __shfl_xor(slo, 4); shi |= __shfl_xor(shi, 1); shi |= __shfl_xor(shi, 2); shi |= __shfl_xor(shi, 4);
    if (sub == 0) sel_sh[ql] = ((unsigned long long)shi << 32) | slo;
    __syncthreads();
    if (wid == 0) { const unsigned long long v = sel_sh[lane]; unsigned a = (unsigned)v, c = (unsigned)(v >> 32);
#pragma unroll
      for (int s = 1; s < 64; s <<= 1) { a |= __shfl_xor(a, s); c |= __shfl_xor(c, s); }
      if (lane == 0) misc[0] = ((unsigned long long)c << 32) | a; }
    __syncthreads();
  }
  const unsigned long long selq = sel_sh[qh * 32 + r32];
  unsigned long long usel; { const unsigned long long v = misc[0]; usel = ((unsigned long long)(unsigned)__builtin_amdgcn_readfirstlane((int)(unsigned)(v >> 32)) << 32) | (unsigned)__builtin_amdgcn_readfirstlane((int)(unsigned)v); }
  { const unsigned long long upto = (cur >= 63) ? ~0ull : ((2ull << cur) - 1ull);
    const bf16* Ks = NKV + ((size_t)(1 * 4 + 0 * 2 + g) * MROWS + rowb) * 128; const bf16* Vs = NKV + ((size_t)(1 * 4 + 1 * 2 + g) * MROWS + rowb) * 128;
#pragma unroll
    for (int d = 0; d < 4; ++d) o[d] = f32x16{};
    m_reg = -1e30f; l_reg = 0.f;
    run_tiles<8, true, true>(lds, Ks, Vs, 128, 128, usel & upto, qr, 0, slope2, q, 0, q, 0, q0w, selq, o, m_reg, l_reg, tid);
    row_bcast(wl, ngp[1] / fmaxf(l_reg, 1e-30f), sc, r32, hi); acc_rows<1>(o, sc, accp, lane);
  }
  { const int tlo = cur >= 8 ? cur - 8 : 0; const unsigned long long upto = (cur >= 63) ? ~0ull : ((2ull << cur) - 1ull); const unsigned long long tmw = upto & ~((1ull << tlo) - 1ull);
    const bf16* Kw = NKV + ((size_t)(2 * 4 + 0 * 2 + g) * MROWS + rowb) * 128; const bf16* Vw = NKV + ((size_t)(2 * 4 + 1 * 2 + g) * MROWS + rowb) * 128;
#pragma unroll
    for (int d = 0; d < 4; ++d) o[d] = f32x16{};
    m_reg = -1e30f; l_reg = 0.f;
    run_tiles<8, true, false>(lds, Kw, Vw, 128, 128, tmw, qr, 0, slope2, q, q - 511, q, q0w + 31 - 511, q0w, 0ull, o, m_reg, l_reg, tid);
    int lane2 = tid_in; asm volatile("" : "+v"(lane2)); lane2 &= 63;
    row_bcast(wl, ngp[2] / fmaxf(l_reg, 1e-30f), sc, lane2 & 31, lane2 >> 5); acc_rows<2>(o, sc, accp, lane2);
#pragma unroll
    for (int r = 0; r < 16; ++r) sc[r] = 1.0f;
    store_rows(o, sc, lds + wid * 8192, ACAT + (rowb + q0w) * 2560 + 1024 + head * 128, 2560, lane2);
  }
  __syncthreads();
}
#undef KSWZ
#undef SBAR
}

namespace cmpx {
typedef short bf16x8 __attribute__((ext_vector_type(8)));
typedef float f32x4 __attribute__((ext_vector_type(4)));
typedef __attribute__((address_space(3))) float lds_f32;
typedef __attribute__((address_space(3))) unsigned short lds_u16;
__device__ __forceinline__ void cmp_unit(char* lds, int u, const bf16* NKV, const bf16* W1t  , const bf16* W2t  , const float* bias1  , bf16* KCMP, int tid_in) {
  int tid = tid_in; asm volatile("" : "+v"(tid)); const int lane = tid & 63, wid = __builtin_amdgcn_readfirstlane(tid >> 6), li = lane & 15, kq = lane >> 4;
  const int ct = u & 15, g = (u >> 4) & 1, b = (u >> 5) & 1, kv = u >> 6, c0 = ct * 16;
  const bf16* A = NKV + ((size_t)(0 * 4 + kv * 2 + g) * MROWS + (size_t)b * SEQ + 16 * (c0 + li)) * 128 + wid * 512 + 8 * kq;
  const bf16* B = W1t + (size_t)kv * 128 * 4096 + (size_t)wid * 16 * 8 * 512 + lane * 8;
  bf16x8 w2[4]; { const bf16* B2p = W2t + ((size_t)kv * 128 + wid * 16 + li) * 128 + 8 * kq;
#pragma unroll
    for (int ks = 0; ks < 4; ++ks) w2[ks] = *(const bf16x8*)(B2p + ks * 32); }
  f32x4 acc[8];
#pragma unroll
  for (int n = 0; n < 8; ++n) acc[n] = (f32x4){0.f, 0.f, 0.f, 0.f};
#pragma unroll 4
  for (int ks = 0; ks < 16; ++ks) { const bf16x8 a = *(const bf16x8*)(A + ks * 32);
#pragma unroll
    for (int n = 0; n < 8; ++n) { const bf16x8 w = *(const bf16x8*)(B + (size_t)(ks * 8 + n) * 512); acc[n] = __builtin_amdgcn_mfma_f32_16x16x32_bf16(a, w, acc[n], 0, 0, 0); } }
  lds_f32* P = (lds_f32*)lds; lds_u16* Hs = (lds_u16*)(lds + 65536);
#pragma unroll
  for (int n = 0; n < 8; ++n)
#pragma unroll
    for (int r = 0; r < 4; ++r) P[wid * 2048 + (4 * kq + r) * 128 + 16 * n + li] = acc[n][r];
  __syncthreads();
  { const int c = tid >> 5, n4 = (tid & 31) * 4; float v[4];
#pragma unroll
    for (int e = 0; e < 4; ++e) { float sacc = bias1[kv * 128 + n4 + e];
#pragma unroll
      for (int w = 0; w < 8; ++w) sacc += P[w * 2048 + c * 128 + n4 + e];
      v[e] = gelu_tanh(sacc); }
#pragma unroll
    for (int e = 0; e < 4; ++e) Hs[c * 128 + n4 + e] = (unsigned short)f2bf(v[e]); }
  __syncthreads();
  { f32x4 o2 = (f32x4){0.f, 0.f, 0.f, 0.f};
#pragma unroll
    for (int ks = 0; ks < 4; ++ks) { const bf16x8 a = *(const __attribute__((address_space(3))) bf16x8*)(Hs + li * 128 + ks * 32 + 8 * kq);
      o2 = __builtin_amdgcn_mfma_f32_16x16x32_bf16(a, w2[ks], o2, 0, 0, 0); }
    bf16* op = KCMP + ((size_t)((kv * BATCH + b) * 2 + g) * 256 + c0) * 128 + wid * 16 + li;
#pragma unroll
    for (int r = 0; r < 4; ++r) { const int c = 4 * kq + r; op[(size_t)c * 128] = (c0 + c < NCMP) ? (bf16)f2bf(o2[r]) : (bf16)0; } }
  __syncthreads();
}
__device__ __forceinline__ void ng_unit(char* lds, int u, const bf16* XB, const bf16* WNG, const float* ssq, float* NG, int tid_in) {
  int tid = tid_in; asm volatile("" : "+v"(tid)); const int lane = tid & 63, wid = __builtin_amdgcn_readfirstlane(tid >> 6), li = lane & 15, kq = lane >> 4;
  const bf16* A = XB + ((size_t)u * 32 + li) * DM + wid * 256 + 8 * kq; const bf16* B = WNG + (size_t)li * DM + wid * 256 + 8 * kq;
  f32x4 acc[2][2];
#pragma unroll
  for (int i = 0; i < 2; ++i)
#pragma unroll
    for (int j = 0; j < 2; ++j) acc[i][j] = (f32x4){0.f, 0.f, 0.f, 0.f};
#pragma unroll
  for (int ks = 0; ks < 8; ++ks) { bf16x8 a[2], w[2];
#pragma unroll
    for (int i = 0; i < 2; ++i) { a[i] = *(const bf16x8*)(A + (size_t)i * 16 * DM + ks * 32); w[i] = *(const bf16x8*)(B + (size_t)i * 16 * DM + ks * 32); }
#pragma unroll
    for (int i = 0; i < 2; ++i)
#pragma unroll
      for (int j = 0; j < 2; ++j) acc[i][j] = __builtin_amdgcn_mfma_f32_16x16x32_bf16(a[i], w[j], acc[i][j], 0, 0, 0); }
  lds_f32* P = (lds_f32*)lds;
#pragma unroll
  for (int i = 0; i < 2; ++i)
#pragma unroll
    for (int j = 0; j < 2; ++j)
#pragma unroll
      for (int r = 0; r < 4; ++r) P[wid * 1024 + (16 * i + 4 * kq + r) * 32 + 16 * j + li] = acc[i][j][r];
  __syncthreads();
  { const int row = tid >> 4, j0 = (tid & 15) * 2; const float rs = pg8::row_rstd(ssq, u * 32 + row);
#pragma unroll
    for (int e = 0; e < 2; ++e) { const int j = j0 + e; float sacc = 0.f;
#pragma unroll
      for (int w = 0; w < 8; ++w) sacc += P[w * 1024 + row * 32 + j];
      if (j < 24) NG[(size_t)(u * 32 + row) * 24 + j] = 1.0f / (1.0f + __expf(-sacc * rs)); } }
  __syncthreads();
}

__device__ __forceinline__ void qk_norm_max(char* lds, const bf16* DQ, const bf16* DK, unsigned* nrm  , int wg, int nwg, int tid_in) {
  int tid = tid_in; asm volatile("" : "+v"(tid)); const int lane = tid & 63, wid = __builtin_amdgcn_readfirstlane(tid >> 6);
  float qm = 0.f, km = 0.f;
  for (int r = wg * 8 + wid; r < MROWS; r += nwg * 8) {
    const v4u a0 = *(const __attribute__((address_space(1))) v4u*)(DQ + (size_t)r * 1024 + lane * 16), a1 = *(const __attribute__((address_space(1))) v4u*)(DQ + (size_t)r * 1024 + lane * 16 + 8);
    const v4u b0 = *(const __attribute__((address_space(1))) v4u*)(DK + (size_t)r * 1024 + lane * 16), b1 = *(const __attribute__((address_space(1))) v4u*)(DK + (size_t)r * 1024 + lane * 16 + 8);
    float sq = 0.f, sk = 0.f;
#pragma unroll
    for (int e = 0; e < 4; ++e) { const float q0 = blo(a0[e]), q1 = bhi(a0[e]), q2 = blo(a1[e]), q3 = bhi(a1[e]); sq += (q0 * q0 + q1 * q1) + (q2 * q2 + q3 * q3);
      const float k0 = blo(b0[e]), k1 = bhi(b0[e]), k2 = blo(b1[e]), k3 = bhi(b1[e]); sk += (k0 * k0 + k1 * k1) + (k2 * k2 + k3 * k3); }
    sq += __shfl_xor(sq, 1); sq += __shfl_xor(sq, 2); sk += __shfl_xor(sk, 1); sk += __shfl_xor(sk, 2);
    qm = fmaxf(qm, sq); km = fmaxf(km, sk); }
  lds_f32* red = (lds_f32*)lds;
  __syncthreads();
  if ((lane & 3) == 0) { red[wid * 32 + (lane >> 2)] = qm; red[wid * 32 + 16 + (lane >> 2)] = km; }
  __syncthreads();
  if (tid < 32) { float m = red[tid];
#pragma unroll
    for (int w = 1; w < 8; ++w) m = fmaxf(m, red[w * 32 + tid]);
    (void)__hip_atomic_fetch_max(nrm + tid * 16, __float_as_uint(m), __ATOMIC_RELAXED, __HIP_MEMORY_SCOPE_AGENT); }
  __syncthreads();
}
}


#ifndef SITE_MASK
#define SITE_MASK 0xffffffffu
#endif
#define SITE(k) ((SITE_MASK >> (k)) & 1u)
struct Args { const float* in[N_IN]; float* out; unsigned char* ws; int step_lo, step_hi; };
constexpr int N_STEPS = 1 + DEPTH * 9 + 1;

__global__ void __launch_bounds__(NTHREADS, 2) trunk_fwd(Args args_unused) {
#define SITE_ARGS const __attribute__((address_space(4))) Args* argp_ = (const __attribute__((address_space(4))) Args*)__builtin_amdgcn_kernarg_segment_ptr(); asm volatile("" : "+s"(argp_)); const __attribute__((address_space(4))) Args& args = *argp_;
    unsigned char* ws; int lo, hi; { SITE_ARGS ws = args.ws; lo = args.step_lo; hi = args.step_hi; }
    extern __shared__ __attribute__((aligned(16))) unsigned char lds_raw[];
    LAS unsigned char* lds = (LAS unsigned char*)lds_raw;
    volatile LAS unsigned* MISC = (volatile LAS unsigned*)(lds + MISC_OFF);
    const int G = gridDim.x, NT = G * NTHREADS, NGW = G * NWAVES;
    const int wave_u = __builtin_amdgcn_readfirstlane((int)(threadIdx.x >> 6));
#define MYTID (wave_u * 64 + lane_id_fresh())
#define SITE_IDS int tid = MYTID; asm volatile("" : "+v"(tid)); const int lane = tid & 63, wave = __builtin_amdgcn_readfirstlane(tid >> 6), gtid = blockIdx.x * NTHREADS + tid, gw = blockIdx.x * NWAVES + wave; (void)lane; (void)gtid; (void)gw;
    gu32* ctl = (gu32*)(ws + WS_CTL);
    for (int u = threadIdx.x; u < (LDS_BYTES - LDSCTL_OFF) / 4; u += NTHREADS) ((LAS unsigned*)(lds + LDSCTL_OFF))[u] = 0u;
    __syncthreads();
    if (hi - lo > 1) (void)xcd_barrier_post((unsigned*)(ctl + CW_BAR), MISC + 8);
#define RUN(s) ((s) >= lo && (s) < hi)
#define SEAM(s) do { if ((s) + 1 < hi) { XcdBarrier bar_; bar_.bar = (unsigned*)((gu32*)(ws + WS_CTL) + CW_BAR); bar_.x = xb_xcc_id(); bar_.st = (volatile LAS unsigned*)(lds + MISC_OFF) + 8; xcd_barrier(bar_); } } while (0)
    bf16* XB = (bf16*)(ws + WS_XB); float* SSQ = (float*)(ws + WS_SSQ);
    bf16* Hb = (bf16*)(ws + WS_H);
    float* BIAS1 = (float*)(ws + WS_MISC); float* LAMV = (float*)(ws + WS_MISC + 4096);
    LAS float* epi_scr = (LAS float*)(lds + EPI_OFF);

    if (SITE(0) && RUN(0)) {
        SITE_IDS SITE_ARGS
        LAS float* scr = (LAS float*)(lds + RING_OFF + wave * 16384);
        const bool halfsplit = (G & 15) == 0; const int Gs = halfsplit ? G / 2 : G, sidx = halfsplit ? (int)(((blockIdx.x >> 4) << 3) | (blockIdx.x & 7u)) : (int)blockIdx.x;
        if (!halfsplit || ((blockIdx.x >> 3) & 1u) == 0u) {
        const int gws = sidx * NWAVES + wave, NGWs = Gs * NWAVES;
        for (int l = 0; l < DEPTH; ++l) cvt_job(args.in[I_WMKV] + (size_t)l * DM * 1024, DM, 1024, 16, args.in[I_MEMN] + l * DM, (bf16*)(ws + WS_WMKV) + (size_t)l * 1024 * DM, DM | TILED_FLAG, 0, 0, scr, gws, NGWs, lane);
        for (int m = gws; m < MROWS + MEMROWS; m += NGWs) {
            const bool isx = m < MROWS; const int r = isx ? m : m - MROWS;
            const float* src = isx ? args.in[I_X] + (size_t)r * DM : args.in[I_MEM] + (size_t)r * DM;
            bf16* db = isx ? XB + (size_t)r * DM : (bf16*)(ws + WS_MEMB) + (size_t)r * DM;
            float* dq = isx ? SSQ + (size_t)r * 8 : (float*)(ws + WS_MEMSSQ) + (size_t)r * 8;
            float s = 0.f; f32x4 v[8];
#pragma unroll
            for (int j = 0; j < 8; ++j) v[j] = *((const GAS f32x4*)src + lane + 64 * j);
#pragma unroll
            for (int j = 0; j < 8; ++j) { s += (v[j][0] * v[j][0] + v[j][1] * v[j][1]) + (v[j][2] * v[j][2] + v[j][3] * v[j][3]);
                *((GAS unsigned long long*)db + lane + 64 * j) = (unsigned long long)pk2(v[j][0], v[j][1]) | ((unsigned long long)pk2(v[j][2], v[j][3]) << 32); }
            s = wave_sum(s);
            if (lane < 8) dq[lane] = (lane == 0) ? s : 0.f;
        }
        for (int o4 = sidx; o4 < DEPTH * 2 * 32; o4 += Gs) { const int n4 = (o4 & 31) * 4, lk = o4 >> 5;
            const float* pos = args.in[I_CPOS] + (size_t)lk * 4096; const float* w = args.in[I_CW1] + (size_t)lk * 4096 * 128 + n4; f32x4 s4 = {0.f, 0.f, 0.f, 0.f};
#pragma unroll
            for (int i = 0; i < 8; ++i) { const int k = wave * 512 + i * 64 + lane; s4 += *(const GAS f32x4*)(w + (size_t)k * 128) * pos[k]; }
            const float s0 = wave_sum(s4[0]), s1 = wave_sum(s4[1]), s2 = wave_sum(s4[2]), s3 = wave_sum(s4[3]);
            LAS float* red = (LAS float*)(lds + EPI_OFF);
            __syncthreads();
            if (lane == 0) { red[wave * 4 + 0] = s0; red[wave * 4 + 1] = s1; red[wave * 4 + 2] = s2; red[wave * 4 + 3] = s3; }
            __syncthreads();
            if (tid < 4) { float t = red[tid];
#pragma unroll
                for (int w8 = 1; w8 < 8; ++w8) t += red[w8 * 4 + tid];
                BIAS1[lk * 128 + n4 + tid] = t; } }
        if (blockIdx.x == 0 && wave >= 1 && wave <= DEPTH) { const int ll = wave - 1; const float* lp = args.in[I_LAM] + ll * 256;
            const float a = wave_sum(lp[lane] * lp[64 + lane]), b2 = wave_sum(lp[128 + lane] * lp[192 + lane]);
            if (lane == 0) LAMV[ll] = expf(a) - expf(b2) + (0.8f - 0.6f * expf(-0.3f * (float)ll)); }
        __syncthreads();
        }
        cvt_pull(args, ws, 0, (gu32*)(ws + WS_CTL) + CW_CVT + 3 * 128, tid, lds + RING_OFF);
        SEAM(0);
    }

    for (int it = 0; it < 3 * DEPTH; ++it) {
        const int l = it / 3, r3 = it - 3 * l; const int sb = 1 + 9 * l + (r3 == 0 ? 0 : (r3 == 1 ? 2 : 7));
        unsigned char* wl = ws + WS_WL + (size_t)l * WL_STRIDE;
        if (r3 != 1) {
            if (SITE(1) && RUN(sb)) {
                pg8::Gemm g{XB, (const bf16*)(wl + (r3 == 0 ? WL_GU1 : WL_GU2)), MROWS, 2 * DFF, DM}; pg8::StaticOrder S; S.init(MROWS, 2 * DFF, G, (int)blockIdx.x);
                pg8::EpiSwiGLU E{Hb, SSQ, DFF, (const LAS float*)(lds + SSQI_OFF)}; pg8::NoHook nh;
                pg8::gemm_phase<pg8::EpiSwiGLU, pg8::StaticOrder, pg8::NoHook, true, true>(lds + RING_OFF, g, S, E, nh, MYTID);
                if (SITE(2) && it == 0) {
                    pg8::Gemm g2{(const bf16*)(ws + WS_MEMB), (const bf16*)(ws + WS_WMKV), MEMROWS, DEPTH * 1024, DM}; pg8::StaticOrder S2; S2.init(MEMROWS, DEPTH * 1024, G, (int)((blockIdx.x + G / 2) % G));
                    pg8::EpiScaleBf16 E2{(bf16*)(ws + WS_MEMKV), DEPTH * 1024, (const float*)(ws + WS_MEMSSQ), (const LAS float*)(lds + SSQI_OFF)};
                    pg8::gemm_phase<pg8::EpiScaleBf16, pg8::StaticOrder, pg8::NoHook, true, true>(lds + RING_OFF, g2, S2, E2, nh, MYTID);
                }
                SEAM(sb);
            }
            if (SITE(3) && RUN(sb + 1)) {
                pg8::Gemm g{Hb, (const bf16*)(wl + (r3 == 0 ? WL_D1 : WL_D2)), MROWS, DM, DFF}; pg8::StaticOrder S; S.init(MROWS, DM, G, (int)blockIdx.x);
                pg8::EpiResid E{XB, SSQ, 0.5f, epi_scr}; pg8::NoHook nh;
                pg8::gemm_phase<pg8::EpiResid, pg8::StaticOrder, pg8::NoHook, true, true>(lds + RING_OFF, g, S, E, nh, MYTID);
                SEAM(sb + 1);
            }
        } else {
            bf16* DQ = (bf16*)(ws + WS_DQ); bf16* DK = (bf16*)(ws + WS_DK); bf16* DV = (bf16*)(ws + WS_DV); bf16* NQ = (bf16*)(ws + WS_NQ);
            bf16* NKV = (bf16*)(ws + WS_NKV); bf16* MQ = (bf16*)(ws + WS_MQ); bf16* MG = (bf16*)(ws + WS_MG); float* NG = (float*)(ws + WS_NG);
            bf16* KCMP = (bf16*)(ws + WS_KCMP); float* HC = (float*)(ws + WS_HC); bf16* ACAT = (bf16*)(ws + WS_ACAT); bf16* MERGED = (bf16*)(ws + WS_MERGED);
            if (SITE(4) && RUN(sb)) {
                pg8::Gemm g{XB, (const bf16*)(wl + WL_IN), MROWS, PROJ_N, DM}; pg8::StaticOrder S; S.init(MROWS, PROJ_N, G, (int)blockIdx.x);
                pg8::EpiProj E{(const LAS float*)(lds + SSQI_OFF), SSQ, DQ, DK, DV, NQ, NKV, MQ, MG, MROWS}; pg8::NoHook nh;
                pg8::gemm_phase<pg8::EpiProj, pg8::StaticOrder, pg8::NoHook, true, true>(lds + RING_OFF, g, S, E, nh, MYTID);
                SEAM(sb);
            }
            if (SITE(5) && RUN(sb + 1)) {
                SITE_IDS SITE_ARGS
                char* alds = (char*)lds_raw + RING_OFF;
                if (G >= 256 && (int)blockIdx.x >= G - 128) { cmpx::cmp_unit(alds, G - 1 - (int)blockIdx.x, NKV, (const bf16*)(wl + WL_C1), (const bf16*)(wl + WL_C2), BIAS1 + l * 256, KCMP, tid); }
                else if (G >= 256) { for (int u = (int)blockIdx.x; u < MROWS / 32; u += G - 128) cmpx::ng_unit(alds, u, XB, (const bf16*)(wl + WL_NG), SSQ, NG, tid);
                                     cmpx::qk_norm_max(alds, DQ, DK, (unsigned*)((gu32*)(ws + WS_CTL) + CW_NRM + l * 512), (int)blockIdx.x, G - 128, tid); }
                else { cmpx::qk_norm_max(alds, DQ, DK, (unsigned*)((gu32*)(ws + WS_CTL) + CW_NRM + l * 512), (int)blockIdx.x, G, tid);
                       for (int u = (int)blockIdx.x; u < MROWS / 32; u += G) cmpx::ng_unit(alds, u, XB, (const bf16*)(wl + WL_NG), SSQ, NG, tid);
                       for (int u = (int)blockIdx.x; u < 128; u += G) cmpx::cmp_unit(alds, u, NKV, (const bf16*)(wl + WL_C1), (const bf16*)(wl + WL_C2), BIAS1 + l * 256, KCMP, tid); }
                SEAM(sb + 1);
            }
#define CVT_PULL() do { SITE_IDS SITE_ARGS cvt_pull(args, ws, l + 1, (gu32*)(ws + WS_CTL) + CW_CVT + l * 128, tid, lds + RING_OFF); } while (0)
            if (SITE(7) && RUN(sb + 2) && l + 1 < DEPTH && (int)(blockIdx.x >> 3) >= (G >> 3) - 5) CVT_PULL();
            if (SITE(7) && RUN(sb + 2)) {
                SITE_IDS SITE_ARGS
                const float lam_init = 0.8f - 0.6f * expf(-0.3f * (float)l);
                { char* alds = (char*)lds_raw + RING_OFF; volatile LAS unsigned* qslot = (volatile LAS unsigned*)(lds + MISC_OFF) + 16; const float lam = LAMV[l]; const float* subln = args.in[I_SUBLN] + l * 128;
                  gu32* qh = (gu32*)(ws + WS_CTL) + CW_Q + (l * 4) * 64;
                  for (;;) {
                      if (tid == 0) qslot[0] = __hip_atomic_fetch_add(qh, 1u, __ATOMIC_RELAXED, __HIP_MEMORY_SCOPE_AGENT);
                      __syncthreads(); const int u = (int)qslot[0]; __syncthreads();
                      if (u >= BATCH * 2 * 64) break;
                      att::nsa_unit(alds, (u >> 1) & 1, u & 1, 63 - (u >> 2), NQ, NKV, KCMP, NG, (float*)(ws + WS_ACC), ACAT, tid); }
                  for (;;) {
                      if (tid == 0) qslot[0] = __hip_atomic_fetch_add(qh + 64, 1u, __ATOMIC_RELAXED, __HIP_MEMORY_SCOPE_AGENT);
                      __syncthreads(); const int u = (int)qslot[0]; __syncthreads();
                      if (u >= BATCH * 8 * 32) break;
                      att::diff_unit(alds, (u >> 3) & 1, u & 7, 31 - (u >> 4), DQ, DK, DV, ACAT, subln, lam, lam_init, (unsigned*)((gu32*)(ws + WS_CTL) + CW_NRM + l * 512), tid); }
                  for (;;) {
                      if (tid == 0) qslot[0] = __hip_atomic_fetch_add(qh + 128, 1u, __ATOMIC_RELAXED, __HIP_MEMORY_SCOPE_AGENT);
                      __syncthreads(); const int u = (int)qslot[0]; __syncthreads();
                      if (u >= BATCH * 4 * 16) break;
                      att::mem_unit(alds, (u >> 2) & 1, u & 3, u >> 3, MQ, (const bf16*)(ws + WS_MEMKV) + (size_t)l * 1024, ACAT, tid); } }
            }
            if (SITE(7) && RUN(sb + 2)) {
                if (l + 1 < DEPTH) CVT_PULL();
                SEAM(sb + 2);
            }
#undef CVT_PULL
            if (SITE(8) && RUN(sb + 3)) {
                pg8::Gemm g{ACAT, (const bf16*)(wl + WL_UP), MROWS, DM, 2560}; pg8::StaticOrder S; S.init(MROWS, DM, G, (int)blockIdx.x);
                pg8::MergeGate mgk{MG}; pg8::EpiMerge E{MERGED, mgk};
                pg8::gemm_phase<pg8::EpiMerge, pg8::StaticOrder, pg8::MergeGate, false, true>(lds + RING_OFF, g, S, E, mgk, MYTID);
                SEAM(sb + 3);
            }
            if (SITE(9) && RUN(sb + 4)) {
                pg8::Gemm g{MERGED, (const bf16*)(wl + WL_O), MROWS, DM, DM}; pg8::StaticOrder S; S.init(MROWS, DM, G, (int)blockIdx.x);
                pg8::EpiResid E{XB, SSQ, 1.0f, epi_scr}; pg8::NoHook nh;
                pg8::gemm_phase<pg8::EpiResid, pg8::StaticOrder, pg8::NoHook, true, true>(lds + RING_OFF, g, S, E, nh, MYTID);
                SEAM(sb + 4);
            }
        }
    }
    if (RUN(N_STEPS - 1)) {
        SITE_IDS SITE_ARGS
        const float* gn = args.in[I_FINN];
        for (int m = gw; m < MROWS; m += NGW) { const GAS unsigned long long* xr = (const GAS unsigned long long*)(XB + (size_t)m * DM) + lane; f32x4 v[8]; float s = 0.f;
#pragma unroll
            for (int j = 0; j < 8; ++j) { const unsigned long long w = xr[64 * j]; const unsigned w0 = (unsigned)w, w1 = (unsigned)(w >> 32); v[j] = (f32x4){blo(w0), bhi(w0), blo(w1), bhi(w1)};
                s += (v[j][0] * v[j][0] + v[j][1] * v[j][1]) + (v[j][2] * v[j][2] + v[j][3] * v[j][3]); }
            const float rs = 1.0f / sqrtf(wave_sum(s) * (1.0f / DM) + NORM_EPS);
#pragma unroll
            for (int j = 0; j < 8; ++j) { const f32x4 gv = *((const f32x4*)gn + lane + 64 * j); *((f32x4*)(args.out + (size_t)m * DM) + lane + 64 * j) = v[j] * rs * gv; } }
    }
#undef RUN
#undef SEAM
#undef SITE_IDS
#undef SITE_ARGS
#undef MYTID
}

#ifndef MK_PER_STEP
#define MK_PER_STEP 0
#endif
extern "C" void kernel_launch(void* const* d_in, const int* in_sizes, int n_in, void* d_out, int out_size, void* d_ws, size_t ws_size, hipStream_t stream) {
    static int grid = 0;
    if (grid == 0) {
        if (n_in != N_IN || in_sizes[0] != MROWS * DM || out_size != MROWS * DM || ws_size < WS_END) {
            fprintf(stderr, "kernel_launch: shape/workspace mismatch: n_in %d in0 %d out %d ws %zu (need %zu)\n", n_in, n_in > 0 ? in_sizes[0] : -1, out_size, ws_size, (size_t)WS_END); grid = -1; return; }
        int dev = 0, cus = 0, per_cu = 0;
        if (hipGetDevice(&dev) != hipSuccess || hipDeviceGetAttribute(&cus, hipDeviceAttributeMultiprocessorCount, dev) != hipSuccess) { grid = -1; return; }
        if (hipFuncSetAttribute((const void*)trunk_fwd, hipFuncAttributeMaxDynamicSharedMemorySize, LDS_BYTES) != hipSuccess) { fprintf(stderr, "kernel_launch: hipFuncSetAttribute failed\n"); grid = -1; return; }
        if (hipOccupancyMaxActiveBlocksPerMultiprocessor(&per_cu, (const void*)trunk_fwd, NTHREADS, LDS_BYTES) != hipSuccess || per_cu < 1)
            fprintf(stderr, "kernel_launch: note: occupancy query reports %d workgroups per CU\n", per_cu);
        (void)hipGetLastError();
        grid = cus;
    }
    if (grid < 0) return;
    if (hipMemsetAsync((char*)d_ws + WS_CTL, 0, CTL_ZERO_BYTES, stream) != hipSuccess) return;
    Args a{};
    for (int i = 0; i < N_IN; ++i) a.in[i] = (const float*)d_in[i];
    a.out = (float*)d_out; a.ws = (unsigned char*)d_ws;
#if MK_PER_STEP
    for (int s = 0; s < N_STEPS; ++s) { a.step_lo = s; a.step_hi = s + 1; hipLaunchKernelGGL(trunk_fwd, dim3(grid), dim3(NTHREADS), LDS_BYTES, stream, a); }
#else
    a.step_lo = 0; a.step_hi = N_STEPS; hipLaunchKernelGGL(trunk_fwd, dim3(grid), dim3(NTHREADS), LDS_BYTES, stream, a);
#endif
    const hipError_t le = hipPeekAtLastError();
    if (le != hipSuccess) fprintf(stderr, "kernel_launch: launch failed: %s\n", hipGetErrorName(le));
}
```
